# Optimizing an MI355X kernel written in HIP

```python
import jax, jax.numpy as jnp
from jax import lax
import numpy as np

D_MODEL = 1024
BATCH = 8
SEQ = 4096
DEPTH = 1

GRID_W = 64
CTX_LEN = 256
D_RWKV = 512
D_CONV = 512
RWKV_HEAD = 64
RWKV_HEADS = D_RWKV // RWKV_HEAD
CONV_WIDTH = 3
LORA_W = 64
LORA_A = 64
LORA_G = 128
N_EXPERTS = 16
EC_CAPACITY = 2
D_EXPERT = 1024
NORM_EPS = 1e-6
GN_EPS = 64e-5
RWKV_COLS = 3 * D_RWKV + LORA_W + LORA_A + LORA_G
CONV_COLS = 3 * D_CONV
D_IN = RWKV_COLS + CONV_COLS

kernel_name = "hybrid_rwkv7_shortconv_ecmoe_dit_block"


def rmsnorm(x, g):
    xf = x.astype(jnp.float32)
    y = xf * lax.rsqrt(jnp.mean(xf * xf, axis=-1, keepdims=True) + NORM_EPS)
    return (y * g.astype(jnp.float32)).astype(x.dtype)


def modulate(h, shift, scale):
    return h * (1 + scale) + shift


def grid_shift(p, rows):
    b, t, ch = p.shape
    q = p.reshape(b, rows, GRID_W, ch // 4, 4)
    zc = jnp.zeros_like(q[:, :, :1, :, 0])
    zr = jnp.zeros_like(q[:, :1, :, :, 0])
    left = jnp.concatenate([zc, q[:, :, :-1, :, 0]], axis=2)
    right = jnp.concatenate([q[:, :, 1:, :, 1], zc], axis=2)
    up = jnp.concatenate([zr, q[:, :-1, :, :, 2]], axis=1)
    down = jnp.concatenate([q[:, 1:, :, :, 3], zr], axis=1)
    return jnp.stack([left, right, up, down], axis=-1).reshape(b, t, ch)


def seq_shift(p):
    b, t, ch = p.shape
    q = p.reshape(b, t, ch // 2, 2)
    z = jnp.zeros_like(q[:, :1, :, 0])
    prev = jnp.concatenate([z, q[:, :-1, :, 0]], axis=1)
    nxt = jnp.concatenate([q[:, 1:, :, 1], z], axis=1)
    return jnp.stack([prev, nxt], axis=-1).reshape(b, t, ch)


def split_rwkv(p, mu, shifted):
    p = p + mu * (shifted - p)
    o = 3 * D_RWKV
    return jnp.split(p, [D_RWKV, 2 * D_RWKV, o, o + LORA_W, o + LORA_W + LORA_A], axis=-1)


def wkv_scan(s0, r, w, k, v, a, b, reverse):
    def step(s, inp):
        r_t, w_t, k_t, v_t, a_t, b_t = inp
        sa = jnp.einsum('bhvk,bhk->bhv', s, a_t)
        s = s * w_t[:, :, None, :] + sa[..., :, None] * b_t[:, :, None, :] + v_t[..., :, None] * k_t[:, :, None, :]
        return s, jnp.einsum('bhvk,bhk->bhv', s, r_t)
    xs = tuple(jnp.moveaxis(z, 1, 0) for z in (r, w, k, v, a, b))
    s, y = lax.scan(step, s0, xs, reverse=reverse)
    return jnp.moveaxis(y, 0, 1), s


def rwkv_bidir(xr, xk, xv, xw, xa, w0, w_up, a0, a_up, k_k, k_a, s0_f, s0_b):
    bsz, t = xr.shape[0], xr.shape[1]
    f32 = jnp.float32
    heads = lambda z: z.astype(f32).reshape(bsz, t, RWKV_HEADS, RWKV_HEAD)
    per_head = lambda z: z.astype(f32).reshape(RWKV_HEADS, RWKV_HEAD)
    r, k, v = heads(xr), heads(xk), heads(xv)
    kk = k * per_head(k_k)
    kk = kk / jnp.maximum(jnp.sqrt(jnp.sum(kk * kk, axis=-1, keepdims=True)), 1e-12)
    tw = jnp.tanh(xw.astype(f32))
    xa = xa.astype(f32)
    k_a_h = per_head(k_a)
    y_sum, k_sum, states = 0.0, 0.0, []
    for d, (rev, s0) in enumerate(((False, s0_f), (True, s0_b))):
        wl = -jax.nn.softplus(-(w0[d].astype(f32) + tw @ w_up[d].astype(f32))) - 0.5
        decay = jnp.exp(-jnp.exp(heads(wl)))
        a = heads(jax.nn.sigmoid(a0[d].astype(f32) + xa @ a_up[d].astype(f32)))
        kd = k * (1 + (a - 1) * k_a_h)
        y, s = wkv_scan(s0, r, decay, kd, v, -kk, kk * a, rev)
        y_sum = y_sum + y
        k_sum = k_sum + kd
        states.append(s)
    return y_sum, states[0], states[1], r, k_sum, v


def rwkv_out(y, r, k_sum, v, xg, g_up, r_k, gn_g, gn_b):
    bsz, t = y.shape[0], y.shape[1]
    f32 = jnp.float32
    mu = jnp.mean(y, axis=-1, keepdims=True)
    var = jnp.mean(jnp.square(y - mu), axis=-1, keepdims=True)
    yn = ((y - mu) * lax.rsqrt(var + GN_EPS)).reshape(bsz, t, D_RWKV) * gn_g.astype(f32) + gn_b.astype(f32)
    bonus = (jnp.sum(r * k_sum * r_k.astype(f32), axis=-1, keepdims=True) * v).reshape(bsz, t, D_RWKV)
    g = jax.nn.sigmoid(xg.astype(f32)) @ g_up.astype(f32)
    return (yn + bonus) * g


def dwconv3(u, w):
    return lax.conv_general_dilated(u, w[:, None, :].astype(u.dtype), window_strides=(1,), padding=((1, 1),),
                                    dimension_numbers=('NWC', 'WIO', 'NWC'), feature_group_count=u.shape[-1])


def short_conv(p, conv_w):
    b_gate, c_gate, u = jnp.split(p, 3, axis=-1)
    return b_gate * dwconv3(c_gate * u, conv_w)


def expert_choice_ffn(h, router_w, w_gate, w_up, w_down):
    bsz, t, d = h.shape
    cap = EC_CAPACITY * t // N_EXPERTS
    aff = jax.nn.softmax((h @ router_w).astype(jnp.float32), axis=-1)
    vals, idx = lax.top_k(jnp.swapaxes(aff, 1, 2), cap)
    xs = jax.vmap(lambda hb, ib: hb[ib])(h, idx)
    hid = jax.nn.silu(jnp.einsum('becd,edf->becf', xs, w_gate)) * jnp.einsum('becd,edf->becf', xs, w_up)
    out = jnp.einsum('becf,efd->becd', hid, w_down) * vals[..., None].astype(h.dtype)
    return jax.vmap(lambda ob, ib: jnp.zeros((t, d), h.dtype).at[ib.reshape(-1)].add(ob.reshape(-1, d)))(out, idx)


def setup_inputs(seed: int = 0) -> dict:
    key = jax.random.key(seed)
    ks = jax.random.split(key, 28)
    L = DEPTH
    nrm = lambda k, shape, scale: jax.random.normal(k, shape, jnp.float32) * scale
    return {
        'x': nrm(ks[0], (BATCH, SEQ, D_MODEL), 1.0),
        'c': nrm(ks[1], (BATCH, D_MODEL), 1.0),
        'ctx': nrm(ks[2], (BATCH, CTX_LEN, D_MODEL), 1.0),
        'c_ctx': nrm(ks[3], (D_MODEL,), 1.0),
        'ada_w': nrm(ks[4], (L, D_MODEL, 6 * D_MODEL), 0.5 * D_MODEL ** -0.5),
        'ada_b': nrm(ks[5], (L, 6 * D_MODEL), 0.02),
        'norm1_g': 1.0 + nrm(ks[6], (L, D_MODEL), 0.02),
        'norm2_g': 1.0 + nrm(ks[7], (L, D_MODEL), 0.02),
        'w_in': nrm(ks[8], (L, D_MODEL, D_IN), D_MODEL ** -0.5),
        'shift_mu': jax.random.uniform(ks[9], (L, RWKV_COLS), jnp.float32),
        'w0': jax.random.uniform(ks[10], (L, 2, D_RWKV), jnp.float32, minval=-6.0, maxval=1.0),
        'w_lora_up': nrm(ks[11], (L, 2, LORA_W, D_RWKV), 0.1 * LORA_W ** -0.5),
        'a0': nrm(ks[12], (L, 2, D_RWKV), 0.5),
        'a_lora_up': nrm(ks[13], (L, 2, LORA_A, D_RWKV), LORA_A ** -0.5),
        'k_k': 0.85 + nrm(ks[14], (L, D_RWKV), 0.05),
        'k_a': 1.0 + nrm(ks[15], (L, D_RWKV), 0.05),
        'r_k': nrm(ks[16], (L, RWKV_HEADS, RWKV_HEAD), 0.1),
        'g_lora_up': nrm(ks[17], (L, LORA_G, D_RWKV), LORA_G ** -0.5),
        'gn_g': 1.0 + nrm(ks[18], (L, D_RWKV), 0.02),
        'gn_b': nrm(ks[19], (L, D_RWKV), 0.02),
        'conv_w': nrm(ks[20], (L, CONV_WIDTH, D_CONV), CONV_WIDTH ** -0.5),
        'w_out': nrm(ks[21], (L, D_RWKV + D_CONV, D_MODEL), (D_RWKV + D_CONV) ** -0.5),
        'router_w': nrm(ks[22], (L, D_MODEL, N_EXPERTS), D_MODEL ** -0.5),
        'exp_w_gate': nrm(ks[23], (L, N_EXPERTS, D_MODEL, D_EXPERT), D_MODEL ** -0.5),
        'exp_w_up': nrm(ks[24], (L, N_EXPERTS, D_MODEL, D_EXPERT), D_MODEL ** -0.5),
        'exp_w_down': nrm(ks[25], (L, N_EXPERTS, D_EXPERT, D_MODEL), D_EXPERT ** -0.5),
        'final_g': 1.0 + nrm(ks[26], (D_MODEL,), 0.02),
    }


def reference(x, c, ctx, c_ctx, ada_w, ada_b, norm1_g, norm2_g, w_in, shift_mu, w0, w_lora_up, a0, a_lora_up,
              k_k, k_a, r_k, g_lora_up, gn_g, gn_b, conv_w, w_out, router_w, exp_w_gate, exp_w_up, exp_w_down,
              final_g):
    bsz, t, _ = x.shape
    rows = t // GRID_W
    s_zero = jnp.zeros((bsz, RWKV_HEADS, RWKV_HEAD, RWKV_HEAD), jnp.float32)
    for l in range(DEPTH):
        last = l == DEPTH - 1
        mod = jax.nn.silu(c) @ ada_w[l] + ada_b[l]
        mod_c = jax.nn.silu(c_ctx) @ ada_w[l] + ada_b[l]
        sh1, sc1, g1, sh2, sc2, g2 = jnp.split(mod[:, None, :], 6, axis=-1)
        csh1, csc1, cg1, csh2, csc2, cg2 = jnp.split(mod_c, 6, axis=-1)

        pc = modulate(rmsnorm(ctx, norm1_g[l]), csh1, csc1) @ w_in[l]
        px = modulate(rmsnorm(x, norm1_g[l]), sh1, sc1) @ w_in[l]
        pc_rw, pc_cv = pc[..., :RWKV_COLS], pc[..., RWKV_COLS:]
        px_rw, px_cv = px[..., :RWKV_COLS], px[..., RWKV_COLS:]

        cr, ck, cv, cw, ca, cgl = split_rwkv(pc_rw, shift_mu[l], seq_shift(pc_rw))
        xr, xk, xv, xw, xa, xgl = split_rwkv(px_rw, shift_mu[l], grid_shift(px_rw, rows))

        yc, sf, sb, rc, kc, vc = rwkv_bidir(cr, ck, cv, cw, ca, w0[l], w_lora_up[l], a0[l], a_lora_up[l],
                                            k_k[l], k_a[l], s_zero, s_zero)
        yx, _, _, rx, kx, vx = rwkv_bidir(xr, xk, xv, xw, xa, w0[l], w_lora_up[l], a0[l], a_lora_up[l],
                                          k_k[l], k_a[l], sf, sb)
        a_x = rwkv_out(yx, rx, kx, vx, xgl, g_lora_up[l], r_k[l], gn_g[l], gn_b[l]).astype(x.dtype)
        b_x = short_conv(px_cv, conv_w[l])
        x = x + g1 * (jnp.concatenate([a_x, b_x], axis=-1) @ w_out[l])
        if not last:
            a_c = rwkv_out(yc, rc, kc, vc, cgl, g_lora_up[l], r_k[l], gn_g[l], gn_b[l]).astype(ctx.dtype)
            b_c = short_conv(pc_cv, conv_w[l])
            ctx = ctx + cg1 * (jnp.concatenate([a_c, b_c], axis=-1) @ w_out[l])

        hx = modulate(rmsnorm(x, norm2_g[l]), sh2, sc2)
        x = x + g2 * expert_choice_ffn(hx, router_w[l], exp_w_gate[l], exp_w_up[l], exp_w_down[l])
        if not last:
            hc = modulate(rmsnorm(ctx, norm2_g[l]), csh2, csc2)
            ctx = ctx + cg2 * expert_choice_ffn(hc, router_w[l], exp_w_gate[l], exp_w_up[l], exp_w_down[l])
    return rmsnorm(x, final_g)
```

```cpp
#include <hip/hip_runtime.h>
#include <hip/hip_cooperative_groups.h>
#include <cstdio>
#include <cstdint>
namespace cg = cooperative_groups;

#ifndef MK_FUSED
#define MK_FUSED 0
#endif

#define LAS __attribute__((address_space(3)))
typedef unsigned short bf16_t;
typedef short bf16x8 __attribute__((ext_vector_type(8)));
typedef float f32x4 __attribute__((ext_vector_type(4)));
typedef unsigned u32x4 __attribute__((ext_vector_type(4)));
typedef unsigned u32x2 __attribute__((ext_vector_type(2)));

constexpr int NB = 8, T = 4096, D = 1024, CTXL = 256, DIN = 3328, RWC = 1792, NH = 8, HD = 64, DR = 512;
constexpr int NE = 16, CAP = 512, DE = 1024;
constexpr int MX = NB * T;
constexpr int MC = NB * CTXL;
constexpr int MALL = MX + MC;
constexpr int NWAVES = 8, NTHR = 512;
constexpr int LDS_BYTES = 147456;

constexpr size_t MiB = 1u << 20;
constexpr size_t WS_CTL = 0;
constexpr size_t WS_MOD = 1 * MiB;
constexpr size_t WS_BDOT = 2 * MiB;
constexpr size_t WS_AFF = 4 * MiB;
constexpr size_t WS_SEL = 6 * MiB;
constexpr size_t WS_WINT = 8 * MiB;
constexpr size_t WS_IDX = 15 * MiB;
constexpr size_t WS_VAL = 15 * MiB + 512 * 1024;
constexpr size_t WS_WOUTT = 16 * MiB;
constexpr size_t WS_W1T = 18 * MiB;
constexpr size_t WS_W2T = 82 * MiB;
constexpr size_t WS_XN = 114 * MiB;
constexpr size_t WS_AX = 114 * MiB;
constexpr size_t WS_XS = 114 * MiB;
constexpr size_t WS_DN = 114 * MiB;
constexpr size_t WS_PX = 182 * MiB;
constexpr size_t WS_X1 = 242 * MiB;
constexpr size_t WS_HX = 370 * MiB;
constexpr size_t WS_HID = 370 * MiB;
constexpr size_t WS_Y = 403 * MiB;
constexpr size_t WS_END = 498 * MiB;

struct Params { const float* in[27]; float* out; unsigned char* ws; int ph_lo, ph_hi; };

__device__ __forceinline__ unsigned f2bf(float f) { unsigned u = __float_as_uint(f); return (u + 0x7fffu + ((u >> 16) & 1u)) >> 16; }
__device__ __forceinline__ unsigned pk2(float lo, float hi) { return f2bf(lo) | (f2bf(hi) << 16); }
__device__ __forceinline__ float bflo(unsigned w) { return __uint_as_float(w << 16); }
__device__ __forceinline__ float bfhi(unsigned w) { return __uint_as_float(w & 0xffff0000u); }
__device__ __forceinline__ void unpack8(const u32x4 w, float (&f)[8]) {
    f[0] = bflo(w.x); f[1] = bfhi(w.x); f[2] = bflo(w.y); f[3] = bfhi(w.y); f[4] = bflo(w.z); f[5] = bfhi(w.z); f[6] = bflo(w.w); f[7] = bfhi(w.w); }
__device__ __forceinline__ u32x4 pack8(const float (&f)[8]) { u32x4 w; w.x = pk2(f[0], f[1]); w.y = pk2(f[2], f[3]); w.z = pk2(f[4], f[5]); w.w = pk2(f[6], f[7]); return w; }
__device__ __forceinline__ float wave_sum(float v) {
#pragma unroll
    for (int o = 1; o < 64; o <<= 1) v += __shfl_xor(v, o);
    return v;
}
__device__ __forceinline__ float wave_max(float v) {
#pragma unroll
    for (int o = 1; o < 64; o <<= 1) v = fmaxf(v, __shfl_xor(v, o));
    return v;
}
__device__ __forceinline__ float red8(float v) {
    v += __int_as_float(__builtin_amdgcn_update_dpp(0, __float_as_int(v), 0xB1, 0xF, 0xF, true));
    v += __int_as_float(__builtin_amdgcn_update_dpp(0, __float_as_int(v), 0x4E, 0xF, 0xF, true));
    v += __int_as_float(__builtin_amdgcn_update_dpp(0, __float_as_int(v), 0x141, 0xF, 0xF, true));
    return v;
}
__device__ __forceinline__ float sigmoidf_(float x) { return 1.f / (1.f + expf(-x)); }

namespace pg8 {
#define PG8_LAS __attribute__((address_space(3)))
constexpr int BM = 256, BK = 64, HALF = 128, HTB = HALF * BK * 2, STAGE_BYTES = 8 * HTB, NXCD = 8, WGM = 8;
__host__ __device__ __forceinline__ int lds_byte(int r, int c) { const int st = (r >> 4) * 2 + (c >> 5), rr = r & 15, cc = c & 31, ob = rr * 64 + cc * 2; return st * 1024 + (ob ^ (((ob >> 9) & 1) << 5)); }
__host__ __device__ __forceinline__ void stage_rc(int b, int& R, int& C) { const int st = b / 1024, sb = b % 1024, swz = sb ^ (((sb >> 9) & 1) << 5); R = (st >> 1) * 16 + swz / 64; C = (st & 1) * 32 + (swz % 64) / 2; }
__host__ __device__ __forceinline__ int perm32(int rho) { const int n = rho >> 4, i = rho & 15; return 8 * (i >> 2) + 4 * n + (i & 3); }
struct Unit { int pm, pn; };
struct Gemm { const bf16_t* A; const bf16_t* Bt; int M, N, K; };

__device__ __forceinline__ int xcd_remap(int wgid, int nwg) { const int q = nwg / NXCD, r = nwg % NXCD, xcd = wgid % NXCD, off = wgid / NXCD; return (xcd < r ? xcd * (q + 1) : r * (q + 1) + (xcd - r) * q) + off; }

struct StaticOrder {
    int nM, nN, nwg, G, c;
    __device__ void init(int M, int N, int G_, int c_) { nM = M / BM; nN = N / BM; nwg = nM * nN; G = G_; c = c_; }
    __device__ bool next(int i, Unit& u) const {
        const long L = (long)i * G + c; if (L >= nwg) return false;
        int wgid = xcd_remap((int)L, nwg);
        const int nig = WGM * nN, gid = wgid / nig, fm = gid * WGM, gsz = (nM - fm) < WGM ? (nM - fm) : WGM;
        u.pm = fm + ((wgid % nig) % gsz); u.pn = (wgid % nig) / gsz; return true;
    }
    __device__ __forceinline__ void a_ready(const Unit&) const {}
    __device__ __forceinline__ void done(const Unit&) const {}
};
struct InProjOrder {
    StaticOrder so; int G, c;
    __device__ void init(int G_, int c_) { so.init(MX, DIN, G_, c_); G = G_; c = c_; }
    __device__ bool next(int i, Unit& u) const {
        const long L = (long)i * G + c;
        if (L < so.nwg) return so.next(i, u);
        const int j = (int)(L - so.nwg); if (j >= 56) return false;
        u.pm = 128 + (j & 7); u.pn = j >> 3; return true;
    }
    __device__ __forceinline__ void a_ready(const Unit&) const {}
    __device__ __forceinline__ void done(const Unit&) const {}
};
struct ExpertOrder {
    int nPM, nPN, nwg, G, c;
    __device__ void init(int nE, int nPM_, int nPN_, int G_, int c_) { nPM = nPM_; nPN = nPN_; nwg = nE * nPM_ * nPN_; G = G_; c = c_; }
    __device__ bool next(int i, Unit& u) const {
        const long L = (long)i * G + c; if (L >= nwg) return false;
        const int wgid = xcd_remap((int)L, nwg);
        const int per = nPM * nPN, e = wgid / per, r = wgid % per;
        u.pm = e * nPM + (r % nPM); u.pn = e * nPN + (r / nPM); return true;
    }
    __device__ __forceinline__ void a_ready(const Unit&) const {}
    __device__ __forceinline__ void done(const Unit&) const {}
};

struct EpiBf16Plain {
    static constexpr bool PERM = true, AFTER_DRAIN = false;
    bf16_t* O; int ldc;
    __device__ __forceinline__ void operator()(const f32x4 (&acc)[2][2][4][2], const Unit& u, int wr, int wc, int fr, int fq) const {
        const int row0 = u.pm * BM + wr * 64 + fr, col0 = u.pn * BM + wc * 32 + 8 * fq;
#pragma unroll
        for (int ai = 0; ai < 2; ++ai)
#pragma unroll
            for (int m = 0; m < 4; ++m) { bf16_t* rowp = O + (size_t)(row0 + ai * HALF + m * 16) * ldc + col0;
#pragma unroll
                for (int bj = 0; bj < 2; ++bj) { const f32x4 v0 = acc[ai][bj][m][0], v1 = acc[ai][bj][m][1];
                    u32x4 w; w.x = pk2(v0[0], v0[1]); w.y = pk2(v0[2], v0[3]); w.z = pk2(v1[0], v1[1]); w.w = pk2(v1[2], v1[3]);
                    *(u32x4*)(rowp + bj * HALF) = w; } }
    }
};
struct EpiResid {
    static constexpr bool PERM = false, AFTER_DRAIN = false;
    const float* x; float* X1; const float* mod;
    __device__ __forceinline__ void operator()(const f32x4 (&acc)[2][2][4][2], const Unit& u, int wr, int wc, int fr, int fq) const {
        const int row0 = u.pm * BM + wr * 64 + fr, col0 = u.pn * BM + wc * 32 + 4 * fq;
        const float* g1 = mod + (size_t)(u.pm >> 4) * 6144 + 2048;
        f32x4 gv[2][2];
#pragma unroll
        for (int bj = 0; bj < 2; ++bj)
#pragma unroll
            for (int n = 0; n < 2; ++n) gv[bj][n] = *(const f32x4*)(g1 + col0 + bj * HALF + n * 16);
#pragma unroll
        for (int ai = 0; ai < 2; ++ai)
#pragma unroll
            for (int m = 0; m < 4; ++m) { const size_t off = (size_t)(row0 + ai * HALF + m * 16) * D + col0;
#pragma unroll
                for (int bj = 0; bj < 2; ++bj)
#pragma unroll
                    for (int n = 0; n < 2; ++n) { const f32x4 xv = *(const f32x4*)(x + off + bj * HALF + n * 16);
                        *(f32x4*)(X1 + off + bj * HALF + n * 16) = xv + gv[bj][n] * acc[ai][bj][m][n]; } }
    }
};
struct EpiSwiGLU {
    static constexpr bool PERM = true, AFTER_DRAIN = false;
    bf16_t* H;
    __device__ __forceinline__ void operator()(const f32x4 (&acc)[2][2][4][2], const Unit& u, int wr, int wc, int fr, int fq) const {
        const int row0 = u.pm * BM + wr * 64 + fr, col0 = (u.pn & 7) * 128 + wc * 32 + 8 * fq;
#pragma unroll
        for (int ai = 0; ai < 2; ++ai)
#pragma unroll
            for (int m = 0; m < 4; ++m) { float h[8];
#pragma unroll
                for (int n = 0; n < 2; ++n)
#pragma unroll
                    for (int q = 0; q < 4; ++q) { const float g = acc[ai][0][m][n][q], up = acc[ai][1][m][n][q]; h[n * 4 + q] = g / (1.f + __expf(-g)) * up; }
                u32x4 w; w.x = pk2(h[0], h[1]); w.y = pk2(h[2], h[3]); w.z = pk2(h[4], h[5]); w.w = pk2(h[6], h[7]);
                *(u32x4*)(H + (size_t)(row0 + ai * HALF + m * 16) * DE + col0) = w; }
    }
};
struct EpiDown {
    static constexpr bool PERM = true, AFTER_DRAIN = false;
    bf16_t* O; const float* val; const float* mod;
    __device__ __forceinline__ void operator()(const f32x4 (&acc)[2][2][4][2], const Unit& u, int wr, int wc, int fr, int fq) const {
        const int row0 = u.pm * BM + wr * 64 + fr, col0 = (u.pn & 3) * BM + wc * 32 + 8 * fq;
        const int b = (u.pm & 15) >> 1;
        const float* g2 = mod + (size_t)b * 6144 + 5120;
        f32x4 gv[2][2];
#pragma unroll
        for (int bj = 0; bj < 2; ++bj)
#pragma unroll
            for (int n = 0; n < 2; ++n) gv[bj][n] = *(const f32x4*)(g2 + col0 + bj * HALF + n * 4);
#pragma unroll
        for (int ai = 0; ai < 2; ++ai)
#pragma unroll
            for (int m = 0; m < 4; ++m) { const int row = row0 + ai * HALF + m * 16; const float vv = val[row]; bf16_t* rowp = O + (size_t)row * D + col0;
#pragma unroll
                for (int bj = 0; bj < 2; ++bj) { const f32x4 v0 = acc[ai][bj][m][0] * gv[bj][0] * vv, v1 = acc[ai][bj][m][1] * gv[bj][1] * vv;
                    u32x4 w; w.x = pk2(v0[0], v0[1]); w.y = pk2(v0[2], v0[3]); w.z = pk2(v1[0], v1[1]); w.w = pk2(v1[2], v1[3]);
                    *(u32x4*)(rowp + bj * HALF) = w; } }
    }
};

template <class Epi, class Sched, bool ALIGN_EPI = false, bool SP2 = false>
__device__ __forceinline__ void gemm_phase(PG8_LAS unsigned char* lds, const Gemm g, const Sched& S, const Epi& E) {
    const int tid = threadIdx.x, wid = __builtin_amdgcn_readfirstlane(tid >> 6), lane = tid & 63, wr = wid >> 2, wc = wid & 3, fr = lane & 15, fq = lane >> 4;
    const int K = g.K, nt = K / BK;
    unsigned voffA[2], voffB[2];
#pragma unroll
    for (int i = 0; i < 2; ++i) { int R, C; stage_rc(tid * 16 + i * 8192, R, C); const int Rb = Epi::PERM ? ((R & ~31) + perm32(R & 31)) : R;
        voffA[i] = (unsigned)(R * K + C) * 2u; voffB[i] = (unsigned)(Rb * K + C) * 2u; }
    const size_t kstep = (size_t)(BK * 2);
    const size_t hstep = (size_t)HALF * K * 2;
    const size_t tstep = 2 * hstep;
    const unsigned ldsw = (unsigned)wid * 1024u;
    const int aoff = lds_byte(wr * 64 + fr, fq * 8), boff = lds_byte(wc * 32 + fr, fq * 8);
#define PG8_SA(b, h) (((b) * 2 + (h)) * HTB)
#define PG8_SB(b, h) ((4 + (b) * 2 + (h)) * HTB)
#define PG8_STAGE(bufoff, gbase, voff) do { _Pragma("unroll") for (int _i = 0; _i < 2; ++_i) \
        __builtin_amdgcn_global_load_lds((const unsigned*)((const char*)(gbase) + (voff)[_i]), (PG8_LAS unsigned*)(lds + (bufoff) + ldsw + _i * 8192), 16, 0, 0); } while (0)
#define PG8_LDA(dst, b, h) do { _Pragma("unroll") for (int m = 0; m < 4; ++m) _Pragma("unroll") for (int k = 0; k < 2; ++k) dst[m][k] = *(const PG8_LAS bf16x8*)(lds + PG8_SA(b, h) + aoff + m * 2048 + k * 1024); } while (0)
#define PG8_LDB(dst, b, h) do { _Pragma("unroll") for (int n = 0; n < 2; ++n) _Pragma("unroll") for (int k = 0; k < 2; ++k) dst[n][k] = *(const PG8_LAS bf16x8*)(lds + PG8_SB(b, h) + boff + n * 2048 + k * 1024); } while (0)
#define PG8_MMA(ai, bj, At, Bt) do { __builtin_amdgcn_s_setprio(1); _Pragma("unroll") for (int m = 0; m < 4; ++m) _Pragma("unroll") for (int n = 0; n < 2; ++n) _Pragma("unroll") for (int k = 0; k < 2; ++k) \
        acc[ai][bj][m][n] = __builtin_amdgcn_mfma_f32_16x16x32_bf16(Bt[n][k], At[m][k], acc[ai][bj][m][n], 0, 0, 0); __builtin_amdgcn_s_setprio(0); } while (0)
#define PG8_WAIT_V(n) asm volatile("s_waitcnt vmcnt(" #n ")" ::: "memory")
#define PG8_WAIT_L(n) asm volatile("s_waitcnt lgkmcnt(" #n ")" ::: "memory")
#define PG8_BAR __builtin_amdgcn_s_barrier()
#define PG8_SCHED __builtin_amdgcn_sched_barrier(0)
    Unit cur, nxt; int ui = 0;
    if (!S.next(0, cur)) return;
    f32x4 acc[2][2][4][2];
#pragma unroll
    for (int a = 0; a < 2; ++a)
#pragma unroll
        for (int b = 0; b < 2; ++b)
#pragma unroll
            for (int m = 0; m < 4; ++m)
#pragma unroll
                for (int n = 0; n < 2; ++n) acc[a][b][m][n] = (f32x4){0.f, 0.f, 0.f, 0.f};
    bf16x8 At[4][2], B0[2][2], B1[2][2];
    const char* cA = (const char*)g.A + (size_t)cur.pm * tstep; const char* cB = (const char*)g.Bt + (size_t)cur.pn * tstep;
    S.a_ready(cur);
    if constexpr (SP2) {
        PG8_STAGE(PG8_SB(0, 0), cB, voffB); PG8_STAGE(PG8_SB(0, 1), cB + hstep, voffB); PG8_STAGE(PG8_SA(0, 0), cA, voffA); PG8_STAGE(PG8_SA(0, 1), cA + hstep, voffA);
        if (wr == 1) PG8_BAR;
        PG8_WAIT_V(2); PG8_BAR;
        PG8_STAGE(PG8_SB(1, 0), cB + kstep, voffB); PG8_STAGE(PG8_SA(1, 0), cA + kstep, voffA); PG8_STAGE(PG8_SB(1, 1), cB + hstep + kstep, voffB);
        PG8_WAIT_V(6); PG8_BAR;
    } else {
        PG8_STAGE(PG8_SB(0, 0), cB, voffB); PG8_STAGE(PG8_SA(0, 0), cA, voffA); PG8_STAGE(PG8_SB(0, 1), cB + hstep, voffB); PG8_STAGE(PG8_SA(0, 1), cA + hstep, voffA);
        if (wr == 1) PG8_BAR;
        PG8_WAIT_V(4); PG8_BAR;
        PG8_STAGE(PG8_SB(1, 0), cB + kstep, voffB); PG8_STAGE(PG8_SA(1, 0), cA + kstep, voffA); PG8_STAGE(PG8_SB(1, 1), cB + hstep + kstep, voffB);
        PG8_WAIT_V(6); PG8_BAR;
    }
    for (;;) {
        const bool has_next = S.next(ui + 1, nxt);
        const char* nA = has_next ? (const char*)g.A + (size_t)nxt.pm * tstep : cA; const char* nB = has_next ? (const char*)g.Bt + (size_t)nxt.pn * tstep : cB;
        for (int t = 0; t < nt; t += 2) {
            const bool last = (t == nt - 2);
            const char* a1 = cA + (size_t)(t + 1) * kstep;
            const char* a2 = last ? nA : cA + (size_t)(t + 2) * kstep; const char* b2 = last ? nB : cB + (size_t)(t + 2) * kstep;
            const char* a3 = a2 + kstep; const char* b3 = b2 + kstep;
            if (last && has_next) S.a_ready(nxt);
            if constexpr (SP2) {
            PG8_LDB(B0, 0, 0); PG8_LDB(B1, 0, 1); PG8_SCHED; PG8_LDA(At, 0, 0); PG8_STAGE(PG8_SA(1, 1), a1 + hstep, voffA);
            PG8_WAIT_V(8); PG8_WAIT_L(0); PG8_BAR; PG8_MMA(0, 0, At, B0); PG8_MMA(0, 1, At, B1); PG8_BAR; PG8_SCHED;
            PG8_LDA(At, 0, 1); PG8_STAGE(PG8_SB(0, 0), b2, voffB); PG8_STAGE(PG8_SB(0, 1), b2 + hstep, voffB); PG8_STAGE(PG8_SA(0, 0), a2, voffA);
            PG8_WAIT_V(8); PG8_WAIT_L(0); PG8_BAR; PG8_MMA(1, 0, At, B0); PG8_MMA(1, 1, At, B1); PG8_BAR; PG8_SCHED;
            PG8_LDB(B0, 1, 0); PG8_LDB(B1, 1, 1); PG8_SCHED; PG8_LDA(At, 1, 0); PG8_STAGE(PG8_SA(0, 1), a2 + hstep, voffA);
            PG8_WAIT_V(8); PG8_WAIT_L(0); PG8_BAR; PG8_MMA(0, 0, At, B0); PG8_MMA(0, 1, At, B1); PG8_BAR; PG8_SCHED;
            PG8_LDA(At, 1, 1); PG8_STAGE(PG8_SB(1, 0), b3, voffB); PG8_STAGE(PG8_SB(1, 1), b3 + hstep, voffB); PG8_STAGE(PG8_SA(1, 0), a3, voffA);
            PG8_WAIT_V(8); PG8_WAIT_L(0); PG8_BAR; PG8_MMA(1, 0, At, B0); PG8_MMA(1, 1, At, B1); PG8_BAR; PG8_SCHED;
            } else {
            PG8_LDB(B0, 0, 0); PG8_SCHED; PG8_LDA(At, 0, 0); PG8_STAGE(PG8_SA(1, 1), a1 + hstep, voffA);
            PG8_WAIT_L(8); PG8_BAR; PG8_WAIT_L(0); PG8_MMA(0, 0, At, B0); PG8_BAR; PG8_SCHED;
            PG8_LDB(B1, 0, 1); PG8_STAGE(PG8_SB(0, 0), b2, voffB);
            PG8_BAR; PG8_WAIT_L(0); PG8_MMA(0, 1, At, B1); PG8_BAR;
            PG8_LDA(At, 0, 1); PG8_STAGE(PG8_SA(0, 0), a2, voffA);
            PG8_BAR; PG8_WAIT_L(0); PG8_MMA(1, 0, At, B0); PG8_BAR; PG8_SCHED;
            PG8_STAGE(PG8_SB(0, 1), b2 + hstep, voffB);
            PG8_WAIT_V(6); PG8_BAR; PG8_MMA(1, 1, At, B1); PG8_BAR;
            PG8_LDB(B0, 1, 0); PG8_SCHED; PG8_LDA(At, 1, 0); PG8_STAGE(PG8_SA(0, 1), a2 + hstep, voffA);
            PG8_WAIT_L(8); PG8_BAR; PG8_WAIT_L(0); PG8_MMA(0, 0, At, B0); PG8_BAR; PG8_SCHED;
            PG8_LDB(B1, 1, 1); PG8_STAGE(PG8_SB(1, 0), b3, voffB);
            PG8_BAR; PG8_WAIT_L(0); PG8_MMA(0, 1, At, B1); PG8_BAR;
            PG8_LDA(At, 1, 1); PG8_STAGE(PG8_SA(1, 0), a3, voffA);
            PG8_BAR; PG8_WAIT_L(0); PG8_MMA(1, 0, At, B0); PG8_BAR; PG8_SCHED;
            PG8_STAGE(PG8_SB(1, 1), b3 + hstep, voffB);
            PG8_WAIT_V(6); PG8_BAR; PG8_MMA(1, 1, At, B1); PG8_BAR;
            }
        }
        if constexpr (ALIGN_EPI) { if (wr == 0) PG8_BAR; }
        if constexpr (!Epi::AFTER_DRAIN) { E(acc, cur, wr, wc, fr, fq); S.done(cur); }
        if (!has_next) break;
#pragma unroll
        for (int a = 0; a < 2; ++a)
#pragma unroll
            for (int b = 0; b < 2; ++b)
#pragma unroll
                for (int m = 0; m < 4; ++m)
#pragma unroll
                    for (int n = 0; n < 2; ++n) acc[a][b][m][n] = (f32x4){0.f, 0.f, 0.f, 0.f};
        cur = nxt; cA = nA; cB = nB; ++ui;
        if constexpr (ALIGN_EPI) { if (wr == 1) PG8_BAR; }
    }
    PG8_WAIT_V(0);
    if constexpr (!ALIGN_EPI) { if (wr == 0) PG8_BAR; }
    PG8_BAR;
#undef PG8_SA
#undef PG8_SB
#undef PG8_STAGE
#undef PG8_LDA
#undef PG8_LDB
#undef PG8_MMA
#undef PG8_WAIT_V
#undef PG8_WAIT_L
#undef PG8_BAR
#undef PG8_SCHED
}
}

#define LDS_WAIT() asm volatile("s_waitcnt lgkmcnt(0)" ::: "memory")

__device__ __forceinline__ void p0_transpose_item(const float* W, int K, int N, bf16_t* WT, int mode, LAS float* scr, int item, int lane) {
    const int nblk = N / 32, kb = item / nblk, nb = item % nblk, k0 = 64 * kb, n0 = 32 * nb;
    const int rbase = mode == 0 ? n0 : ((n0 >> 7) * 256 + (n0 & 127) + (mode == 2 ? 128 : 0));
#pragma unroll 8
    for (int i = 0; i < 32; ++i) { const int kk = 2 * i + (lane >> 5); scr[kk * 33 + (lane & 31)] = W[(size_t)(k0 + kk) * N + n0 + (lane & 31)]; }
    LDS_WAIT(); asm volatile("" ::: "memory");
    const int c = lane & 7;
#pragma unroll
    for (int j = 0; j < 4; ++j) { const int n = (lane >> 3) + 8 * j; const LAS float* s = scr + (8 * c) * 33 + n;
        u32x4 o; o.x = pk2(s[0 * 33], s[1 * 33]); o.y = pk2(s[2 * 33], s[3 * 33]); o.z = pk2(s[4 * 33], s[5 * 33]); o.w = pk2(s[6 * 33], s[7 * 33]);
        *(u32x4*)(WT + (size_t)(rbase + n) * K + k0 + 8 * c) = o; }
    LDS_WAIT(); asm volatile("" ::: "memory");
}

__device__ __forceinline__ void phase0(const Params& p, LAS unsigned char* lds, int bid, int G) {
    const int tid = threadIdx.x, lane = tid & 63, wave = tid >> 6;
    unsigned char* ws = p.ws;
    if (bid < 96) {
        LAS float* sc = (LAS float*)lds;
        LAS float* part = sc + 9 * 1024;
        const float* c = p.in[1]; const float* cctx = p.in[3]; const float* ada_w = p.in[4]; const float* ada_b = p.in[5];
        float* MOD = (float*)(ws + WS_MOD);
        for (int i = tid; i < 9 * 1024; i += NTHR) { const int r = i >> 10, k = i & 1023; const float v = r < 8 ? c[r * 1024 + k] : cctx[k]; sc[i] = v / (1.f + expf(-v)); }
        __syncthreads();
        for (int it = bid; it < 96; it += G) {
            const int col = tid & 63, kg = tid >> 6;
            float acc[9];
#pragma unroll
            for (int r = 0; r < 9; ++r) acc[r] = 0.f;
            const float* w = ada_w + (size_t)(kg * 128) * 6144 + it * 64 + col;
#pragma unroll 4
            for (int k = 0; k < 128; ++k) { const float wv = w[(size_t)k * 6144];
#pragma unroll
                for (int r = 0; r < 9; ++r) acc[r] += sc[r * 1024 + kg * 128 + k] * wv; }
#pragma unroll
            for (int r = 0; r < 9; ++r) part[(kg * 9 + r) * 64 + col] = acc[r];
            __syncthreads();
            for (int o = tid; o < 576; o += NTHR) { const int r = o >> 6, cc = o & 63; float s = ada_b[it * 64 + cc];
#pragma unroll
                for (int q = 0; q < 8; ++q) s += part[(q * 9 + r) * 64 + cc];
                MOD[r * 6144 + it * 64 + cc] = s; }
            __syncthreads();
        }
    }
    {
        LAS float* scr = (LAS float*)(lds + wave * 16384);
        const int vcu = (G % 8 == 0) ? (bid % 8) * (G / 8) + bid / 8 : bid;
        const int gw = vcu * NWAVES + wave, NGW = G * NWAVES;
        constexpr int I_IN = 16 * (DIN / 32), I_OUT = 16 * 32, I_E = 16 * 32;
        constexpr int NITEMS = I_IN + I_OUT + 3 * NE * I_E;
        for (int it = gw; it < NITEMS; it += NGW) {
            int r = it;
            if (r < I_IN) { p0_transpose_item(p.in[8], D, DIN, (bf16_t*)(ws + WS_WINT), 0, scr, r, lane); continue; } r -= I_IN;
            if (r < I_OUT) { p0_transpose_item(p.in[21], D, D, (bf16_t*)(ws + WS_WOUTT), 0, scr, r, lane); continue; } r -= I_OUT;
            const int which = r / (NE * I_E); r -= which * (NE * I_E);
            const int e = r / I_E; r -= e * I_E;
            if (which == 0) p0_transpose_item(p.in[23] + (size_t)e * D * DE, D, DE, (bf16_t*)(ws + WS_W1T) + (size_t)e * 2048 * 1024, 1, scr, r, lane);
            else if (which == 1) p0_transpose_item(p.in[24] + (size_t)e * D * DE, D, DE, (bf16_t*)(ws + WS_W1T) + (size_t)e * 2048 * 1024, 2, scr, r, lane);
            else p0_transpose_item(p.in[25] + (size_t)e * DE * D, DE, D, (bf16_t*)(ws + WS_W2T) + (size_t)e * 1024 * 1024, 0, scr, r, lane);
        }
    }
}

__device__ __forceinline__ void phase1(const Params& p, int bid, int G) {
    const int tid = threadIdx.x, lane = tid & 63, wave = tid >> 6;
    const int gw = bid * NWAVES + wave, NGW = G * NWAVES;
    const float* MOD = (const float*)(p.ws + WS_MOD); const float* n1g = p.in[6];
    bf16_t* XN = (bf16_t*)(p.ws + WS_XN);
    for (int m = gw; m < MALL; m += NGW) {
        const float* src; int mr;
        if (m < MX) { src = p.in[0] + (size_t)m * D; mr = m >> 12; } else { src = p.in[2] + (size_t)(m - MX) * D; mr = 8; }
        const float* sh = MOD + (size_t)mr * 6144; const float* scp = sh + 1024;
        f32x4 v[4]; float ss = 0.f;
#pragma unroll
        for (int j = 0; j < 4; ++j) { v[j] = ((const f32x4*)src)[lane + 64 * j]; ss += (v[j].x * v[j].x + v[j].y * v[j].y) + (v[j].z * v[j].z + v[j].w * v[j].w); }
        const float rstd = rsqrtf(wave_sum(ss) * (1.f / D) + 1e-6f);
#pragma unroll
        for (int j = 0; j < 4; ++j) { const int col = 4 * (lane + 64 * j);
            const f32x4 g = *(const f32x4*)(n1g + col), s = *(const f32x4*)(scp + col), h = *(const f32x4*)(sh + col);
            const f32x4 y = v[j] * rstd * g * (s + 1.f) + h;
            u32x2 o; o.x = pk2(y.x, y.y); o.y = pk2(y.z, y.w);
            *(u32x2*)(XN + (size_t)m * D + col) = o; }
    }
}

constexpr int L_RR = 0, L_KD = 16384, L_VV = 32768, L_AA = 49152, L_BB = 65536, L_WW = 81920;
constexpr int L_XW = 49152, L_XA = 49152 + 17408;
constexpr int L_WUP = 98304, L_AUP = 114688, L_YB = 131072;

__device__ __forceinline__ void lerp8(const bf16_t* PX, int row, const int (&nbr)[4], bool isctx, int cb, const float* mu, float (&out)[8]) {
    float s[8], n0[8], n1[8], n2[8], n3[8];
    const u32x4 z = (u32x4){0u, 0u, 0u, 0u};
    unpack8(*(const u32x4*)(PX + (size_t)row * DIN + cb), s);
    unpack8(nbr[0] >= 0 ? *(const u32x4*)(PX + (size_t)nbr[0] * DIN + cb) : z, n0);
    unpack8(nbr[1] >= 0 ? *(const u32x4*)(PX + (size_t)nbr[1] * DIN + cb) : z, n1);
    if (!isctx) {
        unpack8(nbr[2] >= 0 ? *(const u32x4*)(PX + (size_t)nbr[2] * DIN + cb) : z, n2);
        unpack8(nbr[3] >= 0 ? *(const u32x4*)(PX + (size_t)nbr[3] * DIN + cb) : z, n3);
    }
    const f32x4 m0 = *(const f32x4*)(mu + cb), m1 = *(const f32x4*)(mu + cb + 4);
    const float mv[8] = {m0.x, m0.y, m0.z, m0.w, m1.x, m1.y, m1.z, m1.w};
#pragma unroll
    for (int e = 0; e < 8; ++e) {
        float sv;
        if (isctx) sv = (e & 1) ? n1[e] : n0[e];
        else sv = (e & 3) == 0 ? n0[e] : (e & 3) == 1 ? n1[e] : (e & 3) == 2 ? n2[e] : n3[e];
        out[e] = s[e] + mv[e] * (sv - s[e]);
    }
}
__device__ __forceinline__ void neighbours(int t, bool isctx, int rowbase, int (&nbr)[4]) {
    if (isctx) { nbr[0] = t > 0 ? rowbase + t - 1 : -1; nbr[1] = t < CTXL - 1 ? rowbase + t + 1 : -1; nbr[2] = -1; nbr[3] = -1; }
    else { const int cg_ = t & 63, rg = t >> 6;
        nbr[0] = cg_ > 0 ? rowbase + t - 1 : -1; nbr[1] = cg_ < 63 ? rowbase + t + 1 : -1; nbr[2] = rg > 0 ? rowbase + t - 64 : -1; nbr[3] = rg < 63 ? rowbase + t + 64 : -1; }
}

__device__ __forceinline__ void prep_chunk(const Params& p, LAS unsigned char* lds, int b, int h, int dir, bool isctx, int c) {
    const int tid = threadIdx.x, j = tid >> 3, sub = tid & 7, k0 = sub * 8;
    const bf16_t* PX = (const bf16_t*)(p.ws + WS_PX);
    const int L = isctx ? CTXL : T, rowbase = isctx ? MX + b * CTXL : b * T;
    const int pos = 64 * c + j, t = dir ? (L - 1 - pos) : pos;
    int nbr[4]; neighbours(t, isctx, rowbase, nbr);
    const float* mu = p.in[9];
    LAS float* RR = (LAS float*)(lds + L_RR); LAS float* KD = (LAS float*)(lds + L_KD); LAS float* VV = (LAS float*)(lds + L_VV);
    LAS float* AA = (LAS float*)(lds + L_AA); LAS float* BB = (LAS float*)(lds + L_BB); LAS float* WW = (LAS float*)(lds + L_WW);
    LAS float* XW = (LAS float*)(lds + L_XW); LAS float* XA = (LAS float*)(lds + L_XA);
    const LAS float* WUP = (const LAS float*)(lds + L_WUP); const LAS float* AUP = (const LAS float*)(lds + L_AUP);
    float r[8], k[8];
    { float v[8]; lerp8(PX, rowbase + t, nbr, isctx, 1024 + h * 64 + k0, mu, v);
#pragma unroll
      for (int e = 0; e < 8; ++e) VV[j * 64 + k0 + e] = v[e]; }
    asm volatile("" ::: "memory");
    { float xw[8]; lerp8(PX, rowbase + t, nbr, isctx, 1536 + k0, mu, xw);
#pragma unroll
      for (int e = 0; e < 8; ++e) XW[j * 68 + k0 + e] = tanhf(xw[e]); }
    asm volatile("" ::: "memory");
    { float xa[8]; lerp8(PX, rowbase + t, nbr, isctx, 1600 + k0, mu, xa);
#pragma unroll
      for (int e = 0; e < 8; ++e) XA[j * 68 + k0 + e] = xa[e]; }
    asm volatile("" ::: "memory");
    lerp8(PX, rowbase + t, nbr, isctx, h * 64 + k0, mu, r);
#pragma unroll
    for (int e = 0; e < 8; ++e) RR[j * 64 + k0 + e] = r[e];
    asm volatile("" ::: "memory");
    lerp8(PX, rowbase + t, nbr, isctx, 512 + h * 64 + k0, mu, k);
    __syncthreads();
    float dw[8], da[8];
#pragma unroll
    for (int e = 0; e < 8; ++e) { dw[e] = 0.f; da[e] = 0.f; }
#pragma unroll 1
    for (int m = 0; m < 64; m += 4) {
        const f32x4 tw4 = *(const LAS f32x4*)(XW + j * 68 + m), xa4 = *(const LAS f32x4*)(XA + j * 68 + m);
#pragma unroll
        for (int q = 0; q < 4; ++q) {
            const f32x4 w0 = *(const LAS f32x4*)(WUP + (m + q) * 64 + k0), w1 = *(const LAS f32x4*)(WUP + (m + q) * 64 + k0 + 4);
            const f32x4 a0 = *(const LAS f32x4*)(AUP + (m + q) * 64 + k0), a1 = *(const LAS f32x4*)(AUP + (m + q) * 64 + k0 + 4);
            const float tv = tw4[q], av = xa4[q];
            dw[0] += tv * w0.x; dw[1] += tv * w0.y; dw[2] += tv * w0.z; dw[3] += tv * w0.w; dw[4] += tv * w1.x; dw[5] += tv * w1.y; dw[6] += tv * w1.z; dw[7] += tv * w1.w;
            da[0] += av * a0.x; da[1] += av * a0.y; da[2] += av * a0.z; da[3] += av * a0.w; da[4] += av * a1.x; da[5] += av * a1.y; da[6] += av * a1.z; da[7] += av * a1.w;
        }
    }
    __syncthreads();
    const int hc = h * 64 + k0;
    const float* w0p = p.in[10] + dir * DR + hc; const float* a0p = p.in[12] + dir * DR + hc;
    const float* kkp = p.in[14] + hc; const float* kap = p.in[15] + hc; const float* rkp = p.in[16] + hc;
    float kk[8], ss = 0.f, bd = 0.f, kd[8], as[8], wv[8];
#pragma unroll
    for (int e = 0; e < 8; ++e) {
        kk[e] = k[e] * kkp[e]; ss += kk[e] * kk[e];
        const float z = w0p[e] + dw[e];
        const float sp = (-z > 20.f) ? -z : log1pf(expf(-z));
        const float wl = -sp - 0.5f;
        wv[e] = expf(-expf(wl));
        as[e] = sigmoidf_(a0p[e] + da[e]);
        kd[e] = k[e] * (1.f + (as[e] - 1.f) * kap[e]);
        bd += r[e] * kd[e] * rkp[e];
    }
    ss = red8(ss); bd = red8(bd);
    const float inv = 1.f / fmaxf(sqrtf(ss), 1e-12f);
#pragma unroll
    for (int e = 0; e < 8; ++e) { const float kn = kk[e] * inv; KD[j * 64 + k0 + e] = kd[e]; AA[j * 64 + k0 + e] = -kn; BB[j * 64 + k0 + e] = kn * as[e]; WW[j * 64 + k0 + e] = wv[e]; }
    if (!isctx && sub == 0) ((float*)(p.ws + WS_BDOT))[((size_t)dir * MX + rowbase + t) * NH + h] = bd;
    __syncthreads();
}

__device__ __forceinline__ void phase_scan_naive(const Params& p, LAS unsigned char* lds, int bid, int G) {
    const int tid = threadIdx.x, vrow = tid >> 3, sub = tid & 7, k0 = sub * 8;
    bf16_t* Y = (bf16_t*)(p.ws + WS_Y);
    for (int item = bid; item < NB * NH * 2; item += G) {
        const int dir = item & 1, h = (item >> 1) & 7, b = item >> 4;
        __syncthreads();
        { LAS float* WUP = (LAS float*)(lds + L_WUP); LAS float* AUP = (LAS float*)(lds + L_AUP);
          const float* wu = p.in[11] + (size_t)dir * 64 * DR + h * 64; const float* au = p.in[13] + (size_t)dir * 64 * DR + h * 64;
          for (int i = tid; i < 4096; i += NTHR) { const int m = i >> 6, kc = i & 63; WUP[i] = wu[(size_t)m * DR + kc]; AUP[i] = au[(size_t)m * DR + kc]; } }
        __syncthreads();
        float s[8];
#pragma unroll
        for (int e = 0; e < 8; ++e) s[e] = 0.f;
        for (int ci = 0; ci < 68; ++ci) {
            const bool isctx = ci < 4; const int c = isctx ? ci : ci - 4;
            prep_chunk(p, lds, b, h, dir, isctx, c);
            const LAS float* RR = (const LAS float*)(lds + L_RR); const LAS float* KD = (const LAS float*)(lds + L_KD); const LAS float* VV = (const LAS float*)(lds + L_VV);
            const LAS float* AA = (const LAS float*)(lds + L_AA); const LAS float* BB = (const LAS float*)(lds + L_BB); const LAS float* WW = (const LAS float*)(lds + L_WW);
            LAS float* YB = (LAS float*)(lds + L_YB);
#pragma unroll 2
            for (int j = 0; j < 64; ++j) {
                const int o = j * 64 + k0;
                const f32x4 a0 = *(const LAS f32x4*)(AA + o), a1 = *(const LAS f32x4*)(AA + o + 4);
                const f32x4 b0 = *(const LAS f32x4*)(BB + o), b1 = *(const LAS f32x4*)(BB + o + 4);
                const f32x4 w0 = *(const LAS f32x4*)(WW + o), w1 = *(const LAS f32x4*)(WW + o + 4);
                const f32x4 q0 = *(const LAS f32x4*)(KD + o), q1 = *(const LAS f32x4*)(KD + o + 4);
                const f32x4 r0 = *(const LAS f32x4*)(RR + o), r1 = *(const LAS f32x4*)(RR + o + 4);
                const float vv = VV[j * 64 + vrow];
                float sa = (s[0] * a0.x + s[1] * a0.y) + (s[2] * a0.z + s[3] * a0.w) + (s[4] * a1.x + s[5] * a1.y) + (s[6] * a1.z + s[7] * a1.w);
                sa = red8(sa);
                s[0] = s[0] * w0.x + (sa * b0.x + vv * q0.x); s[1] = s[1] * w0.y + (sa * b0.y + vv * q0.y); s[2] = s[2] * w0.z + (sa * b0.z + vv * q0.z); s[3] = s[3] * w0.w + (sa * b0.w + vv * q0.w);
                s[4] = s[4] * w1.x + (sa * b1.x + vv * q1.x); s[5] = s[5] * w1.y + (sa * b1.y + vv * q1.y); s[6] = s[6] * w1.z + (sa * b1.z + vv * q1.z); s[7] = s[7] * w1.w + (sa * b1.w + vv * q1.w);
                float y = (s[0] * r0.x + s[1] * r0.y) + (s[2] * r0.z + s[3] * r0.w) + (s[4] * r1.x + s[5] * r1.y) + (s[6] * r1.z + s[7] * r1.w);
                y = red8(y);
                if (sub == 0) YB[j * 64 + vrow] = y;
            }
            __syncthreads();
            if (!isctx) {
                const int jj = tid >> 3, pos = 64 * c + jj, t = dir ? (T - 1 - pos) : pos;
                float yv[8];
#pragma unroll
                for (int e = 0; e < 8; ++e) yv[e] = YB[jj * 64 + k0 + e];
                *(u32x4*)(Y + ((size_t)dir * MX + b * T + t) * DR + h * 64 + k0) = pack8(yv);
            }
            __syncthreads();
        }
    }
}

__device__ __forceinline__ void phase_out(const Params& p, LAS unsigned char* lds, int bid, int G) {
    const int tid = threadIdx.x, lane = tid & 63, wave = tid >> 6;
    const bf16_t* PX = (const bf16_t*)(p.ws + WS_PX); const bf16_t* Y = (const bf16_t*)(p.ws + WS_Y);
    const float* BDOT = (const float*)(p.ws + WS_BDOT);
    bf16_t* AX = (bf16_t*)(p.ws + WS_AX);
    LAS unsigned* GUP = (LAS unsigned*)lds;
    LAS float* SG = (LAS float*)(lds + 131072 + wave * 512);
    { const float* gu = p.in[17];
      for (int i = tid; i < 128 * 256; i += NTHR) { const float2 w = ((const float2*)gu)[i]; GUP[i] = pk2(w.x, w.y); } }
    __syncthreads();
    const float* mu = p.in[9];
    const int cb = lane * 8, h = lane >> 3;
    const int gw = bid * NWAVES + wave, NGW = G * NWAVES;
    for (int tok = gw; tok < MX; tok += NGW) {
        const int b = tok >> 12, t = tok & (T - 1), rowbase = b * T;
        int nbr[4]; neighbours(t, false, rowbase, nbr);
        float yf[8], yb[8], y[8];
        unpack8(*(const u32x4*)(Y + (size_t)tok * DR + cb), yf); unpack8(*(const u32x4*)(Y + ((size_t)MX + tok) * DR + cb), yb);
        float s1 = 0.f;
#pragma unroll
        for (int e = 0; e < 8; ++e) { y[e] = yf[e] + yb[e]; s1 += y[e]; }
        const float mean = red8(s1) * (1.f / 64.f);
        float s2 = 0.f;
#pragma unroll
        for (int e = 0; e < 8; ++e) { y[e] -= mean; s2 += y[e] * y[e]; }
        const float rstd = rsqrtf(red8(s2) * (1.f / 64.f) + 64e-5f);
        float v[8]; lerp8(PX, tok, nbr, false, 1024 + cb, mu, v);
        const float bd = BDOT[(size_t)tok * NH + h] + BDOT[((size_t)MX + tok) * NH + h];
        if (lane < 16) { float xg[8]; lerp8(PX, tok, nbr, false, 1664 + lane * 8, mu, xg);
#pragma unroll
            for (int e = 0; e < 8; ++e) SG[lane * 8 + e] = sigmoidf_(xg[e]); }
        LDS_WAIT(); asm volatile("" ::: "memory");
        float g[8];
#pragma unroll
        for (int e = 0; e < 8; ++e) g[e] = 0.f;
#pragma unroll 4
        for (int m = 0; m < 128; m += 4) {
            const f32x4 s4 = *(const LAS f32x4*)(SG + m);
#pragma unroll
            for (int q = 0; q < 4; ++q) { const u32x4 w = *(const LAS u32x4*)(GUP + (m + q) * 256 + lane * 4); const float sv = s4[q];
                g[0] += sv * bflo(w.x); g[1] += sv * bfhi(w.x); g[2] += sv * bflo(w.y); g[3] += sv * bfhi(w.y); g[4] += sv * bflo(w.z); g[5] += sv * bfhi(w.z); g[6] += sv * bflo(w.w); g[7] += sv * bfhi(w.w); }
        }
        float ax[8];
        { const f32x4 g0 = *(const f32x4*)(p.in[18] + cb), g1 = *(const f32x4*)(p.in[18] + cb + 4), b0 = *(const f32x4*)(p.in[19] + cb), b1 = *(const f32x4*)(p.in[19] + cb + 4);
          const float gng[8] = {g0.x, g0.y, g0.z, g0.w, g1.x, g1.y, g1.z, g1.w}, gnb[8] = {b0.x, b0.y, b0.z, b0.w, b1.x, b1.y, b1.z, b1.w};
#pragma unroll
          for (int e = 0; e < 8; ++e) ax[e] = (y[e] * rstd * gng[e] + gnb[e] + bd * v[e]) * g[e]; }
        asm volatile("" ::: "memory");
        *(u32x4*)(AX + (size_t)tok * D + cb) = pack8(ax);
        float bg[8], c0[8], u0[8], cm[8], um[8], cp[8], up[8];
        const u32x4 z = (u32x4){0u, 0u, 0u, 0u};
        const bf16_t* pr = PX + (size_t)tok * DIN + RWC + cb;
        unpack8(*(const u32x4*)pr, bg); unpack8(*(const u32x4*)(pr + 512), c0); unpack8(*(const u32x4*)(pr + 1024), u0);
        unpack8(t > 0 ? *(const u32x4*)(pr - DIN + 512) : z, cm); unpack8(t > 0 ? *(const u32x4*)(pr - DIN + 1024) : z, um);
        unpack8(t < T - 1 ? *(const u32x4*)(pr + DIN + 512) : z, cp); unpack8(t < T - 1 ? *(const u32x4*)(pr + DIN + 1024) : z, up);
        float bx[8];
        { const float* cwp = p.in[20] + cb;
          const f32x4 w00 = *(const f32x4*)(cwp), w01 = *(const f32x4*)(cwp + 4), w10 = *(const f32x4*)(cwp + DR), w11 = *(const f32x4*)(cwp + DR + 4), w20 = *(const f32x4*)(cwp + 2 * DR), w21 = *(const f32x4*)(cwp + 2 * DR + 4);
          const float cw0[8] = {w00.x, w00.y, w00.z, w00.w, w01.x, w01.y, w01.z, w01.w}, cw1[8] = {w10.x, w10.y, w10.z, w10.w, w11.x, w11.y, w11.z, w11.w}, cw2[8] = {w20.x, w20.y, w20.z, w20.w, w21.x, w21.y, w21.z, w21.w};
#pragma unroll
          for (int e = 0; e < 8; ++e) bx[e] = bg[e] * (cw0[e] * (cm[e] * um[e]) + cw1[e] * (c0[e] * u0[e]) + cw2[e] * (cp[e] * up[e])); }
        *(u32x4*)(AX + (size_t)tok * D + DR + cb) = pack8(bx);
        asm volatile("" ::: "memory");
    }
}

__device__ __forceinline__ void phase_hx(const Params& p, LAS unsigned char* lds, int bid, int G) {
    const int tid = threadIdx.x, lane = tid & 63, wave = tid >> 6;
    const float* X1 = (const float*)(p.ws + WS_X1); const float* MOD = (const float*)(p.ws + WS_MOD); const float* n2g = p.in[7];
    bf16_t* HX = (bf16_t*)(p.ws + WS_HX); float* AFF = (float*)(p.ws + WS_AFF);
    LAS float* RW = (LAS float*)lds;
    { const float* rw = p.in[22]; for (int i = tid; i < 1024 * 16; i += NTHR) RW[(i & 15) * 1024 + (i >> 4)] = rw[i]; }
    __syncthreads();
    const int gw = bid * NWAVES + wave, NGW = G * NWAVES;
    for (int tok = gw; tok < MX; tok += NGW) {
        const int b = tok >> 12, t = tok & (T - 1);
        const float* sh = MOD + (size_t)b * 6144 + 3072; const float* scp = sh + 1024;
        f32x4 v[4]; float ss = 0.f;
#pragma unroll
        for (int j = 0; j < 4; ++j) { v[j] = ((const f32x4*)(X1 + (size_t)tok * D))[lane + 64 * j]; ss += (v[j].x * v[j].x + v[j].y * v[j].y) + (v[j].z * v[j].z + v[j].w * v[j].w); }
        const float rstd = rsqrtf(wave_sum(ss) * (1.f / D) + 1e-6f);
        f32x4 yv[4];
#pragma unroll
        for (int j = 0; j < 4; ++j) { const int col = 4 * (lane + 64 * j);
            const f32x4 g = *(const f32x4*)(n2g + col), s = *(const f32x4*)(scp + col), hh = *(const f32x4*)(sh + col);
            const f32x4 y = v[j] * rstd * g * (s + 1.f) + hh; yv[j] = y;
            u32x2 o; o.x = pk2(y.x, y.y); o.y = pk2(y.z, y.w);
            *(u32x2*)(HX + (size_t)tok * D + col) = o; }
        float lg[16];
#pragma unroll
        for (int e = 0; e < 16; ++e) { float a = 0.f;
#pragma unroll
            for (int j = 0; j < 4; ++j) { const f32x4 w = *(const LAS f32x4*)(RW + e * 1024 + 4 * (lane + 64 * j)); const f32x4 y = yv[j];
                a += (y.x * w.x + y.y * w.y) + (y.z * w.z + y.w * w.w); }
            lg[e] = a;
            if ((e & 3) == 3) asm volatile("" ::: "memory"); }
        float mx = -3.0e38f;
#pragma unroll
        for (int e = 0; e < 16; ++e) { lg[e] = wave_sum(lg[e]); mx = fmaxf(mx, lg[e]); }
        float den = 0.f;
#pragma unroll
        for (int e = 0; e < 16; ++e) { lg[e] = expf(lg[e] - mx); den += lg[e]; }
        const float inv = 1.f / den;
        float mine = 0.f;
#pragma unroll
        for (int e = 0; e < 16; ++e) mine = (lane == e) ? lg[e] * inv : mine;
        if (lane < 16) AFF[((size_t)b * NE + lane) * T + t] = mine;
    }
}

__device__ __forceinline__ void phase_topk(const Params& p, LAS unsigned char* lds, int bid, int G) {
    const int tid = threadIdx.x;
    const float* AFF = (const float*)(p.ws + WS_AFF);
    int* IDX = (int*)(p.ws + WS_IDX); float* VAL = (float*)(p.ws + WS_VAL); int* SEL = (int*)(p.ws + WS_SEL);
    LAS unsigned long long* key = (LAS unsigned long long*)lds;
    for (int item = bid; item < NB * NE; item += G) {
        const int b = item >> 4, e = item & 15;
        __syncthreads();
        for (int i = tid; i < T; i += NTHR) { const unsigned bits = __float_as_uint(AFF[(size_t)item * T + i]); key[i] = ((unsigned long long)bits << 32) | (unsigned long long)(0xFFFFFFFFu - (unsigned)i); }
        __syncthreads();
        for (int k = 2; k <= T; k <<= 1)
            for (int jj = k >> 1; jj > 0; jj >>= 1) {
#pragma unroll
                for (int q = 0; q < 4; ++q) { const int pi = tid + q * NTHR; const int i = ((pi & ~(jj - 1)) << 1) | (pi & (jj - 1)), l = i | jj;
                    const unsigned long long a = key[i], c = key[l];
                    const bool desc = ((i & k) == 0);
                    if ((a < c) == desc) { key[i] = c; key[l] = a; } }
                __syncthreads();
            }
        for (int i = tid; i < T; i += NTHR) { const unsigned long long kv = key[i]; const int tok = (int)(0xFFFFFFFFu - (unsigned)(kv & 0xFFFFFFFFull));
            SEL[(size_t)item * T + tok] = i < CAP ? i : -1;
            if (i < CAP) { IDX[item * CAP + i] = tok; VAL[(e * NB + b) * CAP + i] = __uint_as_float((unsigned)(kv >> 32)); } }
    }
}

__device__ __forceinline__ void phase_gather(const Params& p, int bid, int G) {
    const int tid = threadIdx.x, lane = tid & 63, wave = tid >> 6;
    const bf16_t* HX = (const bf16_t*)(p.ws + WS_HX); bf16_t* XS = (bf16_t*)(p.ws + WS_XS); const int* IDX = (const int*)(p.ws + WS_IDX);
    const int gw = bid * NWAVES + wave, NGW = G * NWAVES;
    for (int r = gw; r < NE * NB * CAP; r += NGW) {
        const int e = r >> 12, b = (r >> 9) & 7, slot = r & 511;
        const int tok = IDX[(b * NE + e) * CAP + slot];
        const u32x4* src = (const u32x4*)(HX + ((size_t)b * T + tok) * D); u32x4* dst = (u32x4*)(XS + (size_t)r * D);
        dst[lane] = src[lane]; dst[lane + 64] = src[lane + 64];
    }
}

__device__ __forceinline__ void phase_final(const Params& p, int bid, int G) {
    const int tid = threadIdx.x, lane = tid & 63, wave = tid >> 6;
    const float* X1 = (const float*)(p.ws + WS_X1); const bf16_t* DN = (const bf16_t*)(p.ws + WS_DN); const int* SEL = (const int*)(p.ws + WS_SEL);
    const float* fg = p.in[26];
    const int gw = bid * NWAVES + wave, NGW = G * NWAVES;
    for (int tok = gw; tok < MX; tok += NGW) {
        const int b = tok >> 12, t = tok & (T - 1);
        f32x4 v[4];
#pragma unroll
        for (int j = 0; j < 4; ++j) v[j] = ((const f32x4*)(X1 + (size_t)tok * D))[lane + 64 * j];
        for (int e = 0; e < NE; ++e) {
            const int s = SEL[((size_t)b * NE + e) * T + t];
            if (s >= 0) { const bf16_t* row = DN + ((size_t)(e * NB + b) * CAP + s) * D;
#pragma unroll
                for (int j = 0; j < 4; ++j) { const u32x2 w = *(const u32x2*)(row + 4 * (lane + 64 * j)); v[j].x += bflo(w.x); v[j].y += bfhi(w.x); v[j].z += bflo(w.y); v[j].w += bfhi(w.y); } }
        }
        float ss = 0.f;
#pragma unroll
        for (int j = 0; j < 4; ++j) ss += (v[j].x * v[j].x + v[j].y * v[j].y) + (v[j].z * v[j].z + v[j].w * v[j].w);
        const float rstd = rsqrtf(wave_sum(ss) * (1.f / D) + 1e-6f);
#pragma unroll
        for (int j = 0; j < 4; ++j) { const int col = 4 * (lane + 64 * j); const f32x4 g = *(const f32x4*)(fg + col);
            *(f32x4*)(p.out + (size_t)tok * D + col) = v[j] * rstd * g; }
    }
}

constexpr int N_PHASES = 12;
__global__ void __launch_bounds__(NTHR, 2) mk_fwd(Params p) {
    extern __shared__ __attribute__((aligned(16))) unsigned char lds_raw[];
    LAS unsigned char* lds = (LAS unsigned char*)lds_raw;
    const int bid = blockIdx.x, G = gridDim.x;
    const int lo = p.ph_lo, hi = p.ph_hi;
#if MK_FUSED
    cg::grid_group grid = cg::this_grid();
#define SEAM(k) do { if (lo <= (k) && (k) + 1 < hi) grid.sync(); } while (0)
#else
#define SEAM(k) do { } while (0)
#endif
#ifndef PH_MASK
#define PH_MASK 0xFFF
#endif
#define IN(k) (((PH_MASK >> (k)) & 1) && lo <= (k) && (k) < hi)
    unsigned char* ws = p.ws;
    if (IN(0)) { phase0(p, lds, bid, G); SEAM(0); }
    if (IN(1)) { phase1(p, bid, G); SEAM(1); }
    if (IN(2)) {
        pg8::Gemm g{(const bf16_t*)(ws + WS_XN), (const bf16_t*)(ws + WS_WINT), MALL, DIN, D};
        pg8::InProjOrder S; S.init(G, bid);
        pg8::EpiBf16Plain E{(bf16_t*)(ws + WS_PX), DIN};
        pg8::gemm_phase<pg8::EpiBf16Plain, pg8::InProjOrder, true, true>(lds, g, S, E);
        SEAM(2);
    }
    if (IN(3)) { phase_scan_naive(p, lds, bid, G); SEAM(3); }
    if (IN(4)) { phase_out(p, lds, bid, G); SEAM(4); }
    if (IN(5)) {
        pg8::Gemm g{(const bf16_t*)(ws + WS_AX), (const bf16_t*)(ws + WS_WOUTT), MX, D, D};
        pg8::StaticOrder S; S.init(MX, D, G, bid);
        pg8::EpiResid E{p.in[0], (float*)(ws + WS_X1), (const float*)(ws + WS_MOD)};
        pg8::gemm_phase<pg8::EpiResid, pg8::StaticOrder, true, true>(lds, g, S, E);
        SEAM(5);
    }
    if (IN(6)) { phase_hx(p, lds, bid, G); SEAM(6); }
    if (IN(7)) { phase_topk(p, lds, bid, G); SEAM(7); }
    if (IN(8)) { phase_gather(p, bid, G); SEAM(8); }
    if (IN(9)) {
        pg8::Gemm g{(const bf16_t*)(ws + WS_XS), (const bf16_t*)(ws + WS_W1T), NE * NB * CAP, NE * 2048, D};
        pg8::ExpertOrder S; S.init(NE, 16, 8, G, bid);
        pg8::EpiSwiGLU E{(bf16_t*)(ws + WS_HID)};
        pg8::gemm_phase<pg8::EpiSwiGLU, pg8::ExpertOrder, true, true>(lds, g, S, E);
        SEAM(9);
    }
    if (IN(10)) {
        pg8::Gemm g{(const bf16_t*)(ws + WS_HID), (const bf16_t*)(ws + WS_W2T), NE * NB * CAP, NE * 1024, DE};
        pg8::ExpertOrder S; S.init(NE, 16, 4, G, bid);
        pg8::EpiDown E{(bf16_t*)(ws + WS_DN), (const float*)(ws + WS_VAL), (const float*)(ws + WS_MOD)};
        pg8::gemm_phase<pg8::EpiDown, pg8::ExpertOrder, true, true>(lds, g, S, E);
        SEAM(10);
    }
    if (IN(11)) { phase_final(p, bid, G); }
#undef IN
#undef SEAM
}

extern "C" void kernel_launch(void* const* d_in, const int* in_sizes, int n_in, void* d_out, int out_size, void* d_ws, size_t ws_size, hipStream_t stream) {
    static int grid = 0;
    if (grid == 0) {
        if (n_in != 27 || out_size != MX * D || ws_size < WS_END) { fprintf(stderr, "kernel_launch: unexpected shapes: n_in %d out %d ws %zu (need %zu)\n", n_in, out_size, ws_size, (size_t)WS_END); grid = -1; return; }
        int dev = 0, cus = 0, per_cu = 0;
        hipGetDevice(&dev); hipDeviceGetAttribute(&cus, hipDeviceAttributeMultiprocessorCount, dev);
        hipFuncSetAttribute((const void*)mk_fwd, hipFuncAttributeMaxDynamicSharedMemorySize, LDS_BYTES);
        hipOccupancyMaxActiveBlocksPerMultiprocessor(&per_cu, (const void*)mk_fwd, NTHR, LDS_BYTES);
        if (per_cu < 1) { fprintf(stderr, "kernel_launch: occupancy query says %d blocks per CU\n", per_cu); per_cu = 1; }
        (void)hipGetLastError();
        grid = cus;
    }
    if (grid < 0) return;
    Params p{};
    for (int i = 0; i < 27; ++i) p.in[i] = (const float*)d_in[i];
    p.out = (float*)d_out; p.ws = (unsigned char*)d_ws;
#if MK_FUSED
    p.ph_lo = 0; p.ph_hi = N_PHASES;
    void* args[] = {&p};
    hipError_t e = hipLaunchCooperativeKernel((const void*)mk_fwd, dim3(grid), dim3(NTHR), args, LDS_BYTES, stream);
    if (e != hipSuccess) fprintf(stderr, "cooperative launch failed: %s (grid %d)\n", hipGetErrorString(e), grid);
#else
    for (int ph = 0; ph < N_PHASES; ++ph) {
        p.ph_lo = ph; p.ph_hi = ph + 1;
        hipLaunchKernelGGL(mk_fwd, dim3(grid), dim3(NTHR), LDS_BYTES, stream, p);
    }
#endif
}
```

```cpp
#include <hip/hip_runtime.h>
#include <hip/hip_cooperative_groups.h>
#include <cstdio>
#include <cstdint>
namespace cg = cooperative_groups;

#ifndef MK_FUSED
#define MK_FUSED 1
#endif

#define LAS __attribute__((address_space(3)))
typedef unsigned short bf16_t;
typedef short bf16x8 __attribute__((ext_vector_type(8)));
typedef float f32x4 __attribute__((ext_vector_type(4)));
typedef unsigned u32x4 __attribute__((ext_vector_type(4)));
typedef unsigned u32x2 __attribute__((ext_vector_type(2)));
typedef int i32x8 __attribute__((ext_vector_type(8)));
typedef float f32x2 __attribute__((ext_vector_type(2)));
typedef int i32x4 __attribute__((ext_vector_type(4)));

#ifndef PG8_BUF_MOE1
#define PG8_BUF_MOE1 1
#endif
#ifndef PG8_BUF_MOE2
#define PG8_BUF_MOE2 1
#endif
#ifndef PG8_BUF_IN
#define PG8_BUF_IN 0
#endif
#ifndef PG8_BUF_OUT
#define PG8_BUF_OUT 0
#endif
#ifndef MOE_FP8
#define MOE_FP8 1
#endif
#ifndef XSCOPE
#define XSCOPE 0
#endif
#ifndef CVPOS
#define CVPOS 1
#endif
constexpr int NB = 8, T = 4096, D = 1024, CTXL = 256, DIN = 3328, RWC = 1792, NH = 8, HD = 64, DR = 512;
constexpr int NE = 16, CAP = 512, DE = 1024;
constexpr int MX = NB * T;
constexpr int MC = NB * CTXL;
constexpr int MALL = MX + MC;
constexpr int NWAVES = 8, NTHR = 512;
constexpr int LDS_BYTES = 163840;
constexpr int LDS_MISC = 154368;

constexpr size_t MiB = 1u << 20;
constexpr size_t WS_CTL = 0;
constexpr size_t WS_MOD = 1 * MiB;
constexpr size_t WS_BDOT = 2 * MiB;
constexpr size_t WS_AFF = 4 * MiB;
constexpr size_t WS_SEL = 6 * MiB;
constexpr size_t WS_GAM = 8 * MiB;
constexpr size_t WS_WOUTT = 11 * MiB;
constexpr size_t WS_IDX = 13 * MiB;
constexpr size_t WS_VAL = 13 * MiB + 256 * 1024;
constexpr size_t WS_MLR = 16 * MiB;
constexpr size_t WS_YF = 84 * MiB;
constexpr size_t WS_PX = 116 * MiB;
constexpr size_t WS_NT = 337 * MiB;
constexpr size_t WS_RB = 405 * MiB;
constexpr size_t WS_YB = 469 * MiB;
constexpr size_t WS_XN = 337 * MiB;
constexpr size_t WS_WINT = 405 * MiB;
constexpr size_t WS_AX = 337 * MiB;
constexpr size_t WS_X1 = 112 * MiB;
constexpr size_t WS_HX = 240 * MiB;
constexpr size_t WS_HID = 368 * MiB;
constexpr size_t WS_DN = 240 * MiB;
constexpr size_t WS_END = 501 * MiB;

struct Params { const float* in[27]; float* out; unsigned char* ws; int ph_lo, ph_hi; };

__device__ __forceinline__ unsigned f2bf(float f) { unsigned u = __float_as_uint(f); return (u + 0x7fffu + ((u >> 16) & 1u)) >> 16; }
typedef __bf16 hwbf16x2 __attribute__((ext_vector_type(2)));
typedef float f32x2_ __attribute__((ext_vector_type(2)));
__device__ __forceinline__ unsigned pk2(float lo, float hi) { const f32x2_ v = {lo, hi}; return __builtin_bit_cast(unsigned, __builtin_convertvector(v, hwbf16x2)); }
__device__ __forceinline__ float bflo(unsigned w) { return __uint_as_float(w << 16); }
__device__ __forceinline__ float bfhi(unsigned w) { return __uint_as_float(w & 0xffff0000u); }
__device__ __forceinline__ void unpack8(const u32x4 w, float (&f)[8]) {
    f[0] = bflo(w.x); f[1] = bfhi(w.x); f[2] = bflo(w.y); f[3] = bfhi(w.y); f[4] = bflo(w.z); f[5] = bfhi(w.z); f[6] = bflo(w.w); f[7] = bfhi(w.w); }
__device__ __forceinline__ u32x4 pack8(const float (&f)[8]) { u32x4 w; w.x = pk2(f[0], f[1]); w.y = pk2(f[2], f[3]); w.z = pk2(f[4], f[5]); w.w = pk2(f[6], f[7]); return w; }
__device__ __forceinline__ float wave_sum(float v) {
#pragma unroll
    for (int o = 1; o < 64; o <<= 1) v += __shfl_xor(v, o);
    return v;
}
__device__ __forceinline__ float wave_max(float v) {
#pragma unroll
    for (int o = 1; o < 64; o <<= 1) v = fmaxf(v, __shfl_xor(v, o));
    return v;
}
__device__ __forceinline__ float red8(float v) {
    v += __int_as_float(__builtin_amdgcn_update_dpp(0, __float_as_int(v), 0xB1, 0xF, 0xF, true));
    v += __int_as_float(__builtin_amdgcn_update_dpp(0, __float_as_int(v), 0x4E, 0xF, 0xF, true));
    v += __int_as_float(__builtin_amdgcn_update_dpp(0, __float_as_int(v), 0x141, 0xF, 0xF, true));
    return v;
}
__device__ __forceinline__ float sigmoidf_(float x) { return 1.f / (1.f + expf(-x)); }
__device__ __forceinline__ float fsigmoid(float x) { return __builtin_amdgcn_rcpf(1.f + __expf(-x)); }
__device__ __forceinline__ float ftanh(float x) { return 1.f - 2.f * __builtin_amdgcn_rcpf(1.f + __expf(2.f * x)); }

__device__ __forceinline__ float sat8(float x) { return __builtin_amdgcn_fmed3f(x, -448.f, 448.f); }
__device__ __forceinline__ unsigned pk4_fp8_raw(float a, float b, float c, float d) {
    int w = __builtin_amdgcn_cvt_pk_fp8_f32(a, b, 0, false); w = __builtin_amdgcn_cvt_pk_fp8_f32(c, d, w, true); return (unsigned)w; }
__device__ __forceinline__ unsigned pk4_fp8(float a, float b, float c, float d) { return pk4_fp8_raw(sat8(a), sat8(b), sat8(c), sat8(d)); }
constexpr float W8_SCALE = 64.f;
__device__ __forceinline__ int opq(int x) { asm volatile("" : "+v"(x)); return x; }
__device__ __forceinline__ int my_tid(int wv) { int l; asm volatile("v_mbcnt_lo_u32_b32 %0, -1, 0\n\tv_mbcnt_hi_u32_b32 %0, -1, %0" : "=v"(l)); return (wv << 6) | l; }
__device__ __forceinline__ unsigned char* sgpr_ptr(const void* q) {
    const unsigned long long v = (unsigned long long)(size_t)q;
    return (unsigned char*)(((unsigned long long)(unsigned)__builtin_amdgcn_readfirstlane((int)(v >> 32)) << 32) | (unsigned)__builtin_amdgcn_readfirstlane((int)(unsigned)v)); }
namespace pg8 {
#define PG8_LAS __attribute__((address_space(3)))
constexpr int BM = 256, BK = 64, HALF = 128, HTB = HALF * BK * 2, STAGE_BYTES = 8 * HTB, NXCD = 8, WGM = 8;
__host__ __device__ __forceinline__ int lds_byte(int r, int c) { const int st = (r >> 4) * 2 + (c >> 5), rr = r & 15, cc = c & 31, ob = rr * 64 + cc * 2; return st * 1024 + (ob ^ (((ob >> 9) & 1) << 5)); }
__host__ __device__ __forceinline__ void stage_rc(int b, int& R, int& C) { const int st = b / 1024, sb = b % 1024, swz = sb ^ (((sb >> 9) & 1) << 5); R = (st >> 1) * 16 + swz / 64; C = (st & 1) * 32 + (swz % 64) / 2; }
__host__ __device__ __forceinline__ int perm32(int rho) { const int n = rho >> 4, i = rho & 15; return 8 * (i >> 2) + 4 * n + (i & 3); }
struct Unit { int pm, pn; };
constexpr float WSC = MOE_FP8 ? 1.f / 64.f : 1.f;
struct Gemm { const bf16_t* A; const bf16_t* Bt; int M, N, K; const int* rowmap; };

__device__ __forceinline__ int xcd_remap(int wgid, int nwg) { const int q = nwg / NXCD, r = nwg % NXCD, xcd = wgid % NXCD, off = wgid / NXCD; return (xcd < r ? xcd * (q + 1) : r * (q + 1) + (xcd - r) * q) + off; }

struct StaticOrder {
    int nM, nN, nwg, G, c;
    __device__ void init(int M, int N, int G_, int c_) { nM = M / BM; nN = N / BM; nwg = nM * nN; G = G_; c = c_; }
    __device__ bool next(int i, Unit& u) const {
        const long L = (long)i * G + c; if (L >= nwg) return false;
        int wgid = xcd_remap((int)L, nwg);
        const int nig = WGM * nN, gid = wgid / nig, fm = gid * WGM, gsz = (nM - fm) < WGM ? (nM - fm) : WGM;
        u.pm = fm + ((wgid % nig) % gsz); u.pn = (wgid % nig) / gsz; return true;
    }
    __device__ __forceinline__ void a_ready(const Unit&) const {}
    __device__ __forceinline__ void done(const Unit&) const {}
};
struct InProjOrder {
    StaticOrder so; int G, c;
    __device__ void init(int G_, int c_) { so.init(MX, DIN, G_, c_); G = G_; c = c_; }
    __device__ bool next(int i, Unit& u) const {
        const long L = (long)i * G + c;
        if (L < so.nwg) return so.next(i, u);
        const int j = (int)(L - so.nwg); if (j >= 56) return false;
        u.pm = 128 + (j & 7); u.pn = j >> 3; return true;
    }
    __device__ __forceinline__ void a_ready(const Unit&) const {}
    __device__ __forceinline__ void done(const Unit&) const {}
};
struct ExpertOrder {
    int nPM, nPN, nwg, G, c;
    __device__ void init(int nE, int nPM_, int nPN_, int G_, int c_) { nPM = nPM_; nPN = nPN_; nwg = nE * nPM_ * nPN_; G = G_; c = c_; }
    __device__ bool next(int i, Unit& u) const {
        const long L = (long)i * G + c; if (L >= nwg) return false;
        const int wgid = xcd_remap((int)L, nwg);
        const int per = nPM * nPN, e = wgid / per, r = wgid % per;
        u.pm = e * nPM + (r % nPM); u.pn = e * nPN + (r / nPM); return true;
    }
    __device__ __forceinline__ void a_ready(const Unit&) const {}
    __device__ __forceinline__ void done(const Unit&) const {}
};

struct EpiBf16Plain {
    static constexpr bool PERM = true, AFTER_DRAIN = false;
    bf16_t* O; int ldc;
    __device__ __forceinline__ void operator()(const f32x4 (&acc)[2][2][4][2], const Unit& u, int wr, int wc, int fr, int fq) const {
        const int row0 = u.pm * BM + wr * 64 + fr, col0 = u.pn * BM + wc * 32 + 8 * fq;
#pragma unroll
        for (int ai = 0; ai < 2; ++ai)
#pragma unroll
            for (int m = 0; m < 4; ++m) { bf16_t* rowp = O + (size_t)(row0 + ai * HALF + m * 16) * ldc + col0;
#pragma unroll
                for (int bj = 0; bj < 2; ++bj) { const f32x4 v0 = acc[ai][bj][m][0], v1 = acc[ai][bj][m][1];
                    u32x4 w; w.x = pk2(v0[0], v0[1]); w.y = pk2(v0[2], v0[3]); w.z = pk2(v1[0], v1[1]); w.w = pk2(v1[2], v1[3]);
                    *(u32x4*)(rowp + bj * HALF) = w; } }
    }
};
struct EpiResid {
    static constexpr bool PERM = true, AFTER_DRAIN = false;
    const float* x; bf16_t* X1; const float* mod;
    __device__ __forceinline__ void operator()(const f32x4 (&acc)[2][2][4][2], const Unit& u, int wr, int wc, int fr, int fq) const {
        const int row0 = u.pm * BM + wr * 64 + fr, col0 = u.pn * BM + wc * 32 + 8 * fq;
        const float* g1 = mod + (size_t)(u.pm >> 4) * 6144 + 2048;
        f32x4 gv[2][2];
#pragma unroll
        for (int bj = 0; bj < 2; ++bj)
#pragma unroll
            for (int n = 0; n < 2; ++n) gv[bj][n] = *(const f32x4*)(g1 + col0 + bj * HALF + n * 4);
#pragma unroll
        for (int ai = 0; ai < 2; ++ai) { f32x4 xr[4][2][2];
#pragma unroll
            for (int m = 0; m < 4; ++m) { const size_t off = (size_t)(row0 + ai * HALF + m * 16) * D + col0;
#pragma unroll
                for (int bj = 0; bj < 2; ++bj) { xr[m][bj][0] = *(const f32x4*)(x + off + bj * HALF); xr[m][bj][1] = *(const f32x4*)(x + off + bj * HALF + 4); } }
#pragma unroll
            for (int m = 0; m < 4; ++m) { const size_t off = (size_t)(row0 + ai * HALF + m * 16) * D + col0;
#pragma unroll
                for (int bj = 0; bj < 2; ++bj) { const f32x4 v0 = xr[m][bj][0] + gv[bj][0] * acc[ai][bj][m][0], v1 = xr[m][bj][1] + gv[bj][1] * acc[ai][bj][m][1];
                    u32x4 w; w.x = pk2(v0[0], v0[1]); w.y = pk2(v0[2], v0[3]); w.z = pk2(v1[0], v1[1]); w.w = pk2(v1[2], v1[3]);
                    *(u32x4*)(X1 + off + bj * HALF) = w; } } }
    }
};
struct EpiSwiGLU {
    static constexpr bool PERM = true, AFTER_DRAIN = false;
    unsigned char* H;
    __device__ __forceinline__ void operator()(const f32x4 (&acc)[2][2][4][2], const Unit& u, int wr, int wc, int fr, int fq) const {
        const int row0 = u.pm * BM + wr * 64 + fr, col0 = (u.pn & 7) * 128 + wc * 32 + 8 * fq;
        const __amdgpu_buffer_rsrc_t rsH = __builtin_amdgcn_make_buffer_rsrc((void*)H, 0, 0x80000000u, 0x00020000);
#pragma unroll
        for (int ai = 0; ai < 2; ++ai)
#pragma unroll
            for (int m = 0; m < 4; ++m) { float h[8];
#pragma unroll
                for (int n = 0; n < 2; ++n)
#pragma unroll
                    for (int q = 0; q < 4; ++q) { const float g = acc[ai][0][m][n][q] * WSC, up = acc[ai][1][m][n][q] * WSC; h[n * 4 + q] = g / (1.f + __expf(-g)) * up; }
#if MOE_FP8
                u32x2 w; w.x = pk4_fp8(h[0], h[1], h[2], h[3]); w.y = pk4_fp8(h[4], h[5], h[6], h[7]);
                __builtin_amdgcn_raw_buffer_store_b64(w, rsH, (unsigned)((row0 + ai * HALF + m * 16) * DE + col0), 0, 0); }
#else
                u32x4 w; w.x = pk2(h[0], h[1]); w.y = pk2(h[2], h[3]); w.z = pk2(h[4], h[5]); w.w = pk2(h[6], h[7]);
                *(u32x4*)((bf16_t*)H + (size_t)(row0 + ai * HALF + m * 16) * DE + col0) = w; }
#endif
    }
};
struct EpiDown {
    static constexpr bool PERM = true, AFTER_DRAIN = false;
    bf16_t* O; const float* val; const float* mod;
    __device__ __forceinline__ void operator()(const f32x4 (&acc)[2][2][4][2], const Unit& u, int wr, int wc, int fr, int fq) const {
        const int row0 = u.pm * BM + wr * 64 + fr, col0 = (u.pn & 3) * BM + wc * 32 + 8 * fq;
        const int b = (u.pm & 15) >> 1;
        const unsigned char* mods = sgpr_ptr(mod); const unsigned char* vals_ = sgpr_ptr(val); unsigned char* Os = sgpr_ptr(O);
        f32x4 gv[2][2];
#pragma unroll
        for (int bj = 0; bj < 2; ++bj)
#pragma unroll
            for (int n = 0; n < 2; ++n) gv[bj][n] = *(const f32x4*)(mods + (size_t)(unsigned)((b * 6144 + 5120 + col0 + bj * HALF + n * 4) * 4));
        float vals[2][4];
#pragma unroll
        for (int ai = 0; ai < 2; ++ai)
#pragma unroll
            for (int m = 0; m < 4; ++m) vals[ai][m] = *(const float*)(vals_ + (size_t)(unsigned)((row0 + ai * HALF + m * 16) * 4));
#pragma unroll
        for (int ai = 0; ai < 2; ++ai)
#pragma unroll
#if MOE_FP8
            for (int m = 0; m < 4; ++m) { const int row = row0 + ai * HALF + m * 16; const float vv = vals[ai][m] * 0.25f; unsigned char* rowp = Os + (size_t)(unsigned)(row * D + col0);
#pragma unroll
                for (int bj = 0; bj < 2; ++bj) { const f32x4 v0 = acc[ai][bj][m][0] * gv[bj][0] * vv, v1 = acc[ai][bj][m][1] * gv[bj][1] * vv;
                    u32x2 w; w.x = pk4_fp8(v0[0], v0[1], v0[2], v0[3]); w.y = pk4_fp8(v1[0], v1[1], v1[2], v1[3]);
                    *(u32x2*)(Os + (size_t)(unsigned)(row * D + col0 + bj * HALF)) = w; } }
#else
            for (int m = 0; m < 4; ++m) { const int row = row0 + ai * HALF + m * 16; const float vv = vals[ai][m] * WSC; bf16_t* rowp = (bf16_t*)Os + (size_t)row * D + col0;
#pragma unroll
                for (int bj = 0; bj < 2; ++bj) { const f32x4 v0 = acc[ai][bj][m][0] * gv[bj][0] * vv, v1 = acc[ai][bj][m][1] * gv[bj][1] * vv;
                    u32x4 w; w.x = pk2(v0[0], v0[1]); w.y = pk2(v0[2], v0[3]); w.z = pk2(v1[0], v1[1]); w.w = pk2(v1[2], v1[3]);
                    *(u32x4*)(rowp + bj * HALF) = w; } }
#endif
    }
};

template <class Epi, class Sched, bool ALIGN_EPI = false, bool SP2 = false, bool GATHER = false, bool FP8 = false, int BUF = 0>
__device__ __forceinline__ void gemm_phase(PG8_LAS unsigned char* lds, const Gemm g, const Sched& S, const Epi& E, int wv) {
    const int tid = my_tid(wv), wid = __builtin_amdgcn_readfirstlane(tid >> 6), lane = tid & 63, wr = wid >> 2, wc = wid & 3, fr = lane & 15, fq = lane >> 4;
    const int K = g.K, nt = K / BK;
    unsigned voffA[2], voffB[2]; int gR[2]; unsigned gC[2];
#pragma unroll
    for (int i = 0; i < 2; ++i) { int R, C; stage_rc(tid * 16 + i * 8192, R, C); const int Rb = Epi::PERM ? ((R & ~31) + perm32(R & 31)) : R;
        voffA[i] = (unsigned)(R * K + C) * 2u; voffB[i] = (unsigned)(Rb * K + C) * 2u; gR[i] = R; gC[i] = (unsigned)C * 2u; }
    const __amdgpu_buffer_rsrc_t rsM = __builtin_amdgcn_make_buffer_rsrc((void*)g.rowmap, 0, 0x80000000u, 0x00020000);
    unsigned gAc[2][2], gAn[2][2];
#define PG8_GLOAD(dst, pm_) do { const int _t = my_tid(wv); _Pragma("unroll") for (int _i = 0; _i < 2; ++_i) { int _R, _C; stage_rc(_t * 16 + _i * 8192, _R, _C);     \
        _Pragma("unroll") for (int _h = 0; _h < 2; ++_h) dst[_h][_i] = (unsigned)__builtin_amdgcn_raw_buffer_load_b32(rsM, (unsigned)(((pm_) * BM + _h * HALF + _R) * 4), 0, 0) * (unsigned)(K * 2) + (unsigned)_C * 2u; } } while (0)
    const unsigned kstep = (unsigned)(BK * 2);
    const unsigned hstep = (unsigned)(HALF * K * 2);
    const unsigned tstep = 2u * hstep;
    const unsigned long long uA = ((unsigned long long)(unsigned)__builtin_amdgcn_readfirstlane((int)((unsigned long long)(size_t)g.A >> 32)) << 32) | (unsigned)__builtin_amdgcn_readfirstlane((int)(unsigned)(size_t)g.A);
    const unsigned long long uB = ((unsigned long long)(unsigned)__builtin_amdgcn_readfirstlane((int)((unsigned long long)(size_t)g.Bt >> 32)) << 32) | (unsigned)__builtin_amdgcn_readfirstlane((int)(unsigned)(size_t)g.Bt);
    const __amdgpu_buffer_rsrc_t rsA = __builtin_amdgcn_make_buffer_rsrc((void*)uA, 0, 0x80000000u, 0x00020000);
    const __amdgpu_buffer_rsrc_t rsB = __builtin_amdgcn_make_buffer_rsrc((void*)uB, 0, 0x80000000u, 0x00020000);
    const unsigned ldsw = (unsigned)wid * 1024u;
    const int aoff = lds_byte(wr * 64 + fr, fq * 8), boff = lds_byte(wc * 32 + fr, fq * 8);
#define PG8_SA(b, h) (((b) * 2 + (h)) * HTB)
#define PG8_SB(b, h) ((4 + (b) * 2 + (h)) * HTB)
#define PG8_GLDS(ldsp, v32, gp) asm volatile("s_mov_b32 m0, %0\n\ts_nop 0\n\tglobal_load_lds_dwordx4 %1, %2" :: "s"(__builtin_amdgcn_readfirstlane((int)(size_t)(ldsp))), "v"(v32), "s"(gp) : "memory", "m0")
#define PG8_STAGE(bufoff, goff, voff) do { _Pragma("unroll") for (int _i = 0; _i < 2; ++_i) { \
        if constexpr (BUF == 1 || BUF == 3) __builtin_amdgcn_raw_ptr_buffer_load_lds(rsB, (PG8_LAS void*)(lds + (bufoff) + ldsw + _i * 8192), 16, (voff)[_i], (goff), 0, 0); \
        else if constexpr (BUF == 2) PG8_GLDS(lds + (bufoff) + ldsw + _i * 8192, (voff)[_i] + (unsigned)__builtin_amdgcn_readfirstlane((int)(goff)), (const char*)uB); \
        else __builtin_amdgcn_global_load_lds((const unsigned*)((const char*)g.Bt + (size_t)((goff) + (voff)[_i])), (PG8_LAS unsigned*)(lds + (bufoff) + ldsw + _i * 8192), 16, 0, 0); } } while (0)
#define PG8_STA(bufoff, koff, h, nx) do { _Pragma("unroll") for (int _i = 0; _i < 2; ++_i) { \
        const unsigned _v = GATHER ? ((nx) ? gAn[h][_i] : gAc[h][_i]) : voffA[_i]; const unsigned _s = GATHER ? (koff) : (koff) + (unsigned)(h) * hstep; \
        if constexpr (BUF == 1) __builtin_amdgcn_raw_ptr_buffer_load_lds(rsA, (PG8_LAS void*)(lds + (bufoff) + ldsw + _i * 8192), 16, _v, _s, 0, 0); \
        else if constexpr (BUF == 2 || BUF == 3) PG8_GLDS(lds + (bufoff) + ldsw + _i * 8192, _v + (unsigned)__builtin_amdgcn_readfirstlane((int)_s), (const char*)uA); \
        else __builtin_amdgcn_global_load_lds((const unsigned*)((const char*)g.A + (size_t)(_s + _v)), (PG8_LAS unsigned*)(lds + (bufoff) + ldsw + _i * 8192), 16, 0, 0); } } while (0)
#define PG8_LDA(dst, b, h) do { _Pragma("unroll") for (int m = 0; m < 4; ++m) _Pragma("unroll") for (int k = 0; k < 2; ++k) dst[m][k] = *(const PG8_LAS bf16x8*)(lds + PG8_SA(b, h) + aoff + m * 2048 + k * 1024); } while (0)
#define PG8_LDB(dst, b, h) do { _Pragma("unroll") for (int n = 0; n < 2; ++n) _Pragma("unroll") for (int k = 0; k < 2; ++k) dst[n][k] = *(const PG8_LAS bf16x8*)(lds + PG8_SB(b, h) + boff + n * 2048 + k * 1024); } while (0)
#define PG8_CAT(f) __builtin_shufflevector(__builtin_bit_cast(i32x4, (f)[0]), __builtin_bit_cast(i32x4, (f)[1]), 0, 1, 2, 3, 4, 5, 6, 7)
#define PG8_MMA(ai, bj, At, Bt) do { __builtin_amdgcn_s_setprio(1); \
        if constexpr (FP8) { _Pragma("unroll") for (int m = 0; m < 4; ++m) _Pragma("unroll") for (int n = 0; n < 2; ++n) \
            acc[ai][bj][m][n] = __builtin_amdgcn_mfma_scale_f32_16x16x128_f8f6f4(PG8_CAT(Bt[n]), PG8_CAT(At[m]), acc[ai][bj][m][n], 0, 0, 0, 0, 0, 0); } \
        else { _Pragma("unroll") for (int m = 0; m < 4; ++m) _Pragma("unroll") for (int n = 0; n < 2; ++n) _Pragma("unroll") for (int k = 0; k < 2; ++k) \
            acc[ai][bj][m][n] = __builtin_amdgcn_mfma_f32_16x16x32_bf16(Bt[n][k], At[m][k], acc[ai][bj][m][n], 0, 0, 0); } \
        __builtin_amdgcn_s_setprio(0); } while (0)
#define PG8_WAIT_V(n) asm volatile("s_waitcnt vmcnt(" #n ")" ::: "memory")
#define PG8_WAIT_L(n) asm volatile("s_waitcnt lgkmcnt(" #n ")" ::: "memory")
#define PG8_BAR __builtin_amdgcn_s_barrier()
#define PG8_SCHED __builtin_amdgcn_sched_barrier(0)
    Unit cur, nxt; int ui = 0;
    if (!S.next(0, cur)) return;
    f32x4 acc[2][2][4][2];
#pragma unroll
    for (int a = 0; a < 2; ++a)
#pragma unroll
        for (int b = 0; b < 2; ++b)
#pragma unroll
            for (int m = 0; m < 4; ++m)
#pragma unroll
                for (int n = 0; n < 2; ++n) { acc[a][b][m][n] = (f32x4){0.f, 0.f, 0.f, 0.f}; if constexpr (FP8) asm volatile("" : "+v"(acc[a][b][m][n])); }
    bf16x8 At[4][2], B0[2][2], B1[2][2];
    unsigned cA = GATHER ? 0u : (unsigned)cur.pm * tstep, cB = (unsigned)cur.pn * tstep;
    if constexpr (GATHER) { PG8_GLOAD(gAc, cur.pm); }
    S.a_ready(cur);
    if constexpr (SP2) {
        PG8_STAGE(PG8_SB(0, 0), cB, voffB); PG8_STAGE(PG8_SB(0, 1), cB + hstep, voffB); PG8_STA(PG8_SA(0, 0), cA, 0, false); PG8_STA(PG8_SA(0, 1), cA, 1, false);
        if (wr == 1) PG8_BAR;
        PG8_WAIT_V(2); PG8_BAR;
        PG8_STAGE(PG8_SB(1, 0), cB + kstep, voffB); PG8_STA(PG8_SA(1, 0), cA + kstep, 0, false); PG8_STAGE(PG8_SB(1, 1), cB + hstep + kstep, voffB);
        PG8_WAIT_V(6); PG8_BAR;
    } else {
        PG8_STAGE(PG8_SB(0, 0), cB, voffB); PG8_STA(PG8_SA(0, 0), cA, 0, false); PG8_STAGE(PG8_SB(0, 1), cB + hstep, voffB); PG8_STA(PG8_SA(0, 1), cA, 1, false);
        if (wr == 1) PG8_BAR;
        PG8_WAIT_V(4); PG8_BAR;
        PG8_STAGE(PG8_SB(1, 0), cB + kstep, voffB); PG8_STA(PG8_SA(1, 0), cA + kstep, 0, false); PG8_STAGE(PG8_SB(1, 1), cB + hstep + kstep, voffB);
        PG8_WAIT_V(6); PG8_BAR;
    }
    for (;;) {
        const bool has_next = S.next(ui + 1, nxt);
        const unsigned nA = GATHER ? cA : (has_next ? (unsigned)nxt.pm * tstep : cA), nB = has_next ? (unsigned)nxt.pn * tstep : cB;
        if constexpr (GATHER) { if (has_next) { PG8_GLOAD(gAn, nxt.pm); } else {
#pragma unroll
            for (int _h = 0; _h < 2; ++_h)
#pragma unroll
                for (int _i = 0; _i < 2; ++_i) gAn[_h][_i] = gAc[_h][_i]; } }
#pragma unroll 1
        for (int t = 0; t < nt; t += 2) {
            const bool last = (t == nt - 2);
            const unsigned a1 = cA + (unsigned)(t + 1) * kstep;
            const unsigned a2 = last ? nA : cA + (unsigned)(t + 2) * kstep, b2 = last ? nB : cB + (unsigned)(t + 2) * kstep;
            const unsigned a3 = a2 + kstep, b3 = b2 + kstep;
            if (last && has_next) S.a_ready(nxt);
            if constexpr (SP2) {
            PG8_LDB(B0, 0, 0); PG8_LDB(B1, 0, 1); PG8_SCHED; PG8_LDA(At, 0, 0); PG8_STA(PG8_SA(1, 1), a1, 1, false);
            PG8_WAIT_V(8); PG8_WAIT_L(0); PG8_BAR; PG8_MMA(0, 0, At, B0); PG8_MMA(0, 1, At, B1); PG8_BAR; PG8_SCHED;
            PG8_LDA(At, 0, 1); PG8_STAGE(PG8_SB(0, 0), b2, voffB); PG8_STAGE(PG8_SB(0, 1), b2 + hstep, voffB); PG8_STA(PG8_SA(0, 0), a2, 0, last);
            PG8_WAIT_V(8); PG8_WAIT_L(0); PG8_BAR; PG8_MMA(1, 0, At, B0); PG8_MMA(1, 1, At, B1); PG8_BAR; PG8_SCHED;
            PG8_LDB(B0, 1, 0); PG8_LDB(B1, 1, 1); PG8_SCHED; PG8_LDA(At, 1, 0); PG8_STA(PG8_SA(0, 1), a2, 1, last);
            PG8_WAIT_V(8); PG8_WAIT_L(0); PG8_BAR; PG8_MMA(0, 0, At, B0); PG8_MMA(0, 1, At, B1); PG8_BAR; PG8_SCHED;
            PG8_LDA(At, 1, 1); PG8_STAGE(PG8_SB(1, 0), b3, voffB); PG8_STAGE(PG8_SB(1, 1), b3 + hstep, voffB); PG8_STA(PG8_SA(1, 0), a3, 0, last);
            PG8_WAIT_V(8); PG8_WAIT_L(0); PG8_BAR; PG8_MMA(1, 0, At, B0); PG8_MMA(1, 1, At, B1); PG8_BAR; PG8_SCHED;
            } else {
            PG8_LDB(B0, 0, 0); PG8_SCHED; PG8_LDA(At, 0, 0); PG8_STA(PG8_SA(1, 1), a1, 1, false);
            PG8_WAIT_L(8); PG8_BAR; PG8_WAIT_L(0); PG8_MMA(0, 0, At, B0); PG8_BAR; PG8_SCHED;
            PG8_LDB(B1, 0, 1); PG8_STAGE(PG8_SB(0, 0), b2, voffB);
            PG8_BAR; PG8_WAIT_L(0); PG8_MMA(0, 1, At, B1); PG8_BAR;
            PG8_LDA(At, 0, 1); PG8_STA(PG8_SA(0, 0), a2, 0, last);
            PG8_BAR; PG8_WAIT_L(0); PG8_MMA(1, 0, At, B0); PG8_BAR; PG8_SCHED;
            PG8_STAGE(PG8_SB(0, 1), b2 + hstep, voffB);
            PG8_WAIT_V(6); PG8_BAR; PG8_MMA(1, 1, At, B1); PG8_BAR;
            PG8_LDB(B0, 1, 0); PG8_SCHED; PG8_LDA(At, 1, 0); PG8_STA(PG8_SA(0, 1), a2, 1, last);
            PG8_WAIT_L(8); PG8_BAR; PG8_WAIT_L(0); PG8_MMA(0, 0, At, B0); PG8_BAR; PG8_SCHED;
            PG8_LDB(B1, 1, 1); PG8_STAGE(PG8_SB(1, 0), b3, voffB);
            PG8_BAR; PG8_WAIT_L(0); PG8_MMA(0, 1, At, B1); PG8_BAR;
            PG8_LDA(At, 1, 1); PG8_STA(PG8_SA(1, 0), a3, 0, last);
            PG8_BAR; PG8_WAIT_L(0); PG8_MMA(1, 0, At, B0); PG8_BAR; PG8_SCHED;
            PG8_STAGE(PG8_SB(1, 1), b3 + hstep, voffB);
            PG8_WAIT_V(6); PG8_BAR; PG8_MMA(1, 1, At, B1); PG8_BAR;
            }
        }
        if constexpr (ALIGN_EPI) { if (wr == 0) PG8_BAR; }
        if constexpr (!Epi::AFTER_DRAIN) { const int _l = my_tid(wv) & 63; E(acc, cur, wr, wc, _l & 15, _l >> 4); S.done(cur); }
        if (!has_next) break;
#pragma unroll
        for (int a = 0; a < 2; ++a)
#pragma unroll
            for (int b = 0; b < 2; ++b)
#pragma unroll
                for (int m = 0; m < 4; ++m)
#pragma unroll
                    for (int n = 0; n < 2; ++n) { acc[a][b][m][n] = (f32x4){0.f, 0.f, 0.f, 0.f}; if constexpr (FP8) asm volatile("" : "+v"(acc[a][b][m][n])); }
        cur = nxt; cA = nA; cB = nB; ++ui;
        if constexpr (GATHER) {
#pragma unroll
            for (int _h = 0; _h < 2; ++_h)
#pragma unroll
                for (int _i = 0; _i < 2; ++_i) gAc[_h][_i] = gAn[_h][_i]; }
        if constexpr (ALIGN_EPI) { if (wr == 1) PG8_BAR; }
    }
    PG8_WAIT_V(0);
    if constexpr (!ALIGN_EPI) { if (wr == 0) PG8_BAR; }
    PG8_BAR;
#undef PG8_SA
#undef PG8_SB
#undef PG8_STAGE
#undef PG8_STA
#undef PG8_GLDS
#undef PG8_GLOAD
#undef PG8_LDA
#undef PG8_LDB
#undef PG8_MMA
#undef PG8_CAT
#undef PG8_WAIT_V
#undef PG8_WAIT_L
#undef PG8_BAR
#undef PG8_SCHED
}
}

#define LDS_WAIT() asm volatile("s_waitcnt lgkmcnt(0)" ::: "memory")
#define LBAR() do { asm volatile("s_waitcnt lgkmcnt(0)" ::: "memory"); __builtin_amdgcn_s_barrier(); asm volatile("" ::: "memory"); } while (0)

__device__ __forceinline__ void cvt_item(const float* W, int K, int N, bf16_t* WT, int mode, int item, int lane) {
    const int nblk = N / 64, kb = item / nblk, nb = item % nblk, k0 = 64 * kb, n0 = 64 * nb;
    const int rbase = mode == 0 ? n0 : ((n0 >> 7) * 256 + (n0 & 127) + (mode == 2 ? 128 : 0));
    const int r = lane >> 4, c4 = lane & 15;
    const float* src = W + (size_t)(k0 + 16 * r) * N + n0 + 4 * c4;
    f32x4 v[16];
#pragma unroll
    for (int i = 0; i < 16; ++i) v[i] = *(const f32x4*)(src + (size_t)i * N);
    bf16_t* dst = WT + (size_t)(rbase + 4 * c4) * K + k0 + 16 * r;
#pragma unroll
    for (int q = 0; q < 4; ++q)
#pragma unroll
        for (int hh = 0; hh < 2; ++hh) { u32x4 o;
            o.x = pk2(v[8 * hh + 0][q], v[8 * hh + 1][q]); o.y = pk2(v[8 * hh + 2][q], v[8 * hh + 3][q]); o.z = pk2(v[8 * hh + 4][q], v[8 * hh + 5][q]); o.w = pk2(v[8 * hh + 6][q], v[8 * hh + 7][q]);
            *(u32x4*)(dst + (size_t)q * K + 8 * hh) = o; }
}

__device__ __forceinline__ void phase0(const Params& p, LAS unsigned char* lds, int bid, int G, int wv) {
    const int tid = my_tid(wv), lane = tid & 63, wave = tid >> 6;
    unsigned char* ws = p.ws;
    if (bid < 192) {
        LAS float* sc = (LAS float*)lds;
        LAS float* part = sc + 9 * 1024;
        const float* c = p.in[1]; const float* cctx = p.in[3]; const float* ada_w = p.in[4]; const float* ada_b = p.in[5];
        float* MOD = (float*)(ws + WS_MOD);
        for (int i = tid; i < 9 * 1024; i += NTHR) { const int r = i >> 10, k = i & 1023; const float v = r < 8 ? c[r * 1024 + k] : cctx[k]; sc[i] = v / (1.f + expf(-v)); }
        __syncthreads();
        for (int it = bid; it < 192; it += G) {
            const int col = tid & 31, kg = tid >> 5;
            float acc[9];
#pragma unroll
            for (int r = 0; r < 9; ++r) acc[r] = 0.f;
            const float* w = ada_w + (size_t)(kg * 64) * 6144 + it * 32 + col;
#pragma unroll 16
            for (int k = 0; k < 64; ++k) { const float wv = w[(size_t)k * 6144];
#pragma unroll
                for (int r = 0; r < 9; ++r) acc[r] += sc[r * 1024 + kg * 64 + k] * wv; }
#pragma unroll
            for (int r = 0; r < 9; ++r) part[(kg * 9 + r) * 32 + col] = acc[r];
            __syncthreads();
            for (int o = tid; o < 288; o += NTHR) { const int r = o >> 5, cc = o & 31; float s_ = ada_b[it * 32 + cc];
#pragma unroll
                for (int q = 0; q < 16; ++q) s_ += part[(q * 9 + r) * 32 + cc];
                MOD[r * 6144 + it * 32 + cc] = s_; }
            __syncthreads();
        }
    }
    {
        const int gw = bid * NWAVES + wave, NGW = G * NWAVES;
        constexpr int I_IN = 16 * (DIN / 64), I_OUT = 16 * 16;
        for (int it = gw; it < I_IN + I_OUT; it += NGW) {
            if (it < I_IN) cvt_item(p.in[8], D, DIN, (bf16_t*)(ws + WS_WINT), 0, it, lane);
            else cvt_item(p.in[21], D, D, (bf16_t*)(ws + WS_WOUTT), 0, it - I_IN, lane);
        }
    }
}
constexpr size_t OUT_W2T = (MOE_FP8 ? 32 : 64) * MiB;
__device__ __forceinline__ void xcvt_load(const Params& p, int g, int lane, f32x4 (&v)[8]) {
    const int which = g >> 13, r = g & 8191, e = r >> 9, kb = (r >> 4) & 31, nb = r & 15;
    const float* W = which == 0 ? p.in[23] : (which == 1 ? p.in[24] : p.in[25]);
    const __amdgpu_buffer_rsrc_t rs = __builtin_amdgcn_make_buffer_rsrc((void*)W, 0, 64 << 20, 0x00020000);
    const unsigned vo = (unsigned)(((lane >> 4) * 8 * 1024 + (lane & 15) * 4) * 4);
    const unsigned so = (unsigned)(((e * 1024 + kb * 32) * 1024 + nb * 64) * 4);
#pragma unroll
    for (int i = 0; i < 8; ++i) v[i] = __builtin_bit_cast(f32x4, __builtin_amdgcn_raw_buffer_load_b128(rs, vo, so + (unsigned)i * 4096u, 0));
}
__device__ __forceinline__ void xcvt_store(const Params& p, int g, int lane, const f32x4 (&v)[8]) {
    const int which = g >> 13, r = g & 8191, e = r >> 9, kb = (r >> 4) & 31, nb = r & 15, n0 = nb * 64;
    const int rbase = which == 2 ? n0 : ((n0 >> 7) * 256 + (n0 & 127) + (which == 1 ? 128 : 0));
#if MOE_FP8
    const unsigned so = which == 2 ? (unsigned)OUT_W2T + (unsigned)((e * 1024 + rbase) * 1024 + kb * 32) : (unsigned)((e * 2048 + rbase) * 1024 + kb * 32);
    const __amdgpu_buffer_rsrc_t rs = __builtin_amdgcn_make_buffer_rsrc((void*)p.out, 0, 48 << 20, 0x00020000);
    const unsigned vo = (unsigned)((lane & 15) * 4 * 1024 + (lane >> 4) * 8);
#pragma unroll
    for (int q = 0; q < 4; ++q) { u32x2 o;
        o.x = pk4_fp8_raw(v[0][q] * W8_SCALE, v[1][q] * W8_SCALE, v[2][q] * W8_SCALE, v[3][q] * W8_SCALE); o.y = pk4_fp8_raw(v[4][q] * W8_SCALE, v[5][q] * W8_SCALE, v[6][q] * W8_SCALE, v[7][q] * W8_SCALE);
        __builtin_amdgcn_raw_buffer_store_b64(o, rs, vo, so + (unsigned)q * 1024u, 0); }
#else
    const unsigned so = which == 2 ? (unsigned)OUT_W2T + (unsigned)(((e * 1024 + rbase) * 1024 + kb * 32) * 2) : (unsigned)(((e * 2048 + rbase) * 1024 + kb * 32) * 2);
    const __amdgpu_buffer_rsrc_t rs = __builtin_amdgcn_make_buffer_rsrc((void*)p.out, 0, 96 << 20, 0x00020000);
    const unsigned vo = (unsigned)(((lane & 15) * 4 * 1024 + (lane >> 4) * 8) * 2);
#pragma unroll
    for (int q = 0; q < 4; ++q) { u32x4 o;
        o.x = pk2(v[0][q], v[1][q]); o.y = pk2(v[2][q], v[3][q]); o.z = pk2(v[4][q], v[5][q]); o.w = pk2(v[6][q], v[7][q]);
        __builtin_amdgcn_raw_buffer_store_b128(o, rs, vo, so + (unsigned)q * 2048u, 0); }
#endif
}

__device__ __forceinline__ void phase1(const Params& p, int bid, int G, int wv) {
    const int tid = my_tid(wv), lane = tid & 63, wave = tid >> 6;
    const int gw = bid * NWAVES + wave, NGW = G * NWAVES;
    const float* MOD = (const float*)(p.ws + WS_MOD); const float* n1g = p.in[6];
    bf16_t* XN = (bf16_t*)(p.ws + WS_XN);
    f32x4 g[4];
#pragma unroll
    for (int j = 0; j < 4; ++j) g[j] = *(const f32x4*)(n1g + 4 * (lane + 64 * j));
    for (int m0 = gw; m0 < MALL; m0 += 2 * NGW) {
        f32x4 v[2][4]; float ss[2]; int mrow[2];
#pragma unroll
        for (int tk = 0; tk < 2; ++tk) { const int m = m0 + tk * NGW < MALL ? m0 + tk * NGW : m0;
            const float* src = m < MX ? p.in[0] + (size_t)m * D : p.in[2] + (size_t)(m - MX) * D; mrow[tk] = m;
            ss[tk] = 0.f;
#pragma unroll
            for (int j = 0; j < 4; ++j) { v[tk][j] = ((const f32x4*)src)[lane + 64 * j]; ss[tk] += (v[tk][j].x * v[tk][j].x + v[tk][j].y * v[tk][j].y) + (v[tk][j].z * v[tk][j].z + v[tk][j].w * v[tk][j].w); } }
#pragma unroll
        for (int tk = 0; tk < 2; ++tk) { const int m = mrow[tk], mr = m < MX ? (m >> 12) : 8;
            const float* sh = MOD + (size_t)mr * 6144; const float* scp = sh + 1024;
            const float rstd = rsqrtf(wave_sum(ss[tk]) * (1.f / D) + 1e-6f);
#pragma unroll
            for (int j = 0; j < 4; ++j) { const int col = 4 * (lane + 64 * j);
                const f32x4 s_ = *(const f32x4*)(scp + col), h = *(const f32x4*)(sh + col);
                const f32x4 y = v[tk][j] * rstd * g[j] * (s_ + 1.f) + h;
                u32x2 o; o.x = pk2(y.x, y.y); o.y = pk2(y.z, y.w);
                *(u32x2*)(XN + (size_t)m * D + col) = o; } }
    }
}

struct Px5 { u32x4 s, n0, n1, n2, n3; };
__device__ __forceinline__ Px5 px_load(const bf16_t* PX, int row, const int (&nbr)[4], int cb) {
    const __amdgpu_buffer_rsrc_t rs = __builtin_amdgcn_make_buffer_rsrc((void*)PX, 0, MALL * DIN * 2, 0x00020000);
    const unsigned cbb = (unsigned)cb * 2u, OOB = 0xFFFFF000u;
    Px5 q;
    q.s = __builtin_bit_cast(u32x4, __builtin_amdgcn_raw_buffer_load_b128(rs, (unsigned)row * (DIN * 2) + cbb, 0, 0));
    q.n0 = __builtin_bit_cast(u32x4, __builtin_amdgcn_raw_buffer_load_b128(rs, nbr[0] >= 0 ? (unsigned)nbr[0] * (DIN * 2) + cbb : OOB, 0, 0));
    q.n1 = __builtin_bit_cast(u32x4, __builtin_amdgcn_raw_buffer_load_b128(rs, nbr[1] >= 0 ? (unsigned)nbr[1] * (DIN * 2) + cbb : OOB, 0, 0));
    q.n2 = __builtin_bit_cast(u32x4, __builtin_amdgcn_raw_buffer_load_b128(rs, nbr[2] >= 0 ? (unsigned)nbr[2] * (DIN * 2) + cbb : OOB, 0, 0));
    q.n3 = __builtin_bit_cast(u32x4, __builtin_amdgcn_raw_buffer_load_b128(rs, nbr[3] >= 0 ? (unsigned)nbr[3] * (DIN * 2) + cbb : OOB, 0, 0));
    return q; }
__device__ __forceinline__ void px_lerp(const Px5& q, bool isctx, int cb, const float* mu, float (&out)[8]) {
    u32x4 sh;
    if (isctx) { sh.x = (q.n0.x & 0xffffu) | (q.n1.x & 0xffff0000u); sh.y = (q.n0.y & 0xffffu) | (q.n1.y & 0xffff0000u); sh.z = (q.n0.z & 0xffffu) | (q.n1.z & 0xffff0000u); sh.w = (q.n0.w & 0xffffu) | (q.n1.w & 0xffff0000u); }
    else { sh.x = (q.n0.x & 0xffffu) | (q.n1.x & 0xffff0000u); sh.y = (q.n2.y & 0xffffu) | (q.n3.y & 0xffff0000u); sh.z = (q.n0.z & 0xffffu) | (q.n1.z & 0xffff0000u); sh.w = (q.n2.w & 0xffffu) | (q.n3.w & 0xffff0000u); }
    float s[8], sv[8];
    unpack8(q.s, s); unpack8(sh, sv);
    const f32x4 m0 = *(const f32x4*)(mu + cb), m1 = *(const f32x4*)(mu + cb + 4);
    const float mv[8] = {m0.x, m0.y, m0.z, m0.w, m1.x, m1.y, m1.z, m1.w};
#pragma unroll
    for (int e = 0; e < 8; ++e) out[e] = s[e] + mv[e] * (sv[e] - s[e]);
}
__device__ __forceinline__ void neighbours(int t, bool isctx, int rowbase, int (&nbr)[4]) {
    if (isctx) { nbr[0] = t > 0 ? rowbase + t - 1 : -1; nbr[1] = t < CTXL - 1 ? rowbase + t + 1 : -1; nbr[2] = -1; nbr[3] = -1; }
    else { const int cg_ = t & 63, rg = t >> 6;
        nbr[0] = cg_ > 0 ? rowbase + t - 1 : -1; nbr[1] = cg_ < 63 ? rowbase + t + 1 : -1; nbr[2] = rg > 0 ? rowbase + t - 64 : -1; nbr[3] = rg < 63 ? rowbase + t + 64 : -1; }
}

typedef short s16x4 __attribute__((ext_vector_type(4)));
constexpr int RS = 128;
constexpr int IMG = 64 * RS;
__device__ __forceinline__ int ioff(int row, int col) { return row * RS + ((col * 2) ^ (((row & 2) | ((row >> 1) & 4)) << 4)); }
constexpr int I_AT = 0, I_BT = IMG, I_KT = 2 * IMG, I_RT = 3 * IMG, I_BH = 4 * IMG, I_KH = 5 * IMG, I_VV = 6 * IMG;
constexpr int I_LBT = 7 * IMG, I_LAK = 8 * IMG, I_PRB = 9 * IMG, I_PRK = 10 * IMG, I_TM = 11 * IMG, I_Q = 12 * IMG;
constexpr int I_E = 13 * IMG;
constexpr int I_LT = 13 * IMG + 4608;
constexpr int I_WUP = I_LT + 17408, I_AUP = I_WUP + IMG;
constexpr int I_PAR = I_AUP + IMG;
constexpr int I_VV2 = I_PAR + 1280;
constexpr int X_END = I_VV2 + IMG;
constexpr int I_W1 = I_LBT, I_W2 = I_LAK;
constexpr int I_XW = I_Q, I_XA = I_TM;
constexpr int I_DW = I_AT, I_DA = I_LT;
constexpr int I_G = I_PRB, I_GT = I_E;
static_assert(I_DW + 17408 <= I_RT && I_PRK == I_PRB + IMG && X_END + 64 <= LDS_BYTES && X_END == LDS_MISC, "scan LDS map");

__device__ __forceinline__ bf16x8 frag_rm(const LAS unsigned char* img, int row0, int k0, int lane) {
    return *(const LAS bf16x8*)(img + ioff(row0 + (lane & 15), k0 + 8 * (lane >> 4))); }
__device__ __forceinline__ bf16x8 frag_tr(const LAS unsigned char* img, int k0, int col0, int lane) {
    LAS unsigned char* a = (LAS unsigned char*)img + ioff(k0 + 8 * (lane >> 4) + ((lane & 15) >> 2), col0 + 4 * (lane & 3));
    const s16x4 lo = __builtin_amdgcn_ds_read_tr16_b64_v4i16((LAS s16x4*)a);
    const s16x4 hi = __builtin_amdgcn_ds_read_tr16_b64_v4i16((LAS s16x4*)(a + 4 * RS));
    return __builtin_shufflevector(lo, hi, 0, 1, 2, 3, 4, 5, 6, 7); }
#define MFMA16(a, b, c) __builtin_amdgcn_mfma_f32_16x16x32_bf16((a), (b), (c), 0, 0, 0)
__device__ __forceinline__ void st_img(LAS unsigned char* img, int n0, int m0, int lane, const f32x4 v) {
    u32x2 w; w.x = pk2(v[0], v[1]); w.y = pk2(v[2], v[3]);
    *(LAS u32x2*)(img + ioff(n0 + (lane & 15), m0 + 4 * (lane >> 4))) = w; }
__device__ __forceinline__ f32x4 up4(const u32x2 w) { return (f32x4){bflo(w.x), bfhi(w.x), bflo(w.y), bfhi(w.y)}; }

__device__ __forceinline__ void phase_scanX(const Params& p, LAS unsigned char* lds, int bid, int G, int wv) {
    const int tid_ = my_tid(wv), lane_ = tid_ & 63, wave = __builtin_amdgcn_readfirstlane(tid_ >> 6);
    const bf16_t* PX = (const bf16_t*)(p.ws + WS_PX);
    const float* mu = p.in[9];
    const f32x4 fz = (f32x4){0.f, 0.f, 0.f, 0.f};
    for (int it_ = bid; it_ < NB * NH * 2 * 2; it_ += G) {
        const int item = (G == 256) ? ((it_ & 7) * 32 + (it_ >> 3)) : it_;
        const int bhd = item >> 1, dir = bhd & 1, h = (bhd >> 1) & 7, b = bhd >> 4;
        LBAR();
        { const int tid = opq(tid_), j = tid >> 3, k0 = (tid & 7) * 8;
          const float* wu = p.in[11] + (size_t)dir * 64 * DR + (size_t)j * DR + h * 64 + k0; const float* au = p.in[13] + (size_t)dir * 64 * DR + (size_t)j * DR + h * 64 + k0;
          const f32x4 w0 = *(const f32x4*)wu, w1 = *(const f32x4*)(wu + 4), a0 = *(const f32x4*)au, a1 = *(const f32x4*)(au + 4);
          const float wf[8] = {w0.x, w0.y, w0.z, w0.w, w1.x, w1.y, w1.z, w1.w}, af[8] = {a0.x, a0.y, a0.z, a0.w, a1.x, a1.y, a1.z, a1.w};
          *(LAS u32x4*)(lds + I_WUP + ioff(j, k0)) = pack8(wf); *(LAS u32x4*)(lds + I_AUP + ioff(j, k0)) = pack8(af); }
        { const int k0_ = (opq(tid_) & 7) * 8, hc_ = h * 64 + k0_; LAS float* PARw = (LAS float*)(lds + I_PAR) + k0_;
#pragma unroll
          for (int e = 0; e < 8; ++e) { PARw[e] = p.in[10][dir * DR + hc_ + e]; PARw[64 + e] = p.in[12][dir * DR + hc_ + e]; PARw[128 + e] = p.in[14][hc_ + e]; PARw[192 + e] = p.in[15][hc_ + e]; PARw[256 + e] = p.in[16][hc_ + e]; } }
#define X_PXLOAD(ci_) do { const int tid__ = opq(tid_), j__ = tid__ >> 3, k0__ = (tid__ & 7) * 8; const int ci__ = (ci_); const bool ctx__ = ci__ < 4; const int c__ = ctx__ ? ci__ : ci__ - 4; \
            const int L__ = ctx__ ? CTXL : T, rb__ = ctx__ ? MX + b * CTXL : b * T, pos__ = 64 * c__ + j__, t__ = dir ? (L__ - 1 - pos__) : pos__; \
            int nbr__[4]; neighbours(t__, ctx__, rb__, nbr__); \
            qv = px_load(PX, rb__ + t__, nbr__, 1024 + h * 64 + k0__); qw = px_load(PX, rb__ + t__, nbr__, 1536 + k0__); qa = px_load(PX, rb__ + t__, nbr__, 1600 + k0__); \
            qr = px_load(PX, rb__ + t__, nbr__, h * 64 + k0__); qk = px_load(PX, rb__ + t__, nbr__, 512 + h * 64 + k0__); } while (0)
#define X_LERP(ci_, par_, rd_, kd_) do { const int tid__ = opq(tid_), j__ = tid__ >> 3, k0__ = (tid__ & 7) * 8; const bool ctx__ = (ci_) < 4; \
            { float v__[8]; px_lerp(qv, ctx__, 1024 + h * 64 + k0__, mu, v__); *(LAS u32x4*)(lds + ((par_) ? I_VV2 : I_VV) + ioff(j__, k0__)) = pack8(v__); } \
            { float xw__[8]; px_lerp(qw, ctx__, 1536 + k0__, mu, xw__); \
              _Pragma("unroll") for (int e = 0; e < 8; ++e) xw__[e] = ftanh(xw__[e]); \
              *(LAS u32x4*)(lds + I_XW + ioff(j__, k0__)) = pack8(xw__); } \
            { float xa__[8]; px_lerp(qa, ctx__, 1600 + k0__, mu, xa__); *(LAS u32x4*)(lds + I_XA + ioff(j__, k0__)) = pack8(xa__); } \
            px_lerp(qr, ctx__, h * 64 + k0__, mu, rd_); px_lerp(qk, ctx__, 512 + h * 64 + k0__, mu, kd_); } while (0)
#define X_LORA() do { const int lane = opq(lane_); const int pr = wave >> 2, nt = wave & 3; \
            const LAS unsigned char* Ximg = lds + (pr ? I_XA : I_XW); const LAS unsigned char* Wimg = lds + (pr ? I_AUP : I_WUP); \
            LAS float* Dout = (LAS float*)(lds + (pr ? I_DA : I_DW)); \
            const bf16x8 b0 = frag_rm(Ximg, 16 * nt, 0, lane), b1 = frag_rm(Ximg, 16 * nt, 32, lane); \
            bf16x8 wa[4][2]; \
            _Pragma("unroll") for (int mt = 0; mt < 4; ++mt) { wa[mt][0] = frag_tr(Wimg, 0, 16 * mt, lane); wa[mt][1] = frag_tr(Wimg, 32, 16 * mt, lane); } \
            _Pragma("unroll") for (int mt = 0; mt < 4; ++mt) { const f32x4 acc = MFMA16(wa[mt][1], b1, MFMA16(wa[mt][0], b0, fz)); \
                *(LAS f32x4*)(Dout + (16 * nt + (lane & 15)) * 68 + 16 * mt + 4 * (lane >> 4)) = acc; } } while (0)
        float r[8], k[8];
#if XSCOPE
        { Px5 qv, qw, qa, qr, qk; X_PXLOAD((item & 1) * 34);
          X_LERP((item & 1) * 34, 0, r, k); }
#else
        Px5 qv, qw, qa, qr, qk;
        X_PXLOAD((item & 1) * 34);
        X_LERP((item & 1) * 34, 0, r, k);
#endif
        LBAR();
        X_LORA();
        for (int cc = 0; cc < 34; ++cc) {
            const int tid = opq(tid_), j = tid >> 3, sub = tid & 7, k0 = sub * 8;
#if XSCOPE
            Px5 qv, qw, qa, qr, qk;
#endif
            const int ci = (item & 1) * 34 + cc;
            const bool isctx = ci < 4; const int c = isctx ? ci : ci - 4;
            const int u = bhd * 68 + ci;
            const int L = isctx ? CTXL : T, rowbase = isctx ? MX + b * CTXL : b * T;
            const int pos = 64 * c + j, t = dir ? (L - 1 - pos) : pos;
            const LAS unsigned char* vvimg = lds + ((cc & 1) ? I_VV2 : I_VV);
            LBAR();
            if (cc + 1 < 34) X_PXLOAD(ci + 1);
            float kkn[8], ab[8], kd[8];
            { const LAS float* DW = (const LAS float*)(lds + I_DW) + j * 68 + k0; const LAS float* DA = (const LAS float*)(lds + I_DA) + j * 68 + k0;
              const f32x4 d0 = *(const LAS f32x4*)DW, d1 = *(const LAS f32x4*)(DW + 4), e0 = *(const LAS f32x4*)DA, e1 = *(const LAS f32x4*)(DA + 4);
              const float dw[8] = {d0.x, d0.y, d0.z, d0.w, d1.x, d1.y, d1.z, d1.w}, da[8] = {e0.x, e0.y, e0.z, e0.w, e1.x, e1.y, e1.z, e1.w};
              const LAS float* PAR = (const LAS float*)(lds + I_PAR) + k0;
              const LAS float* w0p = PAR; const LAS float* a0p = PAR + 64; const LAS float* kkp = PAR + 128; const LAS float* kap = PAR + 192; const LAS float* rkp = PAR + 256;
              float ss = 0.f, bd = 0.f, lw[8];
#pragma unroll
              for (int e = 0; e < 8; ++e) {
                  kkn[e] = k[e] * kkp[e]; ss += kkn[e] * kkn[e];
                  const float z = w0p[e] + dw[e];
                  lw[e] = -0.60653066f * fsigmoid(z);
                  const float as = fsigmoid(a0p[e] + da[e]);
                  kd[e] = k[e] * (1.f + (as - 1.f) * kap[e]);
                  bd += r[e] * kd[e] * rkp[e];
                  ab[e] = as; }
              ss = red8(ss); bd = red8(bd);
              const float inv = __builtin_amdgcn_rcpf(fmaxf(__builtin_amdgcn_sqrtf(ss), 1e-12f));
#pragma unroll
              for (int e = 0; e < 8; ++e) { kkn[e] *= inv; ab[e] *= kkn[e]; }
              LAS float* Gs = (LAS float*)(lds + I_G) + j * 64 + k0;
              *(LAS f32x4*)Gs = (f32x4){lw[0], lw[1], lw[2], lw[3]}; *(LAS f32x4*)(Gs + 4) = (f32x4){lw[4], lw[5], lw[6], lw[7]};
              if (!isctx && sub == 0) *(float*)(p.ws + (size_t)(unsigned)(WS_BDOT + ((dir * MX + rowbase + t) * NH + h) * 4)) = bd; }
            LBAR();
            { const int kap = tid & 63, jq = tid >> 6; LAS float* Gs = (LAS float*)(lds + I_G); LAS float* GT = (LAS float*)(lds + I_GT);
              float pf[8], run = 0.f;
#pragma unroll
              for (int e = 0; e < 8; ++e) { run += Gs[(8 * jq + e) * 64 + kap]; pf[e] = run; }
              GT[jq * 64 + kap] = run;
              LBAR();
              float off = 0.f;
#pragma unroll
              for (int q = 0; q < 7; ++q) off += (q < jq) ? GT[q * 64 + kap] : 0.f;
#pragma unroll
              for (int e = 0; e < 8; ++e) Gs[(8 * jq + e) * 64 + kap] = pf[e] + off; }
            LBAR();
            { const LAS float* Gs = (const LAS float*)(lds + I_G);
              const f32x4 g0 = *(const LAS f32x4*)(Gs + j * 64 + k0), g1 = *(const LAS f32x4*)(Gs + j * 64 + k0 + 4);
              const f32x4 c0 = *(const LAS f32x4*)(Gs + 63 * 64 + k0), c1 = *(const LAS f32x4*)(Gs + 63 * 64 + k0 + 4);
              f32x4 m0 = fz, m1 = fz; if (j > 0) { m0 = *(const LAS f32x4*)(Gs + (j - 1) * 64 + k0); m1 = *(const LAS f32x4*)(Gs + (j - 1) * 64 + k0 + 4); }
              const float g[8] = {g0.x, g0.y, g0.z, g0.w, g1.x, g1.y, g1.z, g1.w}, gm[8] = {m0.x, m0.y, m0.z, m0.w, m1.x, m1.y, m1.z, m1.w}, gc[8] = {c0.x, c0.y, c0.z, c0.w, c1.x, c1.y, c1.z, c1.w};
              float at[8], bt[8], kt[8], rt[8], bh[8], kh[8];
#pragma unroll
              for (int e = 0; e < 8; ++e) { const float eg = __expf(g[e]), em = __expf(gm[e]), ei = __expf(-g[e]), eh = __expf(gc[e] - g[e]);
                  at[e] = -kkn[e] * em; bt[e] = ab[e] * ei; kt[e] = kd[e] * ei; rt[e] = r[e] * eg; bh[e] = ab[e] * eh; kh[e] = kd[e] * eh; }
              const int o = ioff(j, k0);
              *(LAS u32x4*)(lds + I_AT + o) = pack8(at); *(LAS u32x4*)(lds + I_BT + o) = pack8(bt); *(LAS u32x4*)(lds + I_KT + o) = pack8(kt);
              *(LAS u32x4*)(lds + I_RT + o) = pack8(rt); *(LAS u32x4*)(lds + I_BH + o) = pack8(bh); *(LAS u32x4*)(lds + I_KH + o) = pack8(kh);
              if (j == 0) { float* GAM = (float*)(p.ws + (size_t)(unsigned)(WS_GAM + (u * 64 + k0) * 4));
#pragma unroll
                  for (int e = 0; e < 8; ++e) GAM[e] = __expf(gc[e]); } }
            LBAR();
            const int cvitem = __builtin_amdgcn_readfirstlane(opq((CVPOS != 0 && cc < 32 && wave >= 5) ? item * 96 + cc * 3 + (wave - 5) : -1));
            f32x4 cv[8];
#if CVPOS == 1
            if (cvitem >= 0) xcvt_load(p, cvitem, opq(lane_), cv);
#endif
            { const int lane = opq(lane_); const int nt = wave >> 1, mb = (wave & 1) * 2;
              const bf16x8 bB0 = frag_rm(lds + I_BT, 16 * nt, 0, lane), bB1 = frag_rm(lds + I_BT, 16 * nt, 32, lane);
              const int n = 16 * nt + (lane & 15);
#pragma unroll
              for (int mi = 0; mi < 2; ++mi) { const int mt = mb + mi, m0 = 16 * mt + 4 * (lane >> 4);
                  const bf16x8 aA0 = frag_rm(lds + I_AT, 16 * mt, 0, lane), aA1 = frag_rm(lds + I_AT, 16 * mt, 32, lane);
                  f32x4 lt = MFMA16(aA1, bB1, MFMA16(aA0, bB0, fz));
#pragma unroll
                  for (int q = 0; q < 4; ++q) lt[q] = (m0 + q > n) ? lt[q] : 0.f;
                  *(LAS f32x4*)((LAS float*)(lds + I_LT) + n * 68 + m0) = lt;
                  st_img(lds + I_LBT, 16 * nt, 16 * mt, lane, lt); } }
            LBAR();
            if (wave == 0) {
                const int lane = opq(lane_); const int a16 = lane >> 4, il = lane & 15;
                const LAS float* LT = (const LAS float*)(lds + I_LT);
                typedef float f32x2v __attribute__((ext_vector_type(2)));
                f32x2v tp[8];
#pragma unroll
                for (int i = 0; i < 8; ++i) tp[i] = (f32x2v){0.f, 0.f};
                f32x4 Lc[4], Ln[4];
#pragma unroll
                for (int q4 = 0; q4 < 4; ++q4) { Lc[q4] = fz; Ln[q4] = fz; }
                Lc[3] = *(const LAS f32x4*)(LT + (16 * a16 + 14) * 68 + 16 * a16 + 12);
                tp[7].y = (il == 15) ? 1.f : 0.f;
#pragma unroll
                for (int jl = 14; jl >= 0; --jl) {
                    if (jl > 0) { const LAS float* Lrow = LT + (16 * a16 + jl - 1) * 68 + 16 * a16;
#pragma unroll
                        for (int q4 = 0; q4 < 4; ++q4) if (4 * q4 + 3 > jl - 1) Ln[q4] = *(const LAS f32x4*)(Lrow + 4 * q4); }
                    f32x2v s01 = (f32x2v){(il == jl) ? 1.f : 0.f, 0.f}, s23 = (f32x2v){0.f, 0.f};
#pragma unroll
                    for (int q4 = 0; q4 < 4; ++q4) if (4 * q4 + 3 > jl) { const f32x4 Lv = Lc[q4];
                        s01 += tp[2 * q4] * (f32x2v){Lv.x, Lv.y}; s23 += tp[2 * q4 + 1] * (f32x2v){Lv.z, Lv.w}; }
                    float tv_ = (s01.x + s01.y) + (s23.x + s23.y);
                    asm volatile("" : "+v"(tv_) :: "memory");
                    if (jl & 1) tp[jl >> 1].y = tv_; else tp[jl >> 1].x = tv_;
#pragma unroll
                    for (int q4 = 0; q4 < 4; ++q4) Lc[q4] = Ln[q4];
                }
                LAS unsigned char* tmi = lds + I_TM;
                const u32x4 z4 = (u32x4){0u, 0u, 0u, 0u};
#pragma unroll
                for (int c8 = 0; c8 < 2; ++c8) { const float tv[8] = {tp[4 * c8].x, tp[4 * c8].y, tp[4 * c8 + 1].x, tp[4 * c8 + 1].y, tp[4 * c8 + 2].x, tp[4 * c8 + 2].y, tp[4 * c8 + 3].x, tp[4 * c8 + 3].y};
                    *(LAS u32x4*)(tmi + ioff(lane, 16 * a16 + 8 * c8)) = pack8(tv); }
                if ((a16 & 1) == 0) {
#pragma unroll
                    for (int c8 = 0; c8 < 2; ++c8) *(LAS u32x4*)(tmi + ioff(lane, 16 * (a16 + 1) + 8 * c8)) = z4; }
                if (a16 < 2) {
#pragma unroll
                    for (int c8 = 0; c8 < 4; ++c8) *(LAS u32x4*)(tmi + ioff(lane, 32 + 8 * c8)) = z4; }
                asm volatile("s_waitcnt lgkmcnt(0)" ::: "memory");
                const bf16x8 zf = (bf16x8){0, 0, 0, 0, 0, 0, 0, 0};
                const bool khi = (lane & 32) != 0;
#pragma unroll
                for (int pq = 0; pq < 2; ++pq) {
                    bf16x8 fa = frag_tr(lds + I_TM, 32 * pq, 32 * pq, lane), fb = frag_tr(lds + I_LBT, 32 * pq, 32 * pq + 16, lane);
                    fa = khi ? zf : fa; fb = khi ? zf : fb;
                    st_img(lds + I_E, 16 * pq, 0, lane, MFMA16(fa, fb, fz)); }
                asm volatile("s_waitcnt lgkmcnt(0)" ::: "memory");
#pragma unroll
                for (int pq = 0; pq < 2; ++pq) {
                    bf16x8 fa = frag_tr(lds + I_E, 16 * pq, 0, lane), fb = frag_rm(lds + I_TM, 32 * pq + 16, 32 * pq + 16, lane);
                    fa = khi ? zf : fa; fb = khi ? zf : fb;
                    st_img(lds + I_TM, 32 * pq + 16, 32 * pq, lane, MFMA16(fa, fb, fz)); }
                asm volatile("s_waitcnt lgkmcnt(0)" ::: "memory");
                { f32x4 ea[4];
#pragma unroll
                  for (int tq = 0; tq < 4; ++tq) { const int nt2 = tq >> 1, mt2 = tq & 1;
                      ea[tq] = MFMA16(frag_tr(lds + I_TM, 0, 16 * mt2, lane), frag_tr(lds + I_LBT, 0, 32 + 16 * nt2, lane), fz); }
#pragma unroll
                  for (int tq = 0; tq < 4; ++tq) st_img(lds + I_E, 16 * (tq >> 1), 16 * (tq & 1), lane, ea[tq]); }
                asm volatile("s_waitcnt lgkmcnt(0)" ::: "memory");
                { f32x4 ta[4];
#pragma unroll
                  for (int tq = 0; tq < 4; ++tq) { const int nt2 = tq >> 1, mt2 = tq & 1;
                      ta[tq] = MFMA16(frag_tr(lds + I_E, 0, 16 * mt2, lane), frag_rm(lds + I_TM, 32 + 16 * nt2, 32, lane), fz); }
#pragma unroll
                  for (int tq = 0; tq < 4; ++tq) st_img(lds + I_TM, 32 + 16 * (tq >> 1), 16 * (tq & 1), lane, ta[tq]); }
            } else if (wave < 5) {
                const int lane = opq(lane_); const int nt = wave - 1, n = 16 * nt + (lane & 15);
                const bf16x8 bA0 = frag_rm(lds + I_AT, 16 * nt, 0, lane), bA1 = frag_rm(lds + I_AT, 16 * nt, 32, lane);
                const bf16x8 bR0 = frag_rm(lds + I_RT, 16 * nt, 0, lane), bR1 = frag_rm(lds + I_RT, 16 * nt, 32, lane);
                bf16x8 fk[4][2], fb[4][2];
#pragma unroll
                for (int mt = 0; mt < 4; ++mt) { fk[mt][0] = frag_rm(lds + I_KT, 16 * mt, 0, lane); fk[mt][1] = frag_rm(lds + I_KT, 16 * mt, 32, lane);
                                                 fb[mt][0] = frag_rm(lds + I_BT, 16 * mt, 0, lane); fb[mt][1] = frag_rm(lds + I_BT, 16 * mt, 32, lane); }
                f32x4 laks[4], prbs[4];
#pragma unroll
                for (int mt = 0; mt < 4; ++mt) { const int m0 = 16 * mt + 4 * (lane >> 4);
                    f32x4 lak = MFMA16(fk[mt][1], bA1, MFMA16(fk[mt][0], bA0, fz)), prb = MFMA16(fb[mt][1], bR1, MFMA16(fb[mt][0], bR0, fz));
#pragma unroll
                    for (int q = 0; q < 4; ++q) { lak[q] = (m0 + q < n) ? lak[q] : 0.f; prb[q] = (m0 + q <= n) ? prb[q] : 0.f; }
                    laks[mt] = lak; prbs[mt] = prb; }
#pragma unroll
                for (int mt = 0; mt < 4; ++mt) { st_img(lds + I_LAK, 16 * nt, 16 * mt, lane, laks[mt]); st_img(lds + I_PRB, 16 * nt, 16 * mt, lane, prbs[mt]); }
                bf16x8 fv[4][2];
#pragma unroll
                for (int mt = 0; mt < 4; ++mt) { fv[mt][0] = frag_tr(vvimg, 0, 16 * mt, lane); fv[mt][1] = frag_tr(vvimg, 32, 16 * mt, lane); }
                asm volatile("s_waitcnt lgkmcnt(0)" ::: "memory");
                const bf16x8 bL0 = frag_rm(lds + I_LAK, 16 * nt, 0, lane), bL1 = frag_rm(lds + I_LAK, 16 * nt, 32, lane);
                f32x4 qs[4];
#pragma unroll
                for (int mt = 0; mt < 4; ++mt) qs[mt] = MFMA16(fv[mt][1], bL1, MFMA16(fv[mt][0], bL0, fz));
#pragma unroll
                for (int mt = 0; mt < 4; ++mt) st_img(lds + I_Q, 16 * nt, 16 * mt, lane, qs[mt]);
            } else {
                const int lane = opq(lane_);
#if CVPOS == 3
                if (cvitem >= 0) xcvt_load(p, cvitem, lane, cv);
#endif
#pragma unroll
                for (int bt = 0; bt < 2; ++bt) { bf16x8 fa[3][2], fr[3][2]; f32x4 accs[3];
#pragma unroll
                    for (int k3 = 0; k3 < 3; ++k3) { const int tq = (wave - 5) + 3 * (3 * bt + k3); const int tqc = tq < 16 ? tq : 15, nt = tqc >> 2, mt = tqc & 3;
                        fa[k3][0] = frag_rm(lds + I_KT, 16 * mt, 0, lane); fa[k3][1] = frag_rm(lds + I_KT, 16 * mt, 32, lane);
                        fr[k3][0] = frag_rm(lds + I_RT, 16 * nt, 0, lane); fr[k3][1] = frag_rm(lds + I_RT, 16 * nt, 32, lane); }
#pragma unroll
                    for (int k3 = 0; k3 < 3; ++k3) { const int tq = (wave - 5) + 3 * (3 * bt + k3); const int tqc = tq < 16 ? tq : 15, nt = tqc >> 2, mt = tqc & 3, n = 16 * nt + (lane & 15), m0 = 16 * mt + 4 * (lane >> 4);
                        f32x4 acc = MFMA16(fa[k3][1], fr[k3][1], MFMA16(fa[k3][0], fr[k3][0], fz));
#pragma unroll
                        for (int q = 0; q < 4; ++q) acc[q] = (m0 + q <= n) ? acc[q] : 0.f;
                        accs[k3] = acc; }
#pragma unroll
                    for (int k3 = 0; k3 < 3; ++k3) { const int tq = (wave - 5) + 3 * (3 * bt + k3); const int tqc = tq < 16 ? tq : 15, nt = tqc >> 2, mt = tqc & 3;
                        st_img(lds + I_PRK, 16 * nt, 16 * mt, lane, accs[k3]); } }
#if CVPOS == 2
                if (cvitem >= 0) xcvt_load(p, cvitem, lane, cv);
#endif
                if (cvitem >= 0) xcvt_store(p, cvitem, lane, cv);
            }
            LBAR();
            { const int lane = opq(lane_); const int pr = wave >> 2, nt = wave & 3; const LAS unsigned char* Aimg = lds + (pr ? I_Q : I_AT); LAS unsigned char* Oimg = lds + (pr ? I_W2 : I_W1);
              const bf16x8 bT0 = frag_rm(lds + I_TM, 16 * nt, 0, lane), bT1 = frag_rm(lds + I_TM, 16 * nt, 32, lane);
#pragma unroll
              for (int mt = 0; mt < 4; ++mt) { f32x4 acc = MFMA16(frag_tr(Aimg, 0, 16 * mt, lane), bT0, fz); acc = MFMA16(frag_tr(Aimg, 32, 16 * mt, lane), bT1, acc);
                  st_img(Oimg, 16 * nt, 16 * mt, lane, acc); } }
            LBAR();
            float rn[8], kn[8];
            if (cc + 1 < 34) { X_LERP(ci + 1, (cc + 1) & 1, rn, kn); LBAR(); X_LORA(); }
            { const int lane = opq(lane_); const int nt = wave >> 1, mb = (wave & 1) * 2;
              const int n = 16 * nt + (lane & 15);
              const bf16x8 bBh0 = frag_tr(lds + I_BH, 0, 16 * nt, lane), bBh1 = frag_tr(lds + I_BH, 32, 16 * nt, lane);
              const bf16x8 bW20 = frag_tr(lds + I_W2, 0, 16 * nt, lane), bW21 = frag_tr(lds + I_W2, 32, 16 * nt, lane);
              const bf16x8 bVv0 = frag_tr(vvimg, 0, 16 * nt, lane), bVv1 = frag_tr(vvimg, 32, 16 * nt, lane);
              const bf16x8 bPb0 = frag_rm(lds + I_PRB, 16 * nt, 0, lane), bPb1 = frag_rm(lds + I_PRB, 16 * nt, 32, lane);
              const bf16x8 bPk0 = frag_rm(lds + I_PRK, 16 * nt, 0, lane), bPk1 = frag_rm(lds + I_PRK, 16 * nt, 32, lane);
              const unsigned MLRo = (unsigned)WS_MLR + (unsigned)u * 8192u, NTo = (unsigned)WS_NT + (unsigned)u * 8192u, RBo = (unsigned)WS_RB + (unsigned)(bhd * 64 + c) * 8192u;
              const int posn = 64 * c + n, tn = dir ? (T - 1 - posn) : posn;
              const unsigned Yo = (unsigned)(dir ? WS_YB : WS_YF) + (unsigned)(((b * T + tn) * DR + h * 64) * 2);
#pragma unroll
              for (int mi = 0; mi < 2; ++mi) { const int mt = mb + mi, m0 = 16 * mt + 4 * (lane >> 4);
                  const bf16x8 aW10 = frag_tr(lds + I_W1, 0, 16 * mt, lane), aW11 = frag_tr(lds + I_W1, 32, 16 * mt, lane);
                  const bf16x8 aBh0 = frag_tr(lds + I_BH, 0, 16 * mt, lane), aBh1 = frag_tr(lds + I_BH, 32, 16 * mt, lane);
                  const bf16x8 aKh0 = frag_tr(lds + I_KH, 0, 16 * mt, lane), aKh1 = frag_tr(lds + I_KH, 32, 16 * mt, lane);
                  const f32x4 mlr = MFMA16(aW11, bBh1, MFMA16(aW10, bBh0, fz));
                  const f32x4 ntv = MFMA16(aKh1, bVv1, MFMA16(aKh0, bVv0, MFMA16(aBh1, bW21, MFMA16(aBh0, bW20, fz))));
                  const int fo = ((nt * 2 + (mt >> 1)) * 64 + (lane & 15) + 16 * (2 * (mt & 1) + (lane >> 5))) * 8 + 4 * ((lane >> 4) & 1);
                  { u32x2 w; w.x = pk2(mlr[0], mlr[1]); w.y = pk2(mlr[2], mlr[3]); *(u32x2*)(p.ws + (size_t)(MLRo + 2u * (unsigned)fo)) = w; }
                  { u32x2 w; w.x = pk2(ntv[0], ntv[1]); w.y = pk2(ntv[2], ntv[3]); *(u32x2*)(p.ws + (size_t)(NTo + 8u * (unsigned)((nt * 4 + mt) * 64 + lane))) = w; }
                  if (!isctx) {
                      const bf16x8 aW20 = frag_tr(lds + I_W2, 0, 16 * mt, lane), aW21 = frag_tr(lds + I_W2, 32, 16 * mt, lane);
                      const bf16x8 aVv0 = frag_tr(vvimg, 0, 16 * mt, lane), aVv1 = frag_tr(vvimg, 32, 16 * mt, lane);
                      f32x4 rb = MFMA16(aW11, bPb1, MFMA16(aW10, bPb0, fz));
                      const f32x4 y0 = MFMA16(aVv1, bPk1, MFMA16(aVv0, bPk0, MFMA16(aW21, bPb1, MFMA16(aW20, bPb0, fz))));
                      rb += up4(*(const LAS u32x2*)(lds + I_RT + ioff(n, m0)));
                      { u32x2 w; w.x = pk2(rb[0], rb[1]); w.y = pk2(rb[2], rb[3]); *(u32x2*)(p.ws + (size_t)(RBo + 2u * (unsigned)fo)) = w; }
                      { u32x2 w; w.x = pk2(y0[0], y0[1]); w.y = pk2(y0[2], y0[3]); *(u32x2*)(p.ws + (size_t)(Yo + 2u * (unsigned)m0)) = w; }
                  } } }
#if XSCOPE
#pragma unroll
            for (int e = 0; e < 8; ++e) { r[e] = rn[e]; k[e] = kn[e]; }
#else
            if (cc + 1 < 34) {
#pragma unroll
                for (int e = 0; e < 8; ++e) { r[e] = rn[e]; k[e] = kn[e]; } }
#endif
        }
    }
}
#undef X_PXLOAD
#undef X_LERP
#undef X_LORA

struct SSet { bf16x8 A0, A1, R0, R1; u32x2 N0, Y0; f32x4 G; size_t yoff; };
__device__ __forceinline__ void phase_scanS(const Params& p, LAS unsigned char* lds, int bid, int G, int wv) {
    const int tid = my_tid(wv), lane = tid & 63, wave = __builtin_amdgcn_readfirstlane(tid >> 6);
    LAS unsigned char* HH = lds; LAS unsigned char* HL = lds + IMG;
    const int mtk = wave >> 1, ntl = wave & 1;
    const f32x4 fz = (f32x4){0.f, 0.f, 0.f, 0.f};
    for (int it = bid; it < NB * NH * 2 * 2; it += G) {
        const int item = it & 127, half = it >> 7, ntg = 2 * half + ntl;
        const int dir = item & 1, h = (item >> 1) & 7, b = item >> 4;
        f32x4 Hm0 = fz;
        LBAR();
        st_img(HH, 16 * ntl, 16 * mtk, lane, fz); st_img(HL, 16 * ntl, 16 * mtk, lane, fz);
        LBAR();
        const bf16_t* MLRg = (const bf16_t*)(p.ws + WS_MLR) + (size_t)item * 68 * 4096; const bf16_t* NTg = (const bf16_t*)(p.ws + WS_NT) + (size_t)item * 68 * 4096;
        const float* GAMg = (const float*)(p.ws + WS_GAM) + (size_t)item * 68 * 64; const bf16_t* RBg = (const bf16_t*)(p.ws + WS_RB) + (size_t)item * 64 * 4096;
        bf16_t* Yg = (bf16_t*)(p.ws + (dir ? WS_YB : WS_YF)) + (size_t)b * T * DR + h * 64;
        const int arow = (mtk * 2 * 64 + lane) * 8;
#define S_LOAD(S_, ci_) do { const int ci__ = (ci_) < 68 ? (ci_) : 67; const int c__ = ci__ >= 4 ? ci__ - 4 : 0; \
            const bf16_t* M__ = MLRg + (size_t)ci__ * 4096; S_.A0 = *(const bf16x8*)(M__ + arow); S_.A1 = *(const bf16x8*)(M__ + arow + 512); \
            S_.N0 = *(const u32x2*)(NTg + (size_t)ci__ * 4096 + lane * 4 + (ntg * 4 + mtk) * 256); \
            S_.G = *(const f32x4*)(GAMg + ci__ * 64 + 16 * mtk + 4 * (lane >> 4)); \
            const bf16_t* R__ = RBg + (size_t)c__ * 4096; S_.R0 = *(const bf16x8*)(R__ + arow); S_.R1 = *(const bf16x8*)(R__ + arow + 512); \
            const int pos__ = 64 * c__ + 16 * mtk + (lane & 15), t__ = dir ? (T - 1 - pos__) : pos__; \
            S_.yoff = (size_t)t__ * DR + 4 * (lane >> 4) + 16 * ntg; S_.Y0 = *(const u32x2*)(Yg + S_.yoff); } while (0)
#define S_STEP(S_, ci_) do { if ((ci_) < 68) { \
            const bf16x8 h00 = frag_rm(HH, 16 * ntl, 0, lane), h01 = frag_rm(HH, 16 * ntl, 32, lane); \
            const bf16x8 l00 = frag_rm(HL, 16 * ntl, 0, lane), l01 = frag_rm(HL, 16 * ntl, 32, lane); \
            f32x4 a0 = Hm0 * S_.G + up4(S_.N0); \
            a0 = MFMA16(S_.A0, h00, a0); a0 = MFMA16(S_.A1, h01, a0); a0 = MFMA16(S_.A0, l00, a0); a0 = MFMA16(S_.A1, l01, a0); \
            if ((ci_) >= 4) { \
                f32x4 y0 = up4(S_.Y0); \
                y0 = MFMA16(h00, S_.R0, y0); y0 = MFMA16(h01, S_.R1, y0); y0 = MFMA16(l00, S_.R0, y0); y0 = MFMA16(l01, S_.R1, y0); \
                { u32x2 w; w.x = pk2(y0[0], y0[1]); w.y = pk2(y0[2], y0[3]); *(u32x2*)(Yg + S_.yoff) = w; } } \
            LBAR(); \
            Hm0 = a0; \
            { f32x4 hi, lo; \
              _Pragma("unroll") for (int q = 0; q < 4; ++q) { hi[q] = __uint_as_float(f2bf(a0[q]) << 16); lo[q] = a0[q] - hi[q]; } \
              st_img(HH, 16 * ntl, 16 * mtk, lane, hi); st_img(HL, 16 * ntl, 16 * mtk, lane, lo); } \
            LBAR(); } } while (0)
        SSet s0, s1, s2, s3;
        S_LOAD(s0, 0); S_LOAD(s1, 1); S_LOAD(s2, 2);
        for (int ci = 0; ci < 68; ci += 4) {
            S_LOAD(s3, ci + 3); S_STEP(s0, ci);
            S_LOAD(s0, ci + 4); S_STEP(s1, ci + 1);
            S_LOAD(s1, ci + 5); S_STEP(s2, ci + 2);
            S_LOAD(s2, ci + 6); S_STEP(s3, ci + 3);
        }
#undef S_LOAD
#undef S_STEP
    }
}

__device__ __forceinline__ void phase_out(const Params& p, LAS unsigned char* lds, int bid, int G, int wv) {
    const int tid_ = my_tid(wv), lane_ = tid_ & 63, wave = __builtin_amdgcn_readfirstlane(tid_ >> 6);
    const bf16_t* PX = (const bf16_t*)(p.ws + WS_PX); const bf16_t* YF = (const bf16_t*)(p.ws + WS_YF); const bf16_t* YB = (const bf16_t*)(p.ws + WS_YB);
    const float* BDOT = (const float*)(p.ws + WS_BDOT);
    bf16_t* AX = (bf16_t*)(p.ws + WS_AX);
    const float* mu = p.in[9];
    constexpr int SGS = 272;
    LAS unsigned char* SG = lds;
    LAS unsigned char* GW = lds + 64 * SGS + wave * IMG;
    const f32x4 fz = (f32x4){0.f, 0.f, 0.f, 0.f};
    bf16x8 gf[4][4];
    { const float* gu = p.in[17] + wave * 64 + (lane_ & 15);
#pragma unroll
      for (int ct = 0; ct < 4; ++ct)
#pragma unroll
          for (int ks = 0; ks < 4; ++ks) { float f[8];
#pragma unroll
              for (int e = 0; e < 8; ++e) f[e] = gu[(size_t)(32 * ks + 8 * (lane_ >> 4) + e) * DR + 16 * ct];
              gf[ct][ks] = __builtin_bit_cast(bf16x8, pack8(f)); } }
    const int tokl = lane_ >> 3, cs = lane_ & 7, cb = wave * 64 + cs * 8;
    float gng[8], gnb[8];
    { const f32x4 g0 = *(const f32x4*)(p.in[18] + cb), g1 = *(const f32x4*)(p.in[18] + cb + 4), b0 = *(const f32x4*)(p.in[19] + cb), b1 = *(const f32x4*)(p.in[19] + cb + 4);
      gng[0] = g0.x; gng[1] = g0.y; gng[2] = g0.z; gng[3] = g0.w; gng[4] = g1.x; gng[5] = g1.y; gng[6] = g1.z; gng[7] = g1.w;
      gnb[0] = b0.x; gnb[1] = b0.y; gnb[2] = b0.z; gnb[3] = b0.w; gnb[4] = b1.x; gnb[5] = b1.y; gnb[6] = b1.z; gnb[7] = b1.w; }
    for (int bq = bid; bq < MX / 64; bq += G) {
        const int bt = (G == 256) ? ((bq & 7) * 64 + ((bq & 255) >> 3) * 2 + (bq >> 8)) : bq;
        const int tok0 = bt * 64, b = tok0 >> 12, rowbase = b * T;
        LBAR();
        { const int tid = opq(tid_), tl = tid >> 3, sub = tid & 7; const int tok = tok0 + tl, t = tok & (T - 1);
          int nbr[4]; neighbours(t, false, rowbase, nbr);
          const Px5 q0 = px_load(PX, tok, nbr, 1664 + sub * 16), q1 = px_load(PX, tok, nbr, 1664 + sub * 16 + 8);
          float x0[8], x1[8]; px_lerp(q0, false, 1664 + sub * 16, mu, x0); px_lerp(q1, false, 1664 + sub * 16 + 8, mu, x1);
#pragma unroll
          for (int e = 0; e < 8; ++e) { x0[e] = fsigmoid(x0[e]); x1[e] = fsigmoid(x1[e]); }
          *(LAS u32x4*)(SG + tl * SGS + sub * 32) = pack8(x0); *(LAS u32x4*)(SG + tl * SGS + sub * 32 + 16) = pack8(x1); }
        LBAR();
        { const int lane = opq(lane_);
#pragma unroll
          for (int tt = 0; tt < 4; ++tt) { bf16x8 bs[4];
#pragma unroll
              for (int ks = 0; ks < 4; ++ks) bs[ks] = *(const LAS bf16x8*)(SG + (16 * tt + (lane & 15)) * SGS + (32 * ks + 8 * (lane >> 4)) * 2);
#pragma unroll
              for (int ct = 0; ct < 4; ++ct) { f32x4 acc = fz;
#pragma unroll
                  for (int ks = 0; ks < 4; ++ks) acc = MFMA16(gf[ct][ks], bs[ks], acc);
                  st_img(GW, 16 * tt, 16 * ct, lane, acc); } } }
        asm volatile("s_waitcnt lgkmcnt(0)" ::: "memory");
#pragma unroll 2
        for (int ps = 0; ps < 8; ++ps) {
            const int lane = opq(lane_); const int tl = 8 * ps + (lane >> 3), tok = tok0 + tl, t = tok & (T - 1);
            int nbr[4]; neighbours(t, false, rowbase, nbr);
            const Px5 qv = px_load(PX, tok, nbr, 1024 + cb);
            float yf[8], yb[8], y[8], g[8], v[8];
            unpack8(*(const u32x4*)(YF + (size_t)tok * DR + cb), yf); unpack8(*(const u32x4*)(YB + (size_t)tok * DR + cb), yb);
            const float bd = BDOT[(size_t)tok * NH + wave] + BDOT[((size_t)MX + tok) * NH + wave];
            unpack8(*(const LAS u32x4*)(GW + ioff(tl, 8 * (lane & 7))), g);
            px_lerp(qv, false, 1024 + cb, mu, v);
            float s1 = 0.f;
#pragma unroll
            for (int e = 0; e < 8; ++e) { y[e] = yf[e] + yb[e]; s1 += y[e]; }
            const float mean = red8(s1) * (1.f / 64.f);
            float s2 = 0.f;
#pragma unroll
            for (int e = 0; e < 8; ++e) { y[e] -= mean; s2 += y[e] * y[e]; }
            const float rstd = rsqrtf(red8(s2) * (1.f / 64.f) + 64e-5f);
            float ax[8];
#pragma unroll
            for (int e = 0; e < 8; ++e) ax[e] = (y[e] * rstd * gng[e] + gnb[e] + bd * v[e]) * g[e];
            *(u32x4*)(AX + (size_t)tok * D + cb) = pack8(ax);
        }
        { const float* cwp = p.in[20] + cb;
          const f32x4 w00 = *(const f32x4*)(cwp), w01 = *(const f32x4*)(cwp + 4), w10 = *(const f32x4*)(cwp + DR), w11 = *(const f32x4*)(cwp + DR + 4), w20 = *(const f32x4*)(cwp + 2 * DR), w21 = *(const f32x4*)(cwp + 2 * DR + 4);
          const float cw0[8] = {w00.x, w00.y, w00.z, w00.w, w01.x, w01.y, w01.z, w01.w}, cw1[8] = {w10.x, w10.y, w10.z, w10.w, w11.x, w11.y, w11.z, w11.w}, cw2[8] = {w20.x, w20.y, w20.z, w20.w, w21.x, w21.y, w21.z, w21.w};
#pragma unroll 2
          for (int ps = 0; ps < 8; ++ps) {
              const int lane = opq(lane_); const int tok = tok0 + 8 * ps + (lane >> 3), t = tok & (T - 1);
              float bg[8], c0[8], u0[8], cm[8], um[8], cp[8], up[8];
              const u32x4 z = (u32x4){0u, 0u, 0u, 0u};
              const bf16_t* pr = PX + (size_t)tok * DIN + RWC + cb;
              unpack8(*(const u32x4*)pr, bg); unpack8(*(const u32x4*)(pr + 512), c0); unpack8(*(const u32x4*)(pr + 1024), u0);
              unpack8(t > 0 ? *(const u32x4*)(pr - DIN + 512) : z, cm); unpack8(t > 0 ? *(const u32x4*)(pr - DIN + 1024) : z, um);
              unpack8(t < T - 1 ? *(const u32x4*)(pr + DIN + 512) : z, cp); unpack8(t < T - 1 ? *(const u32x4*)(pr + DIN + 1024) : z, up);
              float bx[8];
#pragma unroll
              for (int e = 0; e < 8; ++e) bx[e] = bg[e] * (cw0[e] * (cm[e] * um[e]) + cw1[e] * (c0[e] * u0[e]) + cw2[e] * (cp[e] * up[e]));
              *(u32x4*)(AX + (size_t)tok * D + DR + cb) = pack8(bx);
          } }
    }
}

__device__ __forceinline__ void phase_hx(const Params& p, LAS unsigned char* lds, int bid, int G, int wv) {
    const int tid = my_tid(wv), lane = tid & 63, wave = tid >> 6;
    const bf16_t* X1 = (const bf16_t*)(p.ws + WS_X1); const float* MOD = (const float*)(p.ws + WS_MOD); const float* n2g = p.in[7];
    unsigned char* HX = p.ws + WS_HX; float* AFF = (float*)(p.ws + WS_AFF);
    LAS float* RW = (LAS float*)lds;
    { const float* rw = p.in[22]; for (int i = tid; i < 1024 * 16; i += NTHR) RW[(i & 15) * 1024 + (i >> 4)] = rw[i]; }
    __syncthreads();
    const int gw = bid * NWAVES + wave, NGW = G * NWAVES;
    const bool u5 = (lane & 32) != 0, u4 = (lane & 16) != 0, u3 = (lane & 8) != 0, u2 = (lane & 4) != 0;
    const int emine = (u5 ? 8 : 0) + (u4 ? 4 : 0) + (u3 ? 2 : 0) + (u2 ? 1 : 0);
    for (int blk = gw; blk < MX / 16; blk += NGW) {
        const int tokb = blk * 16, b = tokb >> 12;
        const float* sh = MOD + (size_t)b * 6144 + 3072; const float* scp = sh + 1024;
        f32x4 ga[4], hb[4];
#pragma unroll
        for (int j = 0; j < 4; ++j) { const int col = 4 * (lane + 64 * j); ga[j] = *(const f32x4*)(n2g + col) * (*(const f32x4*)(scp + col) + 1.f); hb[j] = *(const f32x4*)(sh + col); }
        u32x2 xq[2][4];
#pragma unroll
        for (int tk = 0; tk < 2; ++tk)
#pragma unroll
            for (int j = 0; j < 4; ++j) xq[tk][j] = ((const u32x2*)(X1 + (size_t)(tokb + tk) * D))[lane + 64 * j];
        for (int it = 0; it < 8; ++it) {
            f32x4 yv[2][4]; float lg[2][16];
            u32x2 xn[2][4];
            { const int itn = it < 7 ? it + 1 : it;
#pragma unroll
              for (int tk = 0; tk < 2; ++tk)
#pragma unroll
                for (int j = 0; j < 4; ++j) xn[tk][j] = ((const u32x2*)(X1 + (size_t)(tokb + 2 * itn + tk) * D))[lane + 64 * j]; }
#pragma unroll
            for (int tk = 0; tk < 2; ++tk) { const int tok = tokb + 2 * it + tk;
                f32x4 v[4]; float ss = 0.f;
#pragma unroll
                for (int j = 0; j < 4; ++j) { v[j] = up4(xq[tk][j]); ss += (v[j].x * v[j].x + v[j].y * v[j].y) + (v[j].z * v[j].z + v[j].w * v[j].w); }
                const float rstd = rsqrtf(wave_sum(ss) * (1.f / D) + 1e-6f);
#pragma unroll
                for (int j = 0; j < 4; ++j) { const f32x4 y = v[j] * rstd * ga[j] + hb[j]; yv[tk][j] = y;
#if MOE_FP8
                    *(unsigned*)(HX + (size_t)tok * D + 4 * (lane + 64 * j)) = pk4_fp8_raw(y.x, y.y, y.z, y.w); } }
#else
                    u32x2 o; o.x = pk2(y.x, y.y); o.y = pk2(y.z, y.w);
                    *(u32x2*)((bf16_t*)HX + (size_t)tok * D + 4 * (lane + 64 * j)) = o; } }
#endif
#pragma unroll
            for (int e = 0; e < 16; ++e) { float a0 = 0.f, a1 = 0.f;
#pragma unroll
                for (int j = 0; j < 4; ++j) { const f32x4 w = *(const LAS f32x4*)(RW + e * 1024 + 4 * (lane + 64 * j)); const f32x4 y0 = yv[0][j], y1 = yv[1][j];
                    a0 += (y0.x * w.x + y0.y * w.y) + (y0.z * w.z + y0.w * w.w); a1 += (y1.x * w.x + y1.y * w.y) + (y1.z * w.z + y1.w * w.w); }
                asm volatile("" : "+v"(a0), "+v"(a1) :: "memory");
                lg[0][e] = a0; lg[1][e] = a1; }
#pragma unroll
            for (int tk = 0; tk < 2; ++tk) { const int tok = tokb + 2 * it + tk, t = tok & (T - 1);
                float r8[8], r4[4], r2[2], r1;
#pragma unroll
                for (int k = 0; k < 8; ++k) { const float keep = u5 ? lg[tk][k + 8] : lg[tk][k], send = u5 ? lg[tk][k] : lg[tk][k + 8]; r8[k] = keep + __shfl_xor(send, 32); }
#pragma unroll
                for (int k = 0; k < 4; ++k) { const float keep = u4 ? r8[k + 4] : r8[k], send = u4 ? r8[k] : r8[k + 4]; r4[k] = keep + __shfl_xor(send, 16); }
#pragma unroll
                for (int k = 0; k < 2; ++k) { const float keep = u3 ? r4[k + 2] : r4[k], send = u3 ? r4[k] : r4[k + 2]; r2[k] = keep + __shfl_xor(send, 8); }
                { const float keep = u2 ? r2[1] : r2[0], send = u2 ? r2[0] : r2[1]; r1 = keep + __shfl_xor(send, 4); }
                r1 += __shfl_xor(r1, 1); r1 += __shfl_xor(r1, 2);
                float mx = r1;
                mx = fmaxf(mx, __shfl_xor(mx, 4)); mx = fmaxf(mx, __shfl_xor(mx, 8)); mx = fmaxf(mx, __shfl_xor(mx, 16)); mx = fmaxf(mx, __shfl_xor(mx, 32));
                const float ex = expf(r1 - mx);
                float den = ex;
                den += __shfl_xor(den, 4); den += __shfl_xor(den, 8); den += __shfl_xor(den, 16); den += __shfl_xor(den, 32);
                if ((lane & 3) == 0) AFF[((size_t)b * NE + emine) * T + t] = ex / den; }
#pragma unroll
            for (int tk = 0; tk < 2; ++tk)
#pragma unroll
                for (int j = 0; j < 4; ++j) xq[tk][j] = xn[tk][j];
        }
    }
}

__device__ __forceinline__ int block_scan512(int v, LAS int* sc, int tid, int& total) {
    const int lane = tid & 63, w = tid >> 6;
    int x = v;
#pragma unroll
    for (int o = 1; o < 64; o <<= 1) { const int y = __shfl_up(x, o); x += (lane >= o) ? y : 0; }
    if (lane == 63) sc[w] = x;
    __syncthreads();
    int base = 0, tot = 0;
#pragma unroll
    for (int i = 0; i < 8; ++i) { const int t = sc[i]; tot += t; base += (i < w) ? t : 0; }
    __syncthreads();
    total = tot; return base + x - v;
}
__device__ __forceinline__ void radix_round(const int (&bin)[8], const bool (&act)[8], int need, LAS int* hist, LAS int* sc, int tid, int& Bsel, int& aboveSel) {
#pragma unroll
    for (int q = 0; q < 8; ++q) hist[tid * 8 + q] = 0;
    __syncthreads();
#pragma unroll
    for (int q = 0; q < 8; ++q) if (act[q]) atomicAdd((int*)(hist + bin[q]), 1);
    __syncthreads();
    int c[8], ssum = 0;
#pragma unroll
    for (int q = 0; q < 8; ++q) { c[q] = hist[tid * 8 + q]; ssum += c[q]; }
    int total; const int P = block_scan512(ssum, sc, tid, total);
    int running = total - P - ssum;
#pragma unroll
    for (int q = 7; q >= 0; --q) { if (running < need && running + c[q] >= need) { sc[8] = tid * 8 + q; sc[9] = running; } running += c[q]; }
    __syncthreads();
    Bsel = sc[8]; aboveSel = sc[9];
    __syncthreads();
}
__device__ __forceinline__ void phase_topk(const Params& p, LAS unsigned char* lds, int bid, int G, int wv) {
    const int tid = my_tid(wv);
    const float* AFF = (const float*)(p.ws + WS_AFF);
    int* IDX = (int*)(p.ws + WS_IDX); float* VAL = (float*)(p.ws + WS_VAL); int* SEL = (int*)(p.ws + WS_SEL);
    LAS int* hist = (LAS int*)lds;
    LAS int* sc = (LAS int*)(lds + 16384);
    for (int item = bid; item < NB * NE; item += G) {
        const int b = item >> 4, e = item & 15;
        __syncthreads();
        const f32x4 v0 = ((const f32x4*)(AFF + (size_t)item * T))[2 * tid], v1 = ((const f32x4*)(AFF + (size_t)item * T))[2 * tid + 1];
        const float val[8] = {v0.x, v0.y, v0.z, v0.w, v1.x, v1.y, v1.z, v1.w};
        unsigned key[8]; int bin[8]; bool act[8];
#pragma unroll
        for (int q = 0; q < 8; ++q) { key[q] = __float_as_uint(val[q]); bin[q] = (int)(key[q] >> 20); act[q] = true; }
        int B1, ab1; radix_round(bin, act, CAP, hist, sc, tid, B1, ab1);
        const int need1 = CAP - ab1;
#pragma unroll
        for (int q = 0; q < 8; ++q) { act[q] = (int)(key[q] >> 20) == B1; bin[q] = (int)((key[q] >> 8) & 0xFFFu); }
        int B2, ab2; radix_round(bin, act, need1, hist, sc, tid, B2, ab2);
        const int need2 = need1 - ab2;
#pragma unroll
        for (int q = 0; q < 8; ++q) { act[q] = act[q] && (int)((key[q] >> 8) & 0xFFFu) == B2; bin[q] = (int)(key[q] & 0xFFu); }
        int B3, ab3; radix_round(bin, act, need2, hist, sc, tid, B3, ab3);
        const int need3 = need2 - ab3;
        const unsigned K = ((unsigned)B1 << 20) | ((unsigned)B2 << 8) | (unsigned)B3;
        int eqc = 0;
#pragma unroll
        for (int q = 0; q < 8; ++q) eqc += (key[q] == K) ? 1 : 0;
        int tot; int eqr = block_scan512(eqc, sc, tid, tot);
        bool selq[8]; int cnt = 0;
#pragma unroll
        for (int q = 0; q < 8; ++q) { const bool eq = key[q] == K; selq[q] = key[q] > K || (eq && eqr < need3); eqr += eq ? 1 : 0; cnt += selq[q] ? 1 : 0; }
        int slot = block_scan512(cnt, sc, tid, tot);
#pragma unroll
        for (int q = 0; q < 8; ++q) { const int tok = tid * 8 + q;
            SEL[(size_t)item * T + tok] = selq[q] ? slot : -1;
            if (selq[q]) { IDX[(e * NB + b) * CAP + slot] = b * T + tok; VAL[(e * NB + b) * CAP + slot] = val[q]; ++slot; } }
    }
}

__device__ __forceinline__ void phase_final(const Params& p, int bid, int G, int wv) {
    const int tid = my_tid(wv), lane = tid & 63, wave = tid >> 6;
    const bf16_t* X1 = (const bf16_t*)(p.ws + WS_X1); const bf16_t* DN = (const bf16_t*)(p.ws + WS_DN); const int* SEL = (const int*)(p.ws + WS_SEL);
    const float* fg = p.in[26];
    const int gw = bid * NWAVES + wave, NGW = G * NWAVES;
    for (int tok0 = gw; tok0 < MX; tok0 += 2 * NGW) {
        f32x4 v[2][4]; int sel[2]; unsigned long long mask[2];
#pragma unroll
        for (int tk = 0; tk < 2; ++tk) { const int tok = tok0 + tk * NGW, b = tok >> 12, t = tok & (T - 1);
            sel[tk] = lane < NE ? SEL[((size_t)b * NE + lane) * T + t] : -1;
#pragma unroll
            for (int j = 0; j < 4; ++j) v[tk][j] = up4(((const u32x2*)(X1 + (size_t)tok * D))[lane + 64 * j]); }
#pragma unroll
        for (int tk = 0; tk < 2; ++tk) mask[tk] = __ballot(sel[tk] >= 0);
#pragma unroll
        for (int tk = 0; tk < 2; ++tk) { const int tok = tok0 + tk * NGW, b = tok >> 12;
            unsigned long long m = mask[tk];
            while (m) {
#if MOE_FP8
                const unsigned char* rp[4]; float wg[4];
#pragma unroll
                for (int q = 0; q < 4; ++q) {
                    if (m) { const int e = __builtin_ctzll(m); m &= m - 1; const int s_ = __builtin_amdgcn_readlane(sel[tk], e);
                        rp[q] = (const unsigned char*)DN + ((size_t)(e * NB + b) * CAP + s_) * D; wg[q] = 1.f / 16.f; }
                    else { rp[q] = (const unsigned char*)DN; wg[q] = 0.f; } }
                unsigned w[4][4];
#pragma unroll
                for (int q = 0; q < 4; ++q)
#pragma unroll
                    for (int j = 0; j < 4; ++j) w[q][j] = *(const unsigned*)(rp[q] + 4 * (lane + 64 * j));
#pragma unroll
                for (int q = 0; q < 4; ++q)
#pragma unroll
                    for (int j = 0; j < 4; ++j) { const f32x2 lo = __builtin_amdgcn_cvt_pk_f32_fp8((int)w[q][j], false), hi = __builtin_amdgcn_cvt_pk_f32_fp8((int)w[q][j], true);
                        v[tk][j].x += wg[q] * lo.x; v[tk][j].y += wg[q] * lo.y; v[tk][j].z += wg[q] * hi.x; v[tk][j].w += wg[q] * hi.y; }
#else
                const bf16_t* rp[4]; float wg[4];
#pragma unroll
                for (int q = 0; q < 4; ++q) {
                    if (m) { const int e = __builtin_ctzll(m); m &= m - 1; const int s_ = __builtin_amdgcn_readlane(sel[tk], e);
                        rp[q] = DN + ((size_t)(e * NB + b) * CAP + s_) * D; wg[q] = 1.f; }
                    else { rp[q] = DN; wg[q] = 0.f; } }
                u32x2 w[4][4];
#pragma unroll
                for (int q = 0; q < 4; ++q)
#pragma unroll
                    for (int j = 0; j < 4; ++j) w[q][j] = *(const u32x2*)(rp[q] + 4 * (lane + 64 * j));
#pragma unroll
                for (int q = 0; q < 4; ++q)
#pragma unroll
                    for (int j = 0; j < 4; ++j) { v[tk][j].x += wg[q] * bflo(w[q][j].x); v[tk][j].y += wg[q] * bfhi(w[q][j].x); v[tk][j].z += wg[q] * bflo(w[q][j].y); v[tk][j].w += wg[q] * bfhi(w[q][j].y); }
#endif
            } }
#pragma unroll
        for (int tk = 0; tk < 2; ++tk) { const int tok = tok0 + tk * NGW;
            float ss = 0.f;
#pragma unroll
            for (int j = 0; j < 4; ++j) ss += (v[tk][j].x * v[tk][j].x + v[tk][j].y * v[tk][j].y) + (v[tk][j].z * v[tk][j].z + v[tk][j].w * v[tk][j].w);
            const float rstd = rsqrtf(wave_sum(ss) * (1.f / D) + 1e-6f);
#pragma unroll
            for (int j = 0; j < 4; ++j) { const int col = 4 * (lane + 64 * j); const f32x4 g = *(const f32x4*)(fg + col);
                *(f32x4*)(p.out + (size_t)tok * D + col) = v[tk][j] * rstd * g; } }
    }
}

#define XB_TMO      128
#define XB_XCNT(j)  (256  + 64 * (j))
#define XB_XSUB(j)  (1280 + 64 * (j))
#define XB_XGEN(j)  (2304 + 64 * (j))
#define XB_TOP      3328
#define XB_TOPGEN   3392
#define XCD_BAR_WORDS 3456
#define XB_SPIN_CAP (1u << 20)
__device__ __forceinline__ unsigned xb_ld(unsigned* p)              { return __hip_atomic_load(p, __ATOMIC_RELAXED, __HIP_MEMORY_SCOPE_AGENT); }
__device__ __forceinline__ unsigned xb_add(unsigned* p, unsigned v) { return __hip_atomic_fetch_add(p, v, __ATOMIC_RELAXED, __HIP_MEMORY_SCOPE_AGENT); }
__device__ __forceinline__ unsigned xb_xcc_id() { return (unsigned)__builtin_amdgcn_s_getreg((3 << 11) | 20) & 0xFu; }
#define XB_SPIN(cond, bar) do { unsigned _sp = 0; while (cond) { __builtin_amdgcn_s_sleep(1); \
    if ((++_sp & 255u) == 0u) { if (xb_ld(&(bar)[XB_TMO])) break; if (_sp > XB_SPIN_CAP) { atomicAdd(&(bar)[XB_TMO], 1u); break; } } } } while (0)
struct XcdBarrier { unsigned* bar; unsigned x; volatile LAS unsigned* st; int wv; };
__device__ __forceinline__ XcdBarrier xcd_barrier_post(unsigned* bar, volatile LAS unsigned* st, int wv) {
    XcdBarrier b; b.bar = bar; b.x = xb_xcc_id(); b.st = st; b.wv = wv;
    if (my_tid(wv) == 0) (void)xb_add(&bar[XB_XCNT(b.x)], 1u);
    return b;
}
__device__ __forceinline__ void xcd_barrier_complete(unsigned* bar, unsigned x, unsigned& nloc, unsigned& nx) {
    const unsigned G = gridDim.x * gridDim.y * gridDim.z;
    unsigned sum, cnt, mine, sp = 0u;
    for (;;) {
        sum = 0u; cnt = 0u; mine = 0u;
#pragma unroll
        for (unsigned j = 0; j < 16; ++j) { const unsigned c = xb_ld(&bar[XB_XCNT(j)]); sum += c; cnt += (c > 0u) ? 1u : 0u; mine = (j == x) ? c : mine; }
        if (sum == G) break;
        __builtin_amdgcn_s_sleep(1);
        if ((++sp & 255u) == 0u) { if (xb_ld(&bar[XB_TMO])) break; if (sp > XB_SPIN_CAP) { atomicAdd(&bar[XB_TMO], 1u); break; } }
    }
    nloc = mine > 0u ? mine : 1u; nx = cnt > 0u ? cnt : 1u;
}
__device__ __forceinline__ void xcd_barrier(const XcdBarrier& b) {
    asm volatile("s_waitcnt vmcnt(0)" ::: "memory");
    __syncthreads();
    if (my_tid(b.wv) == 0) {
        unsigned* bar = b.bar;
        __builtin_amdgcn_s_waitcnt(0);
        unsigned nloc = b.st[0], nx = b.st[1];
        if (nloc == 0u) { xcd_barrier_complete(bar, b.x, nloc, nx); b.st[0] = nloc; b.st[1] = nx; }
        const unsigned old = xb_add(&bar[XB_XSUB(b.x)], 1u);
        const unsigned gen = old / nloc;
        if (old + 1u == (gen + 1u) * nloc) {
            __builtin_amdgcn_fence(__ATOMIC_RELEASE, "agent");
            asm volatile("s_waitcnt vmcnt(0)" ::: "memory");
            const unsigned og = xb_add(&bar[XB_TOP], 1u);
            const unsigned tg = og / nx;
            if (og + 1u == (tg + 1u) * nx) xb_add(&bar[XB_TOPGEN], 1u);
            else XB_SPIN(xb_ld(&bar[XB_TOPGEN]) == tg, bar);
            __builtin_amdgcn_fence(__ATOMIC_ACQUIRE, "agent");
            xb_add(&bar[XB_XGEN(b.x)], 1u);
            asm volatile("s_waitcnt vmcnt(0)" ::: "memory");
        } else {
            XB_SPIN(xb_ld(&bar[XB_XGEN(b.x)]) == gen, bar);
            __builtin_amdgcn_fence(__ATOMIC_ACQUIRE, "agent");
            asm volatile("s_waitcnt vmcnt(0)" ::: "memory");
        }
    }
    __syncthreads();
}

constexpr int N_PHASES = 12;
__global__ void __launch_bounds__(NTHR, 2) mk_fwd(Params p) {
    extern __shared__ __attribute__((aligned(16))) unsigned char lds_raw[];
    LAS unsigned char* lds = (LAS unsigned char*)lds_raw;
    const int bid = blockIdx.x, G = gridDim.x;
    const int wv = __builtin_amdgcn_readfirstlane((int)threadIdx.x >> 6);
    const int lo = p.ph_lo, hi = p.ph_hi;
#if MK_FUSED
    volatile LAS unsigned* misc = (volatile LAS unsigned*)(lds + LDS_MISC);
    { const int t0 = my_tid(wv); if (t0 < 16) misc[t0] = 0u; }
    __syncthreads();
    const XcdBarrier xbar = xcd_barrier_post((unsigned*)(p.ws + WS_CTL) + 4096, misc, wv);
#define SEAM(k) do { if (lo <= (k) && (k) + 1 < hi) xcd_barrier(xbar); } while (0)
#else
#define SEAM(k) do { } while (0)
#endif
#ifndef PH_MASK
#define PH_MASK 0xFFF
#endif
#ifndef PH_REP
#define PH_REP 0
#endif
#define NREP(k) ((((PH_REP) >> (k)) & 1) ? 2 : 1)
#define IN(k) (((PH_MASK >> (k)) & 1) && lo <= (k) && (k) < hi)
    unsigned char* ws = sgpr_ptr(p.ws); unsigned char* outs = sgpr_ptr(p.out);
    if (IN(0)) { for (int r = 0; r < NREP(0); ++r) { phase0(p, lds, bid, G, wv); __syncthreads(); } SEAM(0); }
    if (IN(1)) { for (int r = 0; r < NREP(1); ++r) phase1(p, bid, G, wv); SEAM(1); }
    if (IN(2)) {
        pg8::Gemm g{(const bf16_t*)(ws + WS_XN), (const bf16_t*)(ws + WS_WINT), MALL, DIN, D, nullptr};
        pg8::InProjOrder S; S.init(G, bid);
        pg8::EpiBf16Plain E{(bf16_t*)(ws + WS_PX), DIN};
        pg8::gemm_phase<pg8::EpiBf16Plain, pg8::InProjOrder, true, true, false, false, PG8_BUF_IN>(lds, g, S, E, wv);
        SEAM(2);
    }
    for (int rep = 0; rep < NREP(4); ++rep) {
    if (IN(3)) { for (int r3 = 0; r3 < NREP(3); ++r3) phase_scanX(p, lds, bid, G, wv); SEAM(3); }
    if (IN(4)) { phase_scanS(p, lds, bid, G, wv); SEAM(4); }
    }
    if (IN(5)) { for (int r = 0; r < NREP(5); ++r) phase_out(p, lds, bid, G, wv); SEAM(5); }
    if (IN(6)) {
        pg8::Gemm g{(const bf16_t*)(ws + WS_AX), (const bf16_t*)(ws + WS_WOUTT), MX, D, D, nullptr};
        pg8::StaticOrder S; S.init(MX, D, G, bid);
        pg8::EpiResid E{p.in[0], (bf16_t*)(ws + WS_X1), (const float*)(ws + WS_MOD)};
        pg8::gemm_phase<pg8::EpiResid, pg8::StaticOrder, true, true, false, false, PG8_BUF_OUT>(lds, g, S, E, wv);
        SEAM(6);
    }
    if (IN(7)) { for (int r = 0; r < NREP(7); ++r) { phase_hx(p, lds, bid, G, wv); __syncthreads(); }
#if CVPOS == 0
        { const int tid = my_tid(wv), lane = tid & 63, gw = bid * NWAVES + (tid >> 6);
          for (int g = gw; g < 3 * 8192; g += G * NWAVES) { f32x4 cv[8]; xcvt_load(p, g, lane, cv); xcvt_store(p, g, lane, cv); } }
#endif
        SEAM(7); }
    if (IN(8)) { for (int r = 0; r < NREP(8); ++r) phase_topk(p, lds, bid, G, wv); SEAM(8); }
    if (IN(9)) {
        pg8::Gemm g{(const bf16_t*)(ws + WS_HX), (const bf16_t*)outs, NE * NB * CAP, NE * 2048, MOE_FP8 ? D / 2 : D, (const int*)(ws + WS_IDX)};
        pg8::ExpertOrder S; S.init(NE, 16, 8, G, bid);
        pg8::EpiSwiGLU E{ws + WS_HID};
        pg8::gemm_phase<pg8::EpiSwiGLU, pg8::ExpertOrder, true, true, true, MOE_FP8 != 0, PG8_BUF_MOE1>(lds, g, S, E, wv);
        SEAM(9);
    }
    if (IN(10)) {
        pg8::Gemm g{(const bf16_t*)(ws + WS_HID), (const bf16_t*)(outs + OUT_W2T), NE * NB * CAP, NE * 1024, MOE_FP8 ? DE / 2 : DE, nullptr};
        pg8::ExpertOrder S; S.init(NE, 16, 4, G, bid);
        pg8::EpiDown E{(bf16_t*)(ws + WS_DN), (const float*)(ws + WS_VAL), (const float*)(ws + WS_MOD)};
        pg8::gemm_phase<pg8::EpiDown, pg8::ExpertOrder, true, true, false, MOE_FP8 != 0, PG8_BUF_MOE2>(lds, g, S, E, wv);
        SEAM(10);
    }
    if (IN(11)) { for (int r = 0; r < NREP(11); ++r) phase_final(p, bid, G, wv); }
#undef IN
#undef SEAM
}

extern "C" void kernel_launch(void* const* d_in, const int* in_sizes, int n_in, void* d_out, int out_size, void* d_ws, size_t ws_size, hipStream_t stream) {
    static int grid = 0;
    if (grid == 0) {
        if (n_in != 27 || out_size != MX * D || ws_size < WS_END) { fprintf(stderr, "kernel_launch: unexpected shapes: n_in %d out %d ws %zu (need %zu)\n", n_in, out_size, ws_size, (size_t)WS_END); grid = -1; return; }
        int dev = 0, cus = 0, per_cu = 0;
        hipGetDevice(&dev); hipDeviceGetAttribute(&cus, hipDeviceAttributeMultiprocessorCount, dev);
        hipFuncSetAttribute((const void*)mk_fwd, hipFuncAttributeMaxDynamicSharedMemorySize, LDS_BYTES);
        hipOccupancyMaxActiveBlocksPerMultiprocessor(&per_cu, (const void*)mk_fwd, NTHR, LDS_BYTES);
        if (per_cu < 1) { fprintf(stderr, "kernel_launch: occupancy query says %d blocks per CU\n", per_cu); per_cu = 1; }
        (void)hipGetLastError();
        grid = cus;
    }
    if (grid < 0) return;
    Params p{};
    for (int i = 0; i < 27; ++i) p.in[i] = (const float*)d_in[i];
    p.out = (float*)d_out; p.ws = (unsigned char*)d_ws;
#if MK_FUSED
    (void)hipMemsetAsync((char*)d_ws + WS_CTL, 0, 65536, stream);
    p.ph_lo = 0; p.ph_hi = N_PHASES;
    void* args[] = {&p};
    hipError_t e = hipLaunchCooperativeKernel((const void*)mk_fwd, dim3(grid), dim3(NTHR), args, LDS_BYTES, stream);
    if (e != hipSuccess) fprintf(stderr, "cooperative launch failed: %s (grid %d)\n", hipGetErrorString(e), grid);
#else
    for (int ph = 0; ph < N_PHASES; ++ph) {
        p.ph_lo = ph; p.ph_hi = ph + 1;
        hipLaunchKernelGGL(mk_fwd, dim3(grid), dim3(NTHR), LDS_BYTES, stream, p);
    }
#endif
}
```

```cpp
#include <hip/hip_runtime.h>
#include <hip/hip_cooperative_groups.h>
#include <cstdio>
#include <cstdint>
namespace cg = cooperative_groups;

#ifndef MK_FUSED
#define MK_FUSED 1
#endif

#define LAS __attribute__((address_space(3)))
typedef unsigned short bf16_t;
typedef short bf16x8 __attribute__((ext_vector_type(8)));
typedef float f32x4 __attribute__((ext_vector_type(4)));
typedef unsigned u32x4 __attribute__((ext_vector_type(4)));
typedef unsigned u32x2 __attribute__((ext_vector_type(2)));
typedef int i32x8 __attribute__((ext_vector_type(8)));
typedef float f32x2 __attribute__((ext_vector_type(2)));
typedef int i32x4 __attribute__((ext_vector_type(4)));

#ifndef PG8_BUF_MOE1
#define PG8_BUF_MOE1 1
#endif
#ifndef PG8_BUF_MOE2
#define PG8_BUF_MOE2 1
#endif
#ifndef PG8_BUF_IN
#define PG8_BUF_IN 0
#endif
#ifndef PG8_BUF_OUT
#define PG8_BUF_OUT 0
#endif
#ifndef MOE_FP8
#define MOE_FP8 1
#endif
#ifndef XSCOPE
#define XSCOPE 0
#endif
#ifndef CVPOS
#define CVPOS 1
#endif
constexpr int NB = 8, T = 4096, D = 1024, CTXL = 256, DIN = 3328, RWC = 1792, NH = 8, HD = 64, DR = 512;
constexpr int NE = 16, CAP = 512, DE = 1024;
constexpr int MX = NB * T;
constexpr int MC = NB * CTXL;
constexpr int MALL = MX + MC;
constexpr int NWAVES = 8, NTHR = 512;
constexpr int LDS_BYTES = 163840;
constexpr int LDS_MISC = 154368;

constexpr size_t MiB = 1u << 20;
constexpr size_t WS_CTL = 0;
constexpr size_t WS_MOD = 1 * MiB;
constexpr size_t WS_BDOT = 2 * MiB;
constexpr size_t WS_AFF = 4 * MiB;
constexpr size_t WS_SEL = 6 * MiB;
constexpr size_t WS_GAM = 8 * MiB;
constexpr size_t WS_WOUTT = 11 * MiB;
constexpr size_t WS_IDX = 13 * MiB;
constexpr size_t WS_VAL = 13 * MiB + 256 * 1024;
constexpr size_t WS_MLR = 16 * MiB;
constexpr size_t WS_YF = 84 * MiB;
constexpr size_t WS_PX = 116 * MiB;
constexpr size_t WS_NT = 337 * MiB;
constexpr size_t WS_RB = 405 * MiB;
constexpr size_t WS_YB = 469 * MiB;
constexpr size_t WS_XN = 337 * MiB;
constexpr size_t WS_WINT = 405 * MiB;
constexpr size_t WS_AX = 337 * MiB;
constexpr size_t WS_X1 = 112 * MiB;
constexpr size_t WS_HX = 240 * MiB;
constexpr size_t WS_HID = 368 * MiB;
constexpr size_t WS_DN = 240 * MiB;
constexpr size_t WS_END = 501 * MiB;

struct Params { const float* in[27]; float* out; unsigned char* ws; int ph_lo, ph_hi; };

__device__ __forceinline__ unsigned f2bf(float f) { unsigned u = __float_as_uint(f); return (u + 0x7fffu + ((u >> 16) & 1u)) >> 16; }
typedef __bf16 hwbf16x2 __attribute__((ext_vector_type(2)));
typedef float f32x2_ __attribute__((ext_vector_type(2)));
__device__ __forceinline__ unsigned pk2(float lo, float hi) { const f32x2_ v = {lo, hi}; return __builtin_bit_cast(unsigned, __builtin_convertvector(v, hwbf16x2)); }
__device__ __forceinline__ float bflo(unsigned w) { return __uint_as_float(w << 16); }
__device__ __forceinline__ float bfhi(unsigned w) { return __uint_as_float(w & 0xffff0000u); }
__device__ __forceinline__ void unpack8(const u32x4 w, float (&f)[8]) {
    f[0] = bflo(w.x); f[1] = bfhi(w.x); f[2] = bflo(w.y); f[3] = bfhi(w.y); f[4] = bflo(w.z); f[5] = bfhi(w.z); f[6] = bflo(w.w); f[7] = bfhi(w.w); }
__device__ __forceinline__ u32x4 pack8(const float (&f)[8]) { u32x4 w; w.x = pk2(f[0], f[1]); w.y = pk2(f[2], f[3]); w.z = pk2(f[4], f[5]); w.w = pk2(f[6], f[7]); return w; }
__device__ __forceinline__ float wave_sum(float v) {
#pragma unroll
    for (int o = 1; o < 64; o <<= 1) v += __shfl_xor(v, o);
    return v;
}
__device__ __forceinline__ float wave_max(float v) {
#pragma unroll
    for (int o = 1; o < 64; o <<= 1) v = fmaxf(v, __shfl_xor(v, o));
    return v;
}
__device__ __forceinline__ float red8(float v) {
    v += __int_as_float(__builtin_amdgcn_update_dpp(0, __float_as_int(v), 0xB1, 0xF, 0xF, true));
    v += __int_as_float(__builtin_amdgcn_update_dpp(0, __float_as_int(v), 0x4E, 0xF, 0xF, true));
    v += __int_as_float(__builtin_amdgcn_update_dpp(0, __float_as_int(v), 0x141, 0xF, 0xF, true));
    return v;
}
__device__ __forceinline__ float sigmoidf_(float x) { return 1.f / (1.f + expf(-x)); }
__device__ __forceinline__ float fsigmoid(float x) { return __builtin_amdgcn_rcpf(1.f + __expf(-x)); }
__device__ __forceinline__ float ftanh(float x) { return 1.f - 2.f * __builtin_amdgcn_rcpf(1.f + __expf(2.f * x)); }

__device__ __forceinline__ float sat8(float x) { return __builtin_amdgcn_fmed3f(x, -448.f, 448.f); }
__device__ __forceinline__ unsigned pk4_fp8_raw(float a, float b, float c, float d) {
    int w = __builtin_amdgcn_cvt_pk_fp8_f32(a, b, 0, false); w = __builtin_amdgcn_cvt_pk_fp8_f32(c, d, w, true); return (unsigned)w; }
__device__ __forceinline__ unsigned pk4_fp8(float a, float b, float c, float d) { return pk4_fp8_raw(sat8(a), sat8(b), sat8(c), sat8(d)); }
constexpr float W8_SCALE = 64.f;
__device__ __forceinline__ int opq(int x) { asm volatile("" : "+v"(x)); return x; }
__device__ __forceinline__ int my_tid(int wv) { int l; asm volatile("v_mbcnt_lo_u32_b32 %0, -1, 0\n\tv_mbcnt_hi_u32_b32 %0, -1, %0" : "=v"(l)); return (wv << 6) | l; }
__device__ __forceinline__ unsigned char* sgpr_ptr(const void* q) {
    const unsigned long long v = (unsigned long long)(size_t)q;
    return (unsigned char*)(((unsigned long long)(unsigned)__builtin_amdgcn_readfirstlane((int)(v >> 32)) << 32) | (unsigned)__builtin_amdgcn_readfirstlane((int)(unsigned)v)); }
namespace pg8 {
#define PG8_LAS __attribute__((address_space(3)))
constexpr int BM = 256, BK = 64, HALF = 128, HTB = HALF * BK * 2, STAGE_BYTES = 8 * HTB, NXCD = 8, WGM = 8;
__host__ __device__ __forceinline__ int lds_byte(int r, int c) { const int st = (r >> 4) * 2 + (c >> 5), rr = r & 15, cc = c & 31, ob = rr * 64 + cc * 2; return st * 1024 + (ob ^ (((ob >> 9) & 1) << 5)); }
__host__ __device__ __forceinline__ void stage_rc(int b, int& R, int& C) { const int st = b / 1024, sb = b % 1024, swz = sb ^ (((sb >> 9) & 1) << 5); R = (st >> 1) * 16 + swz / 64; C = (st & 1) * 32 + (swz % 64) / 2; }
__host__ __device__ __forceinline__ int perm32(int rho) { const int n = rho >> 4, i = rho & 15; return 8 * (i >> 2) + 4 * n + (i & 3); }
struct Unit { int pm, pn; };
constexpr float WSC = MOE_FP8 ? 1.f / 64.f : 1.f;
struct Gemm { const bf16_t* A; const bf16_t* Bt; int M, N, K; const int* rowmap; };

__device__ __forceinline__ int xcd_remap(int wgid, int nwg) { const int q = nwg / NXCD, r = nwg % NXCD, xcd = wgid % NXCD, off = wgid / NXCD; return (xcd < r ? xcd * (q + 1) : r * (q + 1) + (xcd - r) * q) + off; }

struct StaticOrder {
    int nM, nN, nwg, G, c;
    __device__ void init(int M, int N, int G_, int c_) { nM = M / BM; nN = N / BM; nwg = nM * nN; G = G_; c = c_; }
    __device__ bool next(int i, Unit& u) const {
        const long L = (long)i * G + c; if (L >= nwg) return false;
        int wgid = xcd_remap((int)L, nwg);
        const int nig = WGM * nN, gid = wgid / nig, fm = gid * WGM, gsz = (nM - fm) < WGM ? (nM - fm) : WGM;
        u.pm = fm + ((wgid % nig) % gsz); u.pn = (wgid % nig) / gsz; return true;
    }
    __device__ __forceinline__ void a_ready(const Unit&) const {}
    __device__ __forceinline__ void done(const Unit&) const {}
};
struct InProjOrder {
    StaticOrder so; int G, c;
    __device__ void init(int G_, int c_) { so.init(MX, DIN, G_, c_); G = G_; c = c_; }
    __device__ bool next(int i, Unit& u) const {
        const long L = (long)i * G + c;
        if (L < so.nwg) return so.next(i, u);
        const int j = (int)(L - so.nwg); if (j >= 56) return false;
        u.pm = 128 + (j & 7); u.pn = j >> 3; return true;
    }
    __device__ __forceinline__ void a_ready(const Unit&) const {}
    __device__ __forceinline__ void done(const Unit&) const {}
};
struct ExpertOrder {
    int nPM, nPN, nwg, G, c;
    __device__ void init(int nE, int nPM_, int nPN_, int G_, int c_) { nPM = nPM_; nPN = nPN_; nwg = nE * nPM_ * nPN_; G = G_; c = c_; }
    __device__ bool next(int i, Unit& u) const {
        const long L = (long)i * G + c; if (L >= nwg) return false;
        const int wgid = xcd_remap((int)L, nwg);
        const int per = nPM * nPN, e = wgid / per, r = wgid % per;
        u.pm = e * nPM + (r % nPM); u.pn = e * nPN + (r / nPM); return true;
    }
    __device__ __forceinline__ void a_ready(const Unit&) const {}
    __device__ __forceinline__ void done(const Unit&) const {}
};

struct EpiBf16Plain {
    static constexpr bool PERM = true, AFTER_DRAIN = false;
    bf16_t* O; int ldc;
    __device__ __forceinline__ void operator()(const f32x4 (&acc)[2][2][4][2], const Unit& u, int wr, int wc, int fr, int fq) const {
        const int row0 = u.pm * BM + wr * 64 + fr, col0 = u.pn * BM + wc * 32 + 8 * fq;
#pragma unroll
        for (int ai = 0; ai < 2; ++ai)
#pragma unroll
            for (int m = 0; m < 4; ++m) { bf16_t* rowp = O + (size_t)(row0 + ai * HALF + m * 16) * ldc + col0;
#pragma unroll
                for (int bj = 0; bj < 2; ++bj) { const f32x4 v0 = acc[ai][bj][m][0], v1 = acc[ai][bj][m][1];
                    u32x4 w; w.x = pk2(v0[0], v0[1]); w.y = pk2(v0[2], v0[3]); w.z = pk2(v1[0], v1[1]); w.w = pk2(v1[2], v1[3]);
                    *(u32x4*)(rowp + bj * HALF) = w; } }
    }
};
struct EpiResid {
    static constexpr bool PERM = true, AFTER_DRAIN = false;
    const float* x; bf16_t* X1; const float* mod;
    __device__ __forceinline__ void operator()(const f32x4 (&acc)[2][2][4][2], const Unit& u, int wr, int wc, int fr, int fq) const {
        const int row0 = u.pm * BM + wr * 64 + fr, col0 = u.pn * BM + wc * 32 + 8 * fq;
        const float* g1 = mod + (size_t)(u.pm >> 4) * 6144 + 2048;
        f32x4 gv[2][2];
#pragma unroll
        for (int bj = 0; bj < 2; ++bj)
#pragma unroll
            for (int n = 0; n < 2; ++n) gv[bj][n] = *(const f32x4*)(g1 + col0 + bj * HALF + n * 4);
#pragma unroll
        for (int ai = 0; ai < 2; ++ai) { f32x4 xr[4][2][2];
#pragma unroll
            for (int m = 0; m < 4; ++m) { const size_t off = (size_t)(row0 + ai * HALF + m * 16) * D + col0;
#pragma unroll
                for (int bj = 0; bj < 2; ++bj) { xr[m][bj][0] = *(const f32x4*)(x + off + bj * HALF); xr[m][bj][1] = *(const f32x4*)(x + off + bj * HALF + 4); } }
#pragma unroll
            for (int m = 0; m < 4; ++m) { const size_t off = (size_t)(row0 + ai * HALF + m * 16) * D + col0;
#pragma unroll
                for (int bj = 0; bj < 2; ++bj) { const f32x4 v0 = xr[m][bj][0] + gv[bj][0] * acc[ai][bj][m][0], v1 = xr[m][bj][1] + gv[bj][1] * acc[ai][bj][m][1];
                    u32x4 w; w.x = pk2(v0[0], v0[1]); w.y = pk2(v0[2], v0[3]); w.z = pk2(v1[0], v1[1]); w.w = pk2(v1[2], v1[3]);
                    *(u32x4*)(X1 + off + bj * HALF) = w; } } }
    }
};
struct EpiSwiGLU {
    static constexpr bool PERM = true, AFTER_DRAIN = false;
    unsigned char* H;
    __device__ __forceinline__ void operator()(const f32x4 (&acc)[2][2][4][2], const Unit& u, int wr, int wc, int fr, int fq) const {
        const int row0 = u.pm * BM + wr * 64 + fr, col0 = (u.pn & 7) * 128 + wc * 32 + 8 * fq;
        const __amdgpu_buffer_rsrc_t rsH = __builtin_amdgcn_make_buffer_rsrc((void*)H, 0, 0x80000000u, 0x00020000);
#pragma unroll
        for (int ai = 0; ai < 2; ++ai)
#pragma unroll
            for (int m = 0; m < 4; ++m) { float h[8];
#pragma unroll
                for (int n = 0; n < 2; ++n)
#pragma unroll
                    for (int q = 0; q < 4; ++q) { const float g = acc[ai][0][m][n][q] * WSC, up = acc[ai][1][m][n][q] * WSC; h[n * 4 + q] = g / (1.f + __expf(-g)) * up; }
#if MOE_FP8
                u32x2 w; w.x = pk4_fp8(h[0], h[1], h[2], h[3]); w.y = pk4_fp8(h[4], h[5], h[6], h[7]);
                __builtin_amdgcn_raw_buffer_store_b64(w, rsH, (unsigned)((row0 + ai * HALF + m * 16) * DE + col0), 0, 0); }
#else
                u32x4 w; w.x = pk2(h[0], h[1]); w.y = pk2(h[2], h[3]); w.z = pk2(h[4], h[5]); w.w = pk2(h[6], h[7]);
                *(u32x4*)((bf16_t*)H + (size_t)(row0 + ai * HALF + m * 16) * DE + col0) = w; }
#endif
    }
};
struct EpiDown {
    static constexpr bool PERM = true, AFTER_DRAIN = false;
    bf16_t* O; const float* val; const float* mod;
    __device__ __forceinline__ void operator()(const f32x4 (&acc)[2][2][4][2], const Unit& u, int wr, int wc, int fr, int fq) const {
        const int row0 = u.pm * BM + wr * 64 + fr, col0 = (u.pn & 3) * BM + wc * 32 + 8 * fq;
        const int b = (u.pm & 15) >> 1;
        const unsigned char* mods = sgpr_ptr(mod); const unsigned char* vals_ = sgpr_ptr(val); unsigned char* Os = sgpr_ptr(O);
        f32x4 gv[2][2];
#pragma unroll
        for (int bj = 0; bj < 2; ++bj)
#pragma unroll
            for (int n = 0; n < 2; ++n) gv[bj][n] = *(const f32x4*)(mods + (size_t)(unsigned)((b * 6144 + 5120 + col0 + bj * HALF + n * 4) * 4));
        float vals[2][4];
#pragma unroll
        for (int ai = 0; ai < 2; ++ai)
#pragma unroll
            for (int m = 0; m < 4; ++m) vals[ai][m] = *(const float*)(vals_ + (size_t)(unsigned)((row0 + ai * HALF + m * 16) * 4));
#pragma unroll
        for (int ai = 0; ai < 2; ++ai)
#pragma unroll
#if MOE_FP8
            for (int m = 0; m < 4; ++m) { const int row = row0 + ai * HALF + m * 16; const float vv = vals[ai][m] * 0.25f; unsigned char* rowp = Os + (size_t)(unsigned)(row * D + col0);
#pragma unroll
                for (int bj = 0; bj < 2; ++bj) { const f32x4 v0 = acc[ai][bj][m][0] * gv[bj][0] * vv, v1 = acc[ai][bj][m][1] * gv[bj][1] * vv;
                    u32x2 w; w.x = pk4_fp8(v0[0], v0[1], v0[2], v0[3]); w.y = pk4_fp8(v1[0], v1[1], v1[2], v1[3]);
                    *(u32x2*)(Os + (size_t)(unsigned)(row * D + col0 + bj * HALF)) = w; } }
#else
            for (int m = 0; m < 4; ++m) { const int row = row0 + ai * HALF + m * 16; const float vv = vals[ai][m] * WSC; bf16_t* rowp = (bf16_t*)Os + (size_t)row * D + col0;
#pragma unroll
                for (int bj = 0; bj < 2; ++bj) { const f32x4 v0 = acc[ai][bj][m][0] * gv[bj][0] * vv, v1 = acc[ai][bj][m][1] * gv[bj][1] * vv;
                    u32x4 w; w.x = pk2(v0[0], v0[1]); w.y = pk2(v0[2], v0[3]); w.z = pk2(v1[0], v1[1]); w.w = pk2(v1[2], v1[3]);
                    *(u32x4*)(rowp + bj * HALF) = w; } }
#endif
    }
};

template <class Epi, class Sched, bool ALIGN_EPI = false, bool SP2 = false, bool GATHER = false, bool FP8 = false, int BUF = 0>
__device__ __forceinline__ void gemm_phase(PG8_LAS unsigned char* lds, const Gemm g, const Sched& S, const Epi& E, int wv) {
    const int tid = my_tid(wv), wid = __builtin_amdgcn_readfirstlane(tid >> 6), lane = tid & 63, wr = wid >> 2, wc = wid & 3, fr = lane & 15, fq = lane >> 4;
    const int K = g.K, nt = K / BK;
    unsigned voffA[2], voffB[2]; int gR[2]; unsigned gC[2];
#pragma unroll
    for (int i = 0; i < 2; ++i) { int R, C; stage_rc(tid * 16 + i * 8192, R, C); const int Rb = Epi::PERM ? ((R & ~31) + perm32(R & 31)) : R;
        voffA[i] = (unsigned)(R * K + C) * 2u; voffB[i] = (unsigned)(Rb * K + C) * 2u; gR[i] = R; gC[i] = (unsigned)C * 2u; }
    const __amdgpu_buffer_rsrc_t rsM = __builtin_amdgcn_make_buffer_rsrc((void*)g.rowmap, 0, 0x80000000u, 0x00020000);
    unsigned gAc[2][2], gAn[2][2];
#define PG8_GLOAD(dst, pm_) do { const int _t = my_tid(wv); _Pragma("unroll") for (int _i = 0; _i < 2; ++_i) { int _R, _C; stage_rc(_t * 16 + _i * 8192, _R, _C);     \
        _Pragma("unroll") for (int _h = 0; _h < 2; ++_h) dst[_h][_i] = (unsigned)__builtin_amdgcn_raw_buffer_load_b32(rsM, (unsigned)(((pm_) * BM + _h * HALF + _R) * 4), 0, 0) * (unsigned)(K * 2) + (unsigned)_C * 2u; } } while (0)
    const unsigned kstep = (unsigned)(BK * 2);
    const unsigned hstep = (unsigned)(HALF * K * 2);
    const unsigned tstep = 2u * hstep;
    const unsigned long long uA = ((unsigned long long)(unsigned)__builtin_amdgcn_readfirstlane((int)((unsigned long long)(size_t)g.A >> 32)) << 32) | (unsigned)__builtin_amdgcn_readfirstlane((int)(unsigned)(size_t)g.A);
    const unsigned long long uB = ((unsigned long long)(unsigned)__builtin_amdgcn_readfirstlane((int)((unsigned long long)(size_t)g.Bt >> 32)) << 32) | (unsigned)__builtin_amdgcn_readfirstlane((int)(unsigned)(size_t)g.Bt);
    const __amdgpu_buffer_rsrc_t rsA = __builtin_amdgcn_make_buffer_rsrc((void*)uA, 0, 0x80000000u, 0x00020000);
    const __amdgpu_buffer_rsrc_t rsB = __builtin_amdgcn_make_buffer_rsrc((void*)uB, 0, 0x80000000u, 0x00020000);
    const unsigned ldsw = (unsigned)wid * 1024u;
    const int aoff = lds_byte(wr * 64 + fr, fq * 8), boff = lds_byte(wc * 32 + fr, fq * 8);
#define PG8_SA(b, h) (((b) * 2 + (h)) * HTB)
#define PG8_SB(b, h) ((4 + (b) * 2 + (h)) * HTB)
#define PG8_GLDS(ldsp, v32, gp) asm volatile("s_mov_b32 m0, %0\n\ts_nop 0\n\tglobal_load_lds_dwordx4 %1, %2" :: "s"(__builtin_amdgcn_readfirstlane((int)(size_t)(ldsp))), "v"(v32), "s"(gp) : "memory", "m0")
#define PG8_STAGE(bufoff, goff, voff) do { _Pragma("unroll") for (int _i = 0; _i < 2; ++_i) { \
        if constexpr (BUF == 1 || BUF == 3) __builtin_amdgcn_raw_ptr_buffer_load_lds(rsB, (PG8_LAS void*)(lds + (bufoff) + ldsw + _i * 8192), 16, (voff)[_i], (goff), 0, 0); \
        else if constexpr (BUF == 2) PG8_GLDS(lds + (bufoff) + ldsw + _i * 8192, (voff)[_i] + (unsigned)__builtin_amdgcn_readfirstlane((int)(goff)), (const char*)uB); \
        else __builtin_amdgcn_global_load_lds((const unsigned*)((const char*)g.Bt + (size_t)((goff) + (voff)[_i])), (PG8_LAS unsigned*)(lds + (bufoff) + ldsw + _i * 8192), 16, 0, 0); } } while (0)
#define PG8_STA(bufoff, koff, h, nx) do { _Pragma("unroll") for (int _i = 0; _i < 2; ++_i) { \
        const unsigned _v = GATHER ? ((nx) ? gAn[h][_i] : gAc[h][_i]) : voffA[_i]; const unsigned _s = GATHER ? (koff) : (koff) + (unsigned)(h) * hstep; \
        if constexpr (BUF == 1) __builtin_amdgcn_raw_ptr_buffer_load_lds(rsA, (PG8_LAS void*)(lds + (bufoff) + ldsw + _i * 8192), 16, _v, _s, 0, 0); \
        else if constexpr (BUF == 2 || BUF == 3) PG8_GLDS(lds + (bufoff) + ldsw + _i * 8192, _v + (unsigned)__builtin_amdgcn_readfirstlane((int)_s), (const char*)uA); \
        else __builtin_amdgcn_global_load_lds((const unsigned*)((const char*)g.A + (size_t)(_s + _v)), (PG8_LAS unsigned*)(lds + (bufoff) + ldsw + _i * 8192), 16, 0, 0); } } while (0)
#define PG8_LDA(dst, b, h) do { _Pragma("unroll") for (int m = 0; m < 4; ++m) _Pragma("unroll") for (int k = 0; k < 2; ++k) dst[m][k] = *(const PG8_LAS bf16x8*)(lds + PG8_SA(b, h) + aoff + m * 2048 + k * 1024); } while (0)
#define PG8_LDB(dst, b, h) do { _Pragma("unroll") for (int n = 0; n < 2; ++n) _Pragma("unroll") for (int k = 0; k < 2; ++k) dst[n][k] = *(const PG8_LAS bf16x8*)(lds + PG8_SB(b, h) + boff + n * 2048 + k * 1024); } while (0)
#define PG8_CAT(f) __builtin_shufflevector(__builtin_bit_cast(i32x4, (f)[0]), __builtin_bit_cast(i32x4, (f)[1]), 0, 1, 2, 3, 4, 5, 6, 7)
#define PG8_MMA(ai, bj, At, Bt) do { __builtin_amdgcn_s_setprio(1); \
        if constexpr (FP8) { _Pragma("unroll") for (int m = 0; m < 4; ++m) _Pragma("unroll") for (int n = 0; n < 2; ++n) \
            acc[ai][bj][m][n] = __builtin_amdgcn_mfma_scale_f32_16x16x128_f8f6f4(PG8_CAT(Bt[n]), PG8_CAT(At[m]), acc[ai][bj][m][n], 0, 0, 0, 0, 0, 0); } \
        else { _Pragma("unroll") for (int m = 0; m < 4; ++m) _Pragma("unroll") for (int n = 0; n < 2; ++n) _Pragma("unroll") for (int k = 0; k < 2; ++k) \
            acc[ai][bj][m][n] = __builtin_amdgcn_mfma_f32_16x16x32_bf16(Bt[n][k], At[m][k], acc[ai][bj][m][n], 0, 0, 0); } \
        __builtin_amdgcn_s_setprio(0); } while (0)
#define PG8_WAIT_V(n) asm volatile("s_waitcnt vmcnt(" #n ")" ::: "memory")
#define PG8_WAIT_L(n) asm volatile("s_waitcnt lgkmcnt(" #n ")" ::: "memory")
#define PG8_BAR __builtin_amdgcn_s_barrier()
#define PG8_SCHED __builtin_amdgcn_sched_barrier(0)
    Unit cur, nxt; int ui = 0;
    if (!S.next(0, cur)) return;
    f32x4 acc[2][2][4][2];
#pragma unroll
    for (int a = 0; a < 2; ++a)
#pragma unroll
        for (int b = 0; b < 2; ++b)
#pragma unroll
            for (int m = 0; m < 4; ++m)
#pragma unroll
                for (int n = 0; n < 2; ++n) { acc[a][b][m][n] = (f32x4){0.f, 0.f, 0.f, 0.f}; if constexpr (FP8) asm volatile("" : "+v"(acc[a][b][m][n])); }
    bf16x8 At[4][2], B0[2][2], B1[2][2];
    unsigned cA = GATHER ? 0u : (unsigned)cur.pm * tstep, cB = (unsigned)cur.pn * tstep;
    if constexpr (GATHER) { PG8_GLOAD(gAc, cur.pm); }
    S.a_ready(cur);
    if constexpr (SP2) {
        PG8_STAGE(PG8_SB(0, 0), cB, voffB); PG8_STAGE(PG8_SB(0, 1), cB + hstep, voffB); PG8_STA(PG8_SA(0, 0), cA, 0, false); PG8_STA(PG8_SA(0, 1), cA, 1, false);
        if (wr == 1) PG8_BAR;
        PG8_WAIT_V(2); PG8_BAR;
        PG8_STAGE(PG8_SB(1, 0), cB + kstep, voffB); PG8_STA(PG8_SA(1, 0), cA + kstep, 0, false); PG8_STAGE(PG8_SB(1, 1), cB + hstep + kstep, voffB);
        PG8_WAIT_V(6); PG8_BAR;
    } else {
        PG8_STAGE(PG8_SB(0, 0), cB, voffB); PG8_STA(PG8_SA(0, 0), cA, 0, false); PG8_STAGE(PG8_SB(0, 1), cB + hstep, voffB); PG8_STA(PG8_SA(0, 1), cA, 1, false);
        if (wr == 1) PG8_BAR;
        PG8_WAIT_V(4); PG8_BAR;
        PG8_STAGE(PG8_SB(1, 0), cB + kstep, voffB); PG8_STA(PG8_SA(1, 0), cA + kstep, 0, false); PG8_STAGE(PG8_SB(1, 1), cB + hstep + kstep, voffB);
        PG8_WAIT_V(6); PG8_BAR;
    }
    for (;;) {
        const bool has_next = S.next(ui + 1, nxt);
        const unsigned nA = GATHER ? cA : (has_next ? (unsigned)nxt.pm * tstep : cA), nB = has_next ? (unsigned)nxt.pn * tstep : cB;
        if constexpr (GATHER) { if (has_next) { PG8_GLOAD(gAn, nxt.pm); } else {
#pragma unroll
            for (int _h = 0; _h < 2; ++_h)
#pragma unroll
                for (int _i = 0; _i < 2; ++_i) gAn[_h][_i] = gAc[_h][_i]; } }
#pragma unroll 1
        for (int t = 0; t < nt; t += 2) {
            const bool last = (t == nt - 2);
            const unsigned a1 = cA + (unsigned)(t + 1) * kstep;
            const unsigned a2 = last ? nA : cA + (unsigned)(t + 2) * kstep, b2 = last ? nB : cB + (unsigned)(t + 2) * kstep;
            const unsigned a3 = a2 + kstep, b3 = b2 + kstep;
            if (last && has_next) S.a_ready(nxt);
            if constexpr (SP2) {
            PG8_LDB(B0, 0, 0); PG8_LDB(B1, 0, 1); PG8_SCHED; PG8_LDA(At, 0, 0); PG8_STA(PG8_SA(1, 1), a1, 1, false);
            PG8_WAIT_V(8); PG8_WAIT_L(0); PG8_BAR; PG8_MMA(0, 0, At, B0); PG8_MMA(0, 1, At, B1); PG8_BAR; PG8_SCHED;
            PG8_LDA(At, 0, 1); PG8_STAGE(PG8_SB(0, 0), b2, voffB); PG8_STAGE(PG8_SB(0, 1), b2 + hstep, voffB); PG8_STA(PG8_SA(0, 0), a2, 0, last);
            PG8_WAIT_V(8); PG8_WAIT_L(0); PG8_BAR; PG8_MMA(1, 0, At, B0); PG8_MMA(1, 1, At, B1); PG8_BAR; PG8_SCHED;
            PG8_LDB(B0, 1, 0); PG8_LDB(B1, 1, 1); PG8_SCHED; PG8_LDA(At, 1, 0); PG8_STA(PG8_SA(0, 1), a2, 1, last);
            PG8_WAIT_V(8); PG8_WAIT_L(0); PG8_BAR; PG8_MMA(0, 0, At, B0); PG8_MMA(0, 1, At, B1); PG8_BAR; PG8_SCHED;
            PG8_LDA(At, 1, 1); PG8_STAGE(PG8_SB(1, 0), b3, voffB); PG8_STAGE(PG8_SB(1, 1), b3 + hstep, voffB); PG8_STA(PG8_SA(1, 0), a3, 0, last);
            PG8_WAIT_V(8); PG8_WAIT_L(0); PG8_BAR; PG8_MMA(1, 0, At, B0); PG8_MMA(1, 1, At, B1); PG8_BAR; PG8_SCHED;
            } else {
            PG8_LDB(B0, 0, 0); PG8_SCHED; PG8_LDA(At, 0, 0); PG8_STA(PG8_SA(1, 1), a1, 1, false);
            PG8_WAIT_L(8); PG8_BAR; PG8_WAIT_L(0); PG8_MMA(0, 0, At, B0); PG8_BAR; PG8_SCHED;
            PG8_LDB(B1, 0, 1); PG8_STAGE(PG8_SB(0, 0), b2, voffB);
            PG8_BAR; PG8_WAIT_L(0); PG8_MMA(0, 1, At, B1); PG8_BAR;
            PG8_LDA(At, 0, 1); PG8_STA(PG8_SA(0, 0), a2, 0, last);
            PG8_BAR; PG8_WAIT_L(0); PG8_MMA(1, 0, At, B0); PG8_BAR; PG8_SCHED;
            PG8_STAGE(PG8_SB(0, 1), b2 + hstep, voffB);
            PG8_WAIT_V(6); PG8_BAR; PG8_MMA(1, 1, At, B1); PG8_BAR;
            PG8_LDB(B0, 1, 0); PG8_SCHED; PG8_LDA(At, 1, 0); PG8_STA(PG8_SA(0, 1), a2, 1, last);
            PG8_WAIT_L(8); PG8_BAR; PG8_WAIT_L(0); PG8_MMA(0, 0, At, B0); PG8_BAR; PG8_SCHED;
            PG8_LDB(B1, 1, 1); PG8_STAGE(PG8_SB(1, 0), b3, voffB);
            PG8_BAR; PG8_WAIT_L(0); PG8_MMA(0, 1, At, B1); PG8_BAR;
            PG8_LDA(At, 1, 1); PG8_STA(PG8_SA(1, 0), a3, 0, last);
            PG8_BAR; PG8_WAIT_L(0); PG8_MMA(1, 0, At, B0); PG8_BAR; PG8_SCHED;
            PG8_STAGE(PG8_SB(1, 1), b3 + hstep, voffB);
            PG8_WAIT_V(6); PG8_BAR; PG8_MMA(1, 1, At, B1); PG8_BAR;
            }
        }
        if constexpr (ALIGN_EPI) { if (wr == 0) PG8_BAR; }
        if constexpr (!Epi::AFTER_DRAIN) { const int _l = my_tid(wv) & 63; E(acc, cur, wr, wc, _l & 15, _l >> 4); S.done(cur); }
        if (!has_next) break;
#pragma unroll
        for (int a = 0; a < 2; ++a)
#pragma unroll
            for (int b = 0; b < 2; ++b)
#pragma unroll
                for (int m = 0; m < 4; ++m)
#pragma unroll
                    for (int n = 0; n < 2; ++n) { acc[a][b][m][n] = (f32x4){0.f, 0.f, 0.f, 0.f}; if constexpr (FP8) asm volatile("" : "+v"(acc[a][b][m][n])); }
        cur = nxt; cA = nA; cB = nB; ++ui;
        if constexpr (GATHER) {
#pragma unroll
            for (int _h = 0; _h < 2; ++_h)
#pragma unroll
                for (int _i = 0; _i < 2; ++_i) gAc[_h][_i] = gAn[_h][_i]; }
        if constexpr (ALIGN_EPI) { if (wr == 1) PG8_BAR; }
    }
    PG8_WAIT_V(0);
    if constexpr (!ALIGN_EPI) { if (wr == 0) PG8_BAR; }
    PG8_BAR;
#undef PG8_SA
#undef PG8_SB
#undef PG8_STAGE
#undef PG8_STA
#undef PG8_GLDS
#undef PG8_GLOAD
#undef PG8_LDA
#undef PG8_LDB
#undef PG8_MMA
#undef PG8_CAT
#undef PG8_WAIT_V
#undef PG8_WAIT_L
#undef PG8_BAR
#undef PG8_SCHED
}
}

#define LDS_WAIT() asm volatile("s_waitcnt lgkmcnt(0)" ::: "memory")
#define LBAR() do { asm volatile("s_waitcnt lgkmcnt(0)" ::: "memory"); __builtin_amdgcn_s_barrier(); asm volatile("" ::: "memory"); } while (0)

__device__ __forceinline__ void cvt_item(const float* W, int K, int N, bf16_t* WT, int mode, int item, int lane) {
    const int nblk = N / 64, kb = item / nblk, nb = item % nblk, k0 = 64 * kb, n0 = 64 * nb;
    const int rbase = mode == 0 ? n0 : ((n0 >> 7) * 256 + (n0 & 127) + (mode == 2 ? 128 : 0));
    const int r = lane >> 4, c4 = lane & 15;
    const float* src = W + (size_t)(k0 + 16 * r) * N + n0 + 4 * c4;
    f32x4 v[16];
#pragma unroll
    for (int i = 0; i < 16; ++i) v[i] = *(const f32x4*)(src + (size_t)i * N);
    bf16_t* dst = WT + (size_t)(rbase + 4 * c4) * K + k0 + 16 * r;
#pragma unroll
    for (int q = 0; q < 4; ++q)
#pragma unroll
        for (int hh = 0; hh < 2; ++hh) { u32x4 o;
            o.x = pk2(v[8 * hh + 0][q], v[8 * hh + 1][q]); o.y = pk2(v[8 * hh + 2][q], v[8 * hh + 3][q]); o.z = pk2(v[8 * hh + 4][q], v[8 * hh + 5][q]); o.w = pk2(v[8 * hh + 6][q], v[8 * hh + 7][q]);
            *(u32x4*)(dst + (size_t)q * K + 8 * hh) = o; }
}

__device__ __forceinline__ void phase0(const Params& p, LAS unsigned char* lds, int bid, int G, int wv) {
    const int tid = my_tid(wv), lane = tid & 63, wave = tid >> 6;
    unsigned char* ws = p.ws;
    if (bid < 192) {
        LAS float* sc = (LAS float*)lds;
        LAS float* part = sc + 9 * 1024;
        const float* c = p.in[1]; const float* cctx = p.in[3]; const float* ada_w = p.in[4]; const float* ada_b = p.in[5];
        float* MOD = (float*)(ws + WS_MOD);
        for (int i = tid; i < 9 * 1024; i += NTHR) { const int r = i >> 10, k = i & 1023; const float v = r < 8 ? c[r * 1024 + k] : cctx[k]; sc[i] = v / (1.f + expf(-v)); }
        __syncthreads();
        for (int it = bid; it < 192; it += G) {
            const int col = tid & 31, kg = tid >> 5;
            float acc[9];
#pragma unroll
            for (int r = 0; r < 9; ++r) acc[r] = 0.f;
            const float* w = ada_w + (size_t)(kg * 64) * 6144 + it * 32 + col;
#pragma unroll 16
            for (int k = 0; k < 64; ++k) { const float wv = w[(size_t)k * 6144];
#pragma unroll
                for (int r = 0; r < 9; ++r) acc[r] += sc[r * 1024 + kg * 64 + k] * wv; }
#pragma unroll
            for (int r = 0; r < 9; ++r) part[(kg * 9 + r) * 32 + col] = acc[r];
            __syncthreads();
            for (int o = tid; o < 288; o += NTHR) { const int r = o >> 5, cc = o & 31; float s_ = ada_b[it * 32 + cc];
#pragma unroll
                for (int q = 0; q < 16; ++q) s_ += part[(q * 9 + r) * 32 + cc];
                MOD[r * 6144 + it * 32 + cc] = s_; }
            __syncthreads();
        }
    }
    {
        const int gw = bid * NWAVES + wave, NGW = G * NWAVES;
        constexpr int I_IN = 16 * (DIN / 64), I_OUT = 16 * 16;
        for (int it = gw; it < I_IN + I_OUT; it += NGW) {
            if (it < I_IN) cvt_item(p.in[8], D, DIN, (bf16_t*)(ws + WS_WINT), 0, it, lane);
            else cvt_item(p.in[21], D, D, (bf16_t*)(ws + WS_WOUTT), 0, it - I_IN, lane);
        }
    }
}
constexpr size_t OUT_W2T = (MOE_FP8 ? 32 : 64) * MiB;
__device__ __forceinline__ void xcvt_load(const Params& p, int g, int lane, f32x4 (&v)[8]) {
    const int which = g >> 13, r = g & 8191, e = r >> 9, kb = (r >> 4) & 31, nb = r & 15;
    const float* W = which == 0 ? p.in[23] : (which == 1 ? p.in[24] : p.in[25]);
    const __amdgpu_buffer_rsrc_t rs = __builtin_amdgcn_make_buffer_rsrc((void*)W, 0, 64 << 20, 0x00020000);
    const unsigned vo = (unsigned)(((lane >> 4) * 8 * 1024 + (lane & 15) * 4) * 4);
    const unsigned so = (unsigned)(((e * 1024 + kb * 32) * 1024 + nb * 64) * 4);
#pragma unroll
    for (int i = 0; i < 8; ++i) v[i] = __builtin_bit_cast(f32x4, __builtin_amdgcn_raw_buffer_load_b128(rs, vo, so + (unsigned)i * 4096u, 0));
}
__device__ __forceinline__ void xcvt_store(const Params& p, int g, int lane, const f32x4 (&v)[8]) {
    const int which = g >> 13, r = g & 8191, e = r >> 9, kb = (r >> 4) & 31, nb = r & 15, n0 = nb * 64;
    const int rbase = which == 2 ? n0 : ((n0 >> 7) * 256 + (n0 & 127) + (which == 1 ? 128 : 0));
#if MOE_FP8
    const unsigned so = which == 2 ? (unsigned)OUT_W2T + (unsigned)((e * 1024 + rbase) * 1024 + kb * 32) : (unsigned)((e * 2048 + rbase) * 1024 + kb * 32);
    const __amdgpu_buffer_rsrc_t rs = __builtin_amdgcn_make_buffer_rsrc((void*)p.out, 0, 48 << 20, 0x00020000);
    const unsigned vo = (unsigned)((lane & 15) * 4 * 1024 + (lane >> 4) * 8);
#pragma unroll
    for (int q = 0; q < 4; ++q) { u32x2 o;
        o.x = pk4_fp8_raw(v[0][q] * W8_SCALE, v[1][q] * W8_SCALE, v[2][q] * W8_SCALE, v[3][q] * W8_SCALE); o.y = pk4_fp8_raw(v[4][q] * W8_SCALE, v[5][q] * W8_SCALE, v[6][q] * W8_SCALE, v[7][q] * W8_SCALE);
        __builtin_amdgcn_raw_buffer_store_b64(o, rs, vo, so + (unsigned)q * 1024u, 0); }
#else
    const unsigned so = which == 2 ? (unsigned)OUT_W2T + (unsigned)(((e * 1024 + rbase) * 1024 + kb * 32) * 2) : (unsigned)(((e * 2048 + rbase) * 1024 + kb * 32) * 2);
    const __amdgpu_buffer_rsrc_t rs = __builtin_amdgcn_make_buffer_rsrc((void*)p.out, 0, 96 << 20, 0x00020000);
    const unsigned vo = (unsigned)(((lane & 15) * 4 * 1024 + (lane >> 4) * 8) * 2);
#pragma unroll
    for (int q = 0; q < 4; ++q) { u32x4 o;
        o.x = pk2(v[0][q], v[1][q]); o.y = pk2(v[2][q], v[3][q]); o.z = pk2(v[4][q], v[5][q]); o.w = pk2(v[6][q], v[7][q]);
        __builtin_amdgcn_raw_buffer_store_b128(o, rs, vo, so + (unsigned)q * 2048u, 0); }
#endif
}

__device__ __forceinline__ void phase1(const Params& p, int bid, int G, int wv) {
    const int tid = my_tid(wv), lane = tid & 63, wave = tid >> 6;
    const int gw = bid * NWAVES + wave, NGW = G * NWAVES;
    const float* MOD = (const float*)(p.ws + WS_MOD); const float* n1g = p.in[6];
    bf16_t* XN = (bf16_t*)(p.ws + WS_XN);
    f32x4 g[4];
#pragma unroll
    for (int j = 0; j < 4; ++j) g[j] = *(const f32x4*)(n1g + 4 * (lane + 64 * j));
    for (int m0 = gw; m0 < MALL; m0 += 2 * NGW) {
        f32x4 v[2][4]; float ss[2]; int mrow[2];
#pragma unroll
        for (int tk = 0; tk < 2; ++tk) { const int m = m0 + tk * NGW < MALL ? m0 + tk * NGW : m0;
            const float* src = m < MX ? p.in[0] + (size_t)m * D : p.in[2] + (size_t)(m - MX) * D; mrow[tk] = m;
            ss[tk] = 0.f;
#pragma unroll
            for (int j = 0; j < 4; ++j) { v[tk][j] = ((const f32x4*)src)[lane + 64 * j]; ss[tk] += (v[tk][j].x * v[tk][j].x + v[tk][j].y * v[tk][j].y) + (v[tk][j].z * v[tk][j].z + v[tk][j].w * v[tk][j].w); } }
#pragma unroll
        for (int tk = 0; tk < 2; ++tk) { const int m = mrow[tk], mr = m < MX ? (m >> 12) : 8;
            const float* sh = MOD + (size_t)mr * 6144; const float* scp = sh + 1024;
            const float rstd = rsqrtf(wave_sum(ss[tk]) * (1.f / D) + 1e-6f);
#pragma unroll
            for (int j = 0; j < 4; ++j) { const int col = 4 * (lane + 64 * j);
                const f32x4 s_ = *(const f32x4*)(scp + col), h = *(const f32x4*)(sh + col);
                const f32x4 y = v[tk][j] * rstd * g[j] * (s_ + 1.f) + h;
                u32x2 o; o.x = pk2(y.x, y.y); o.y = pk2(y.z, y.w);
                *(u32x2*)(XN + (size_t)m * D + col) = o; } }
    }
}

struct Px5 { u32x4 s, n0, n1, n2, n3; };
__device__ __forceinline__ Px5 px_load(const bf16_t* PX, int row, const int (&nbr)[4], int cb) {
    const __amdgpu_buffer_rsrc_t rs = __builtin_amdgcn_make_buffer_rsrc((void*)PX, 0, MALL * DIN * 2, 0x00020000);
    const unsigned cbb = (unsigned)cb * 2u, OOB = 0xFFFFF000u;
    Px5 q;
    q.s = __builtin_bit_cast(u32x4, __builtin_amdgcn_raw_buffer_load_b128(rs, (unsigned)row * (DIN * 2) + cbb, 0, 0));
    q.n0 = __builtin_bit_cast(u32x4, __builtin_amdgcn_raw_buffer_load_b128(rs, nbr[0] >= 0 ? (unsigned)nbr[0] * (DIN * 2) + cbb : OOB, 0, 0));
    q.n1 = __builtin_bit_cast(u32x4, __builtin_amdgcn_raw_buffer_load_b128(rs, nbr[1] >= 0 ? (unsigned)nbr[1] * (DIN * 2) + cbb : OOB, 0, 0));
    q.n2 = __builtin_bit_cast(u32x4, __builtin_amdgcn_raw_buffer_load_b128(rs, nbr[2] >= 0 ? (unsigned)nbr[2] * (DIN * 2) + cbb : OOB, 0, 0));
    q.n3 = __builtin_bit_cast(u32x4, __builtin_amdgcn_raw_buffer_load_b128(rs, nbr[3] >= 0 ? (unsigned)nbr[3] * (DIN * 2) + cbb : OOB, 0, 0));
    return q; }
__device__ __forceinline__ void px_lerp(const Px5& q, bool isctx, int cb, const float* mu, float (&out)[8]) {
    u32x4 sh;
    if (isctx) { sh.x = (q.n0.x & 0xffffu) | (q.n1.x & 0xffff0000u); sh.y = (q.n0.y & 0xffffu) | (q.n1.y & 0xffff0000u); sh.z = (q.n0.z & 0xffffu) | (q.n1.z & 0xffff0000u); sh.w = (q.n0.w & 0xffffu) | (q.n1.w & 0xffff0000u); }
    else { sh.x = (q.n0.x & 0xffffu) | (q.n1.x & 0xffff0000u); sh.y = (q.n2.y & 0xffffu) | (q.n3.y & 0xffff0000u); sh.z = (q.n0.z & 0xffffu) | (q.n1.z & 0xffff0000u); sh.w = (q.n2.w & 0xffffu) | (q.n3.w & 0xffff0000u); }
    float s[8], sv[8];
    unpack8(q.s, s); unpack8(sh, sv);
    const f32x4 m0 = *(const f32x4*)(mu + cb), m1 = *(const f32x4*)(mu + cb + 4);
    const float mv[8] = {m0.x, m0.y, m0.z, m0.w, m1.x, m1.y, m1.z, m1.w};
#pragma unroll
    for (int e = 0; e < 8; ++e) out[e] = s[e] + mv[e] * (sv[e] - s[e]);
}
__device__ __forceinline__ void neighbours(int t, bool isctx, int rowbase, int (&nbr)[4]) {
    if (isctx) { nbr[0] = t > 0 ? rowbase + t - 1 : -1; nbr[1] = t < CTXL - 1 ? rowbase + t + 1 : -1; nbr[2] = -1; nbr[3] = -1; }
    else { const int cg_ = t & 63, rg = t >> 6;
        nbr[0] = cg_ > 0 ? rowbase + t - 1 : -1; nbr[1] = cg_ < 63 ? rowbase + t + 1 : -1; nbr[2] = rg > 0 ? rowbase + t - 64 : -1; nbr[3] = rg < 63 ? rowbase + t + 64 : -1; }
}

typedef short s16x4 __attribute__((ext_vector_type(4)));
constexpr int RS = 128;
constexpr int IMG = 64 * RS;
__device__ __forceinline__ int ioff(int row, int col) { return row * RS + ((col * 2) ^ (((row & 2) | ((row >> 1) & 4)) << 4)); }
constexpr int I_AT = 0, I_BT = IMG, I_KT = 2 * IMG, I_RT = 3 * IMG, I_BH = 4 * IMG, I_KH = 5 * IMG, I_VV = 6 * IMG;
constexpr int I_LBT = 7 * IMG, I_LAK = 8 * IMG, I_PRB = 9 * IMG, I_PRK = 10 * IMG, I_TM = 11 * IMG, I_Q = 12 * IMG;
constexpr int I_E = 13 * IMG;
constexpr int I_LT = 13 * IMG + 4608;
constexpr int I_WUP = I_LT + 17408, I_AUP = I_WUP + IMG;
constexpr int I_PAR = I_AUP + IMG;
constexpr int I_VV2 = I_PAR + 1280;
constexpr int X_END = I_VV2 + IMG;
constexpr int I_W1 = I_LBT, I_W2 = I_LAK;
constexpr int I_XW = I_Q, I_XA = I_TM;
constexpr int I_DW = I_AT, I_DA = I_LT;
constexpr int I_G = I_PRB, I_GT = I_E;
static_assert(I_DW + 17408 <= I_RT && I_PRK == I_PRB + IMG && X_END + 64 <= LDS_BYTES && X_END == LDS_MISC, "scan LDS map");

__device__ __forceinline__ bf16x8 frag_rm(const LAS unsigned char* img, int row0, int k0, int lane) {
    return *(const LAS bf16x8*)(img + ioff(row0 + (lane & 15), k0 + 8 * (lane >> 4))); }
__device__ __forceinline__ bf16x8 frag_tr(const LAS unsigned char* img, int k0, int col0, int lane) {
    LAS unsigned char* a = (LAS unsigned char*)img + ioff(k0 + 8 * (lane >> 4) + ((lane & 15) >> 2), col0 + 4 * (lane & 3));
    const s16x4 lo = __builtin_amdgcn_ds_read_tr16_b64_v4i16((LAS s16x4*)a);
    const s16x4 hi = __builtin_amdgcn_ds_read_tr16_b64_v4i16((LAS s16x4*)(a + 4 * RS));
    return __builtin_shufflevector(lo, hi, 0, 1, 2, 3, 4, 5, 6, 7); }
#define MFMA16(a, b, c) __builtin_amdgcn_mfma_f32_16x16x32_bf16((a), (b), (c), 0, 0, 0)
__device__ __forceinline__ void st_img(LAS unsigned char* img, int n0, int m0, int lane, const f32x4 v) {
    u32x2 w; w.x = pk2(v[0], v[1]); w.y = pk2(v[2], v[3]);
    *(LAS u32x2*)(img + ioff(n0 + (lane & 15), m0 + 4 * (lane >> 4))) = w; }
__device__ __forceinline__ f32x4 up4(const u32x2 w) { return (f32x4){bflo(w.x), bfhi(w.x), bflo(w.y), bfhi(w.y)}; }

__device__ __forceinline__ void phase_scanX(const Params& p, LAS unsigned char* lds, int bid, int G, int wv) {
    const int tid_ = my_tid(wv), lane_ = tid_ & 63, wave = __builtin_amdgcn_readfirstlane(tid_ >> 6);
    const bf16_t* PX = (const bf16_t*)(p.ws + WS_PX);
    const float* mu = p.in[9];
    const f32x4 fz = (f32x4){0.f, 0.f, 0.f, 0.f};
    for (int it_ = bid; it_ < NB * NH * 2 * 2; it_ += G) {
        const int item = (G == 256) ? ((it_ & 7) * 32 + (it_ >> 3)) : it_;
        const int bhd = item >> 1, dir = bhd & 1, h = (bhd >> 1) & 7, b = bhd >> 4;
        LBAR();
        { const int tid = opq(tid_), j = tid >> 3, k0 = (tid & 7) * 8;
          const float* wu = p.in[11] + (size_t)dir * 64 * DR + (size_t)j * DR + h * 64 + k0; const float* au = p.in[13] + (size_t)dir * 64 * DR + (size_t)j * DR + h * 64 + k0;
          const f32x4 w0 = *(const f32x4*)wu, w1 = *(const f32x4*)(wu + 4), a0 = *(const f32x4*)au, a1 = *(const f32x4*)(au + 4);
          const float wf[8] = {w0.x, w0.y, w0.z, w0.w, w1.x, w1.y, w1.z, w1.w}, af[8] = {a0.x, a0.y, a0.z, a0.w, a1.x, a1.y, a1.z, a1.w};
          *(LAS u32x4*)(lds + I_WUP + ioff(j, k0)) = pack8(wf); *(LAS u32x4*)(lds + I_AUP + ioff(j, k0)) = pack8(af); }
        { const int k0_ = (opq(tid_) & 7) * 8, hc_ = h * 64 + k0_; LAS float* PARw = (LAS float*)(lds + I_PAR) + k0_;
#pragma unroll
          for (int e = 0; e < 8; ++e) { PARw[e] = p.in[10][dir * DR + hc_ + e]; PARw[64 + e] = p.in[12][dir * DR + hc_ + e]; PARw[128 + e] = p.in[14][hc_ + e]; PARw[192 + e] = p.in[15][hc_ + e]; PARw[256 + e] = p.in[16][hc_ + e]; } }
#define X_PXLOAD(ci_) do { const int tid__ = opq(tid_), j__ = tid__ >> 3, k0__ = (tid__ & 7) * 8; const int ci__ = (ci_); const bool ctx__ = ci__ < 4; const int c__ = ctx__ ? ci__ : ci__ - 4; \
            const int L__ = ctx__ ? CTXL : T, rb__ = ctx__ ? MX + b * CTXL : b * T, pos__ = 64 * c__ + j__, t__ = dir ? (L__ - 1 - pos__) : pos__; \
            int nbr__[4]; neighbours(t__, ctx__, rb__, nbr__); \
            qv = px_load(PX, rb__ + t__, nbr__, 1024 + h * 64 + k0__); qw = px_load(PX, rb__ + t__, nbr__, 1536 + k0__); qa = px_load(PX, rb__ + t__, nbr__, 1600 + k0__); \
            qr = px_load(PX, rb__ + t__, nbr__, h * 64 + k0__); qk = px_load(PX, rb__ + t__, nbr__, 512 + h * 64 + k0__); } while (0)
#define X_LERP(ci_, par_, rd_, kd_) do { const int tid__ = opq(tid_), j__ = tid__ >> 3, k0__ = (tid__ & 7) * 8; const bool ctx__ = (ci_) < 4; \
            { float v__[8]; px_lerp(qv, ctx__, 1024 + h * 64 + k0__, mu, v__); *(LAS u32x4*)(lds + ((par_) ? I_VV2 : I_VV) + ioff(j__, k0__)) = pack8(v__); } \
            { float xw__[8]; px_lerp(qw, ctx__, 1536 + k0__, mu, xw__); \
              _Pragma("unroll") for (int e = 0; e < 8; ++e) xw__[e] = ftanh(xw__[e]); \
              *(LAS u32x4*)(lds + I_XW + ioff(j__, k0__)) = pack8(xw__); } \
            { float xa__[8]; px_lerp(qa, ctx__, 1600 + k0__, mu, xa__); *(LAS u32x4*)(lds + I_XA + ioff(j__, k0__)) = pack8(xa__); } \
            px_lerp(qr, ctx__, h * 64 + k0__, mu, rd_); px_lerp(qk, ctx__, 512 + h * 64 + k0__, mu, kd_); } while (0)
#define X_LORA() do { const int lane = opq(lane_); const int pr = wave >> 2, nt = wave & 3; \
            const LAS unsigned char* Ximg = lds + (pr ? I_XA : I_XW); const LAS unsigned char* Wimg = lds + (pr ? I_AUP : I_WUP); \
            LAS float* Dout = (LAS float*)(lds + (pr ? I_DA : I_DW)); \
            const bf16x8 b0 = frag_rm(Ximg, 16 * nt, 0, lane), b1 = frag_rm(Ximg, 16 * nt, 32, lane); \
            bf16x8 wa[4][2]; \
            _Pragma("unroll") for (int mt = 0; mt < 4; ++mt) { wa[mt][0] = frag_tr(Wimg, 0, 16 * mt, lane); wa[mt][1] = frag_tr(Wimg, 32, 16 * mt, lane); } \
            _Pragma("unroll") for (int mt = 0; mt < 4; ++mt) { const f32x4 acc = MFMA16(wa[mt][1], b1, MFMA16(wa[mt][0], b0, fz)); \
                *(LAS f32x4*)(Dout + (16 * nt + (lane & 15)) * 68 + 16 * mt + 4 * (lane >> 4)) = acc; } } while (0)
        float r[8], k[8];
#if XSCOPE
        { Px5 qv, qw, qa, qr, qk; X_PXLOAD((item & 1) * 34);
          X_LERP((item & 1) * 34, 0, r, k); }
#else
        Px5 qv, qw, qa, qr, qk;
        X_PXLOAD((item & 1) * 34);
        X_LERP((item & 1) * 34, 0, r, k);
#endif
        LBAR();
        X_LORA();
        for (int cc = 0; cc < 34; ++cc) {
            const int tid = opq(tid_), j = tid >> 3, sub = tid & 7, k0 = sub * 8;
#if XSCOPE
            Px5 qv, qw, qa, qr, qk;
#endif
            const int ci = (item & 1) * 34 + cc;
            const bool isctx = ci < 4; const int c = isctx ? ci : ci - 4;
            const int u = bhd * 68 + ci;
            const int L = isctx ? CTXL : T, rowbase = isctx ? MX + b * CTXL : b * T;
            const int pos = 64 * c + j, t = dir ? (L - 1 - pos) : pos;
            const LAS unsigned char* vvimg = lds + ((cc & 1) ? I_VV2 : I_VV);
            LBAR();
            if (cc + 1 < 34) X_PXLOAD(ci + 1);
            float kkn[8], ab[8], kd[8];
            { const LAS float* DW = (const LAS float*)(lds + I_DW) + j * 68 + k0; const LAS float* DA = (const LAS float*)(lds + I_DA) + j * 68 + k0;
              const f32x4 d0 = *(const LAS f32x4*)DW, d1 = *(const LAS f32x4*)(DW + 4), e0 = *(const LAS f32x4*)DA, e1 = *(const LAS f32x4*)(DA + 4);
              const float dw[8] = {d0.x, d0.y, d0.z, d0.w, d1.x, d1.y, d1.z, d1.w}, da[8] = {e0.x, e0.y, e0.z, e0.w, e1.x, e1.y, e1.z, e1.w};
              const LAS float* PAR = (const LAS float*)(lds + I_PAR) + k0;
              const LAS float* w0p = PAR; const LAS float* a0p = PAR + 64; const LAS float* kkp = PAR + 128; const LAS float* kap = PAR + 192; const LAS float* rkp = PAR + 256;
              float ss = 0.f, bd = 0.f, lw[8];
#pragma unroll
              for (int e = 0; e < 8; ++e) {
                  kkn[e] = k[e] * kkp[e]; ss += kkn[e] * kkn[e];
                  const float z = w0p[e] + dw[e];
                  lw[e] = -0.60653066f * fsigmoid(z);
                  const float as = fsigmoid(a0p[e] + da[e]);
                  kd[e] = k[e] * (1.f + (as - 1.f) * kap[e]);
                  bd += r[e] * kd[e] * rkp[e];
                  ab[e] = as; }
              ss = red8(ss); bd = red8(bd);
              const float inv = __builtin_amdgcn_rcpf(fmaxf(__builtin_amdgcn_sqrtf(ss), 1e-12f));
#pragma unroll
              for (int e = 0; e < 8; ++e) { kkn[e] *= inv; ab[e] *= kkn[e]; }
              LAS float* Gs = (LAS float*)(lds + I_G) + j * 64 + k0;
              *(LAS f32x4*)Gs = (f32x4){lw[0], lw[1], lw[2], lw[3]}; *(LAS f32x4*)(Gs + 4) = (f32x4){lw[4], lw[5], lw[6], lw[7]};
              if (!isctx && sub == 0) *(float*)(p.ws + (size_t)(unsigned)(WS_BDOT + ((dir * MX + rowbase + t) * NH + h) * 4)) = bd; }
            LBAR();
            { const int kap = tid & 63, jq = tid >> 6; LAS float* Gs = (LAS float*)(lds + I_G); LAS float* GT = (LAS float*)(lds + I_GT);
              float pf[8], run = 0.f;
#pragma unroll
              for (int e = 0; e < 8; ++e) { run += Gs[(8 * jq + e) * 64 + kap]; pf[e] = run; }
              GT[jq * 64 + kap] = run;
              LBAR();
              float off = 0.f;
#pragma unroll
              for (int q = 0; q < 7; ++q) off += (q < jq) ? GT[q * 64 + kap] : 0.f;
#pragma unroll
              for (int e = 0; e < 8; ++e) Gs[(8 * jq + e) * 64 + kap] = pf[e] + off; }
            LBAR();
            { const LAS float* Gs = (const LAS float*)(lds + I_G);
              const f32x4 g0 = *(const LAS f32x4*)(Gs + j * 64 + k0), g1 = *(const LAS f32x4*)(Gs + j * 64 + k0 + 4);
              const f32x4 c0 = *(const LAS f32x4*)(Gs + 63 * 64 + k0), c1 = *(const LAS f32x4*)(Gs + 63 * 64 + k0 + 4);
              f32x4 m0 = fz, m1 = fz; if (j > 0) { m0 = *(const LAS f32x4*)(Gs + (j - 1) * 64 + k0); m1 = *(const LAS f32x4*)(Gs + (j - 1) * 64 + k0 + 4); }
              const float g[8] = {g0.x, g0.y, g0.z, g0.w, g1.x, g1.y, g1.z, g1.w}, gm[8] = {m0.x, m0.y, m0.z, m0.w, m1.x, m1.y, m1.z, m1.w}, gc[8] = {c0.x, c0.y, c0.z, c0.w, c1.x, c1.y, c1.z, c1.w};
              float at[8], bt[8], kt[8], rt[8], bh[8], kh[8];
#pragma unroll
              for (int e = 0; e < 8; ++e) { const float eg = __expf(g[e]), em = __expf(gm[e]), ei = __expf(-g[e]), eh = __expf(gc[e] - g[e]);
                  at[e] = -kkn[e] * em; bt[e] = ab[e] * ei; kt[e] = kd[e] * ei; rt[e] = r[e] * eg; bh[e] = ab[e] * eh; kh[e] = kd[e] * eh; }
              const int o = ioff(j, k0);
              *(LAS u32x4*)(lds + I_AT + o) = pack8(at); *(LAS u32x4*)(lds + I_BT + o) = pack8(bt); *(LAS u32x4*)(lds + I_KT + o) = pack8(kt);
              *(LAS u32x4*)(lds + I_RT + o) = pack8(rt); *(LAS u32x4*)(lds + I_BH + o) = pack8(bh); *(LAS u32x4*)(lds + I_KH + o) = pack8(kh);
              if (j == 0) { float* GAM = (float*)(p.ws + (size_t)(unsigned)(WS_GAM + (u * 64 + k0) * 4));
#pragma unroll
                  for (int e = 0; e < 8; ++e) GAM[e] = __expf(gc[e]); } }
            LBAR();
            const int cvitem = __builtin_amdgcn_readfirstlane(opq((CVPOS != 0 && cc < 32 && wave >= 5) ? item * 96 + cc * 3 + (wave - 5) : -1));
            f32x4 cv[8];
#if CVPOS == 1
            if (cvitem >= 0) xcvt_load(p, cvitem, opq(lane_), cv);
#endif
            { const int lane = opq(lane_); const int nt = wave >> 1, mb = (wave & 1) * 2;
              const bf16x8 bB0 = frag_rm(lds + I_BT, 16 * nt, 0, lane), bB1 = frag_rm(lds + I_BT, 16 * nt, 32, lane);
              const int n = 16 * nt + (lane & 15);
#pragma unroll
              for (int mi = 0; mi < 2; ++mi) { const int mt = mb + mi, m0 = 16 * mt + 4 * (lane >> 4);
                  const bf16x8 aA0 = frag_rm(lds + I_AT, 16 * mt, 0, lane), aA1 = frag_rm(lds + I_AT, 16 * mt, 32, lane);
                  f32x4 lt = MFMA16(aA1, bB1, MFMA16(aA0, bB0, fz));
#pragma unroll
                  for (int q = 0; q < 4; ++q) lt[q] = (m0 + q > n) ? lt[q] : 0.f;
                  *(LAS f32x4*)((LAS float*)(lds + I_LT) + n * 68 + m0) = lt;
                  st_img(lds + I_LBT, 16 * nt, 16 * mt, lane, lt); } }
            LBAR();
            if (wave == 0) {
                const int lane = opq(lane_); const int a16 = lane >> 4, il = lane & 15;
                const LAS float* LT = (const LAS float*)(lds + I_LT);
                typedef float f32x2v __attribute__((ext_vector_type(2)));
                f32x2v tp[8];
#pragma unroll
                for (int i = 0; i < 8; ++i) tp[i] = (f32x2v){0.f, 0.f};
                f32x4 Lc[4], Ln[4];
#pragma unroll
                for (int q4 = 0; q4 < 4; ++q4) { Lc[q4] = fz; Ln[q4] = fz; }
                Lc[3] = *(const LAS f32x4*)(LT + (16 * a16 + 14) * 68 + 16 * a16 + 12);
                tp[7].y = (il == 15) ? 1.f : 0.f;
#pragma unroll
                for (int jl = 14; jl >= 0; --jl) {
                    if (jl > 0) { const LAS float* Lrow = LT + (16 * a16 + jl - 1) * 68 + 16 * a16;
#pragma unroll
                        for (int q4 = 0; q4 < 4; ++q4) if (4 * q4 + 3 > jl - 1) Ln[q4] = *(const LAS f32x4*)(Lrow + 4 * q4); }
                    f32x2v s01 = (f32x2v){(il == jl) ? 1.f : 0.f, 0.f}, s23 = (f32x2v){0.f, 0.f};
#pragma unroll
                    for (int q4 = 0; q4 < 4; ++q4) if (4 * q4 + 3 > jl) { const f32x4 Lv = Lc[q4];
                        s01 += tp[2 * q4] * (f32x2v){Lv.x, Lv.y}; s23 += tp[2 * q4 + 1] * (f32x2v){Lv.z, Lv.w}; }
                    float tv_ = (s01.x + s01.y) + (s23.x + s23.y);
                    asm volatile("" : "+v"(tv_) :: "memory");
                    if (jl & 1) tp[jl >> 1].y = tv_; else tp[jl >> 1].x = tv_;
#pragma unroll
                    for (int q4 = 0; q4 < 4; ++q4) Lc[q4] = Ln[q4];
                }
                LAS unsigned char* tmi = lds + I_TM;
                const u32x4 z4 = (u32x4){0u, 0u, 0u, 0u};
#pragma unroll
                for (int c8 = 0; c8 < 2; ++c8) { const float tv[8] = {tp[4 * c8].x, tp[4 * c8].y, tp[4 * c8 + 1].x, tp[4 * c8 + 1].y, tp[4 * c8 + 2].x, tp[4 * c8 + 2].y, tp[4 * c8 + 3].x, tp[4 * c8 + 3].y};
                    *(LAS u32x4*)(tmi + ioff(lane, 16 * a16 + 8 * c8)) = pack8(tv); }
                if ((a16 & 1) == 0) {
#pragma unroll
                    for (int c8 = 0; c8 < 2; ++c8) *(LAS u32x4*)(tmi + ioff(lane, 16 * (a16 + 1) + 8 * c8)) = z4; }
                if (a16 < 2) {
#pragma unroll
                    for (int c8 = 0; c8 < 4; ++c8) *(LAS u32x4*)(tmi + ioff(lane, 32 + 8 * c8)) = z4; }
                asm volatile("s_waitcnt lgkmcnt(0)" ::: "memory");
                const bf16x8 zf = (bf16x8){0, 0, 0, 0, 0, 0, 0, 0};
                const bool khi = (lane & 32) != 0;
#pragma unroll
                for (int pq = 0; pq < 2; ++pq) {
                    bf16x8 fa = frag_tr(lds + I_TM, 32 * pq, 32 * pq, lane), fb = frag_tr(lds + I_LBT, 32 * pq, 32 * pq + 16, lane);
                    fa = khi ? zf : fa; fb = khi ? zf : fb;
                    st_img(lds + I_E, 16 * pq, 0, lane, MFMA16(fa, fb, fz)); }
                asm volatile("s_waitcnt lgkmcnt(0)" ::: "memory");
#pragma unroll
                for (int pq = 0; pq < 2; ++pq) {
                    bf16x8 fa = frag_tr(lds + I_E, 16 * pq, 0, lane), fb = frag_rm(lds + I_TM, 32 * pq + 16, 32 * pq + 16, lane);
                    fa = khi ? zf : fa; fb = khi ? zf : fb;
                    st_img(lds + I_TM, 32 * pq + 16, 32 * pq, lane, MFMA16(fa, fb, fz)); }
                asm volatile("s_waitcnt lgkmcnt(0)" ::: "memory");
                { f32x4 ea[4];
#pragma unroll
                  for (int tq = 0; tq < 4; ++tq) { const int nt2 = tq >> 1, mt2 = tq & 1;
                      ea[tq] = MFMA16(frag_tr(lds + I_TM, 0, 16 * mt2, lane), frag_tr(lds + I_LBT, 0, 32 + 16 * nt2, lane), fz); }
#pragma unroll
                  for (int tq = 0; tq < 4; ++tq) st_img(lds + I_E, 16 * (tq >> 1), 16 * (tq & 1), lane, ea[tq]); }
                asm volatile("s_waitcnt lgkmcnt(0)" ::: "memory");
                { f32x4 ta[4];
#pragma unroll
                  for (int tq = 0; tq < 4; ++tq) { const int nt2 = tq >> 1, mt2 = tq & 1;
                      ta[tq] = MFMA16(frag_tr(lds + I_E, 0, 16 * mt2, lane), frag_rm(lds + I_TM, 32 + 16 * nt2, 32, lane), fz); }
#pragma unroll
                  for (int tq = 0; tq < 4; ++tq) st_img(lds + I_TM, 32 + 16 * (tq >> 1), 16 * (tq & 1), lane, ta[tq]); }
            } else if (wave < 5) {
                const int lane = opq(lane_); const int nt = wave - 1, n = 16 * nt + (lane & 15);
                const bf16x8 bA0 = frag_rm(lds + I_AT, 16 * nt, 0, lane), bA1 = frag_rm(lds + I_AT, 16 * nt, 32, lane);
                const bf16x8 bR0 = frag_rm(lds + I_RT, 16 * nt, 0, lane), bR1 = frag_rm(lds + I_RT, 16 * nt, 32, lane);
                bf16x8 fk[4][2], fb[4][2];
#pragma unroll
                for (int mt = 0; mt < 4; ++mt) { fk[mt][0] = frag_rm(lds + I_KT, 16 * mt, 0, lane); fk[mt][1] = frag_rm(lds + I_KT, 16 * mt, 32, lane);
                                                 fb[mt][0] = frag_rm(lds + I_BT, 16 * mt, 0, lane); fb[mt][1] = frag_rm(lds + I_BT, 16 * mt, 32, lane); }
                f32x4 laks[4], prbs[4];
#pragma unroll
                for (int mt = 0; mt < 4; ++mt) { const int m0 = 16 * mt + 4 * (lane >> 4);
                    f32x4 lak = MFMA16(fk[mt][1], bA1, MFMA16(fk[mt][0], bA0, fz)), prb = MFMA16(fb[mt][1], bR1, MFMA16(fb[mt][0], bR0, fz));
#pragma unroll
                    for (int q = 0; q < 4; ++q) { lak[q] = (m0 + q < n) ? lak[q] : 0.f; prb[q] = (m0 + q <= n) ? prb[q] : 0.f; }
                    laks[mt] = lak; prbs[mt] = prb; }
#pragma unroll
                for (int mt = 0; mt < 4; ++mt) { st_img(lds + I_LAK, 16 * nt, 16 * mt, lane, laks[mt]); st_img(lds + I_PRB, 16 * nt, 16 * mt, lane, prbs[mt]); }
                bf16x8 fv[4][2];
#pragma unroll
                for (int mt = 0; mt < 4; ++mt) { fv[mt][0] = frag_tr(vvimg, 0, 16 * mt, lane); fv[mt][1] = frag_tr(vvimg, 32, 16 * mt, lane); }
                asm volatile("s_waitcnt lgkmcnt(0)" ::: "memory");
                const bf16x8 bL0 = frag_rm(lds + I_LAK, 16 * nt, 0, lane), bL1 = frag_rm(lds + I_LAK, 16 * nt, 32, lane);
                f32x4 qs[4];
#pragma unroll
                for (int mt = 0; mt < 4; ++mt) qs[mt] = MFMA16(fv[mt][1], bL1, MFMA16(fv[mt][0], bL0, fz));
#pragma unroll
                for (int mt = 0; mt < 4; ++mt) st_img(lds + I_Q, 16 * nt, 16 * mt, lane, qs[mt]);
            } else {
                const int lane = opq(lane_);
#if CVPOS == 3
                if (cvitem >= 0) xcvt_load(p, cvitem, lane, cv);
#endif
#pragma unroll
                for (int bt = 0; bt < 2; ++bt) { bf16x8 fa[3][2], fr[3][2]; f32x4 accs[3];
#pragma unroll
                    for (int k3 = 0; k3 < 3; ++k3) { const int tq = (wave - 5) + 3 * (3 * bt + k3); const int tqc = tq < 16 ? tq : 15, nt = tqc >> 2, mt = tqc & 3;
                        fa[k3][0] = frag_rm(lds + I_KT, 16 * mt, 0, lane); fa[k3][1] = frag_rm(lds + I_KT, 16 * mt, 32, lane);
                        fr[k3][0] = frag_rm(lds + I_RT, 16 * nt, 0, lane); fr[k3][1] = frag_rm(lds + I_RT, 16 * nt, 32, lane); }
#pragma unroll
                    for (int k3 = 0; k3 < 3; ++k3) { const int tq = (wave - 5) + 3 * (3 * bt + k3); const int tqc = tq < 16 ? tq : 15, nt = tqc >> 2, mt = tqc & 3, n = 16 * nt + (lane & 15), m0 = 16 * mt + 4 * (lane >> 4);
                        f32x4 acc = MFMA16(fa[k3][1], fr[k3][1], MFMA16(fa[k3][0], fr[k3][0], fz));
#pragma unroll
                        for (int q = 0; q < 4; ++q) acc[q] = (m0 + q <= n) ? acc[q] : 0.f;
                        accs[k3] = acc; }
#pragma unroll
                    for (int k3 = 0; k3 < 3; ++k3) { const int tq = (wave - 5) + 3 * (3 * bt + k3); const int tqc = tq < 16 ? tq : 15, nt = tqc >> 2, mt = tqc & 3;
                        st_img(lds + I_PRK, 16 * nt, 16 * mt, lane, accs[k3]); } }
#if CVPOS == 2
                if (cvitem >= 0) xcvt_load(p, cvitem, lane, cv);
#endif
                if (cvitem >= 0) xcvt_store(p, cvitem, lane, cv);
            }
            LBAR();
            { const int lane = opq(lane_); const int pr = wave >> 2, nt = wave & 3; const LAS unsigned char* Aimg = lds + (pr ? I_Q : I_AT); LAS unsigned char* Oimg = lds + (pr ? I_W2 : I_W1);
              const bf16x8 bT0 = frag_rm(lds + I_TM, 16 * nt, 0, lane), bT1 = frag_rm(lds + I_TM, 16 * nt, 32, lane);
#pragma unroll
              for (int mt = 0; mt < 4; ++mt) { f32x4 acc = MFMA16(frag_tr(Aimg, 0, 16 * mt, lane), bT0, fz); acc = MFMA16(frag_tr(Aimg, 32, 16 * mt, lane), bT1, acc);
                  st_img(Oimg, 16 * nt, 16 * mt, lane, acc); } }
            LBAR();
            float rn[8], kn[8];
            if (cc + 1 < 34) { X_LERP(ci + 1, (cc + 1) & 1, rn, kn); LBAR(); X_LORA(); }
            { const int lane = opq(lane_); const int nt = wave >> 1, mb = (wave & 1) * 2;
              const int n = 16 * nt + (lane & 15);
              const bf16x8 bBh0 = frag_tr(lds + I_BH, 0, 16 * nt, lane), bBh1 = frag_tr(lds + I_BH, 32, 16 * nt, lane);
              const bf16x8 bW20 = frag_tr(lds + I_W2, 0, 16 * nt, lane), bW21 = frag_tr(lds + I_W2, 32, 16 * nt, lane);
              const bf16x8 bVv0 = frag_tr(vvimg, 0, 16 * nt, lane), bVv1 = frag_tr(vvimg, 32, 16 * nt, lane);
              const bf16x8 bPb0 = frag_rm(lds + I_PRB, 16 * nt, 0, lane), bPb1 = frag_rm(lds + I_PRB, 16 * nt, 32, lane);
              const bf16x8 bPk0 = frag_rm(lds + I_PRK, 16 * nt, 0, lane), bPk1 = frag_rm(lds + I_PRK, 16 * nt, 32, lane);
              const unsigned MLRo = (unsigned)WS_MLR + (unsigned)u * 8192u, NTo = (unsigned)WS_NT + (unsigned)u * 8192u, RBo = (unsigned)WS_RB + (unsigned)(bhd * 64 + c) * 8192u;
              const int posn = 64 * c + n, tn = dir ? (T - 1 - posn) : posn;
              const unsigned Yo = (unsigned)(dir ? WS_YB : WS_YF) + (unsigned)(((b * T + tn) * DR + h * 64) * 2);
#pragma unroll
              for (int mi = 0; mi < 2; ++mi) { const int mt = mb + mi, m0 = 16 * mt + 4 * (lane >> 4);
                  const bf16x8 aW10 = frag_tr(lds + I_W1, 0, 16 * mt, lane), aW11 = frag_tr(lds + I_W1, 32, 16 * mt, lane);
                  const bf16x8 aBh0 = frag_tr(lds + I_BH, 0, 16 * mt, lane), aBh1 = frag_tr(lds + I_BH, 32, 16 * mt, lane);
                  const bf16x8 aKh0 = frag_tr(lds + I_KH, 0, 16 * mt, lane), aKh1 = frag_tr(lds + I_KH, 32, 16 * mt, lane);
                  const f32x4 mlr = MFMA16(aW11, bBh1, MFMA16(aW10, bBh0, fz));
                  const f32x4 ntv = MFMA16(aKh1, bVv1, MFMA16(aKh0, bVv0, MFMA16(aBh1, bW21, MFMA16(aBh0, bW20, fz))));
                  const int fo = ((nt * 2 + (mt >> 1)) * 64 + (lane & 15) + 16 * (2 * (mt & 1) + (lane >> 5))) * 8 + 4 * ((lane >> 4) & 1);
                  { u32x2 w; w.x = pk2(mlr[0], mlr[1]); w.y = pk2(mlr[2], mlr[3]); *(u32x2*)(p.ws + (size_t)(MLRo + 2u * (unsigned)fo)) = w; }
                  { u32x2 w; w.x = pk2(ntv[0], ntv[1]); w.y = pk2(ntv[2], ntv[3]); *(u32x2*)(p.ws + (size_t)(NTo + 8u * (unsigned)((nt * 4 + mt) * 64 + lane))) = w; }
                  if (!isctx) {
                      const bf16x8 aW20 = frag_tr(lds + I_W2, 0, 16 * mt, lane), aW21 = frag_tr(lds + I_W2, 32, 16 * mt, lane);
                      const bf16x8 aVv0 = frag_tr(vvimg, 0, 16 * mt, lane), aVv1 = frag_tr(vvimg, 32, 16 * mt, lane);
                      f32x4 rb = MFMA16(aW11, bPb1, MFMA16(aW10, bPb0, fz));
                      const f32x4 y0 = MFMA16(aVv1, bPk1, MFMA16(aVv0, bPk0, MFMA16(aW21, bPb1, MFMA16(aW20, bPb0, fz))));
                      rb += up4(*(const LAS u32x2*)(lds + I_RT + ioff(n, m0)));
                      { u32x2 w; w.x = pk2(rb[0], rb[1]); w.y = pk2(rb[2], rb[3]); *(u32x2*)(p.ws + (size_t)(RBo + 2u * (unsigned)fo)) = w; }
                      { u32x2 w; w.x = pk2(y0[0], y0[1]); w.y = pk2(y0[2], y0[3]); *(u32x2*)(p.ws + (size_t)(Yo + 2u * (unsigned)m0)) = w; }
                  } } }
#if XSCOPE
#pragma unroll
            for (int e = 0; e < 8; ++e) { r[e] = rn[e]; k[e] = kn[e]; }
#else
            if (cc + 1 < 34) {
#pragma unroll
                for (int e = 0; e < 8; ++e) { r[e] = rn[e]; k[e] = kn[e]; } }
#endif
        }
    }
}
#undef X_PXLOAD
#undef X_LERP
#undef X_LORA

struct SSet { bf16x8 A0, A1, R0, R1; u32x2 N0, Y0; f32x4 G; size_t yoff; };
__device__ __forceinline__ void phase_scanS(const Params& p, LAS unsigned char* lds, int bid, int G, int wv) {
    const int tid = my_tid(wv), lane = tid & 63, wave = __builtin_amdgcn_readfirstlane(tid >> 6);
    LAS unsigned char* HH = lds; LAS unsigned char* HL = lds + IMG;
    const int mtk = wave >> 1, ntl = wave & 1;
    const f32x4 fz = (f32x4){0.f, 0.f, 0.f, 0.f};
    for (int it = bid; it < NB * NH * 2 * 2; it += G) {
        const int item = it & 127, half = it >> 7, ntg = 2 * half + ntl;
        const int dir = item & 1, h = (item >> 1) & 7, b = item >> 4;
        f32x4 Hm0 = fz;
        LBAR();
        st_img(HH, 16 * ntl, 16 * mtk, lane, fz); st_img(HL, 16 * ntl, 16 * mtk, lane, fz);
        LBAR();
        const bf16_t* MLRg = (const bf16_t*)(p.ws + WS_MLR) + (size_t)item * 68 * 4096; const bf16_t* NTg = (const bf16_t*)(p.ws + WS_NT) + (size_t)item * 68 * 4096;
        const float* GAMg = (const float*)(p.ws + WS_GAM) + (size_t)item * 68 * 64; const bf16_t* RBg = (const bf16_t*)(p.ws + WS_RB) + (size_t)item * 64 * 4096;
        bf16_t* Yg = (bf16_t*)(p.ws + (dir ? WS_YB : WS_YF)) + (size_t)b * T * DR + h * 64;
        const int arow = (mtk * 2 * 64 + lane) * 8;
#define S_LOAD(S_, ci_) do { const int ci__ = (ci_) < 68 ? (ci_) : 67; const int c__ = ci__ >= 4 ? ci__ - 4 : 0; \
            const bf16_t* M__ = MLRg + (size_t)ci__ * 4096; S_.A0 = *(const bf16x8*)(M__ + arow); S_.A1 = *(const bf16x8*)(M__ + arow + 512); \
            S_.N0 = *(const u32x2*)(NTg + (size_t)ci__ * 4096 + lane * 4 + (ntg * 4 + mtk) * 256); \
            S_.G = *(const f32x4*)(GAMg + ci__ * 64 + 16 * mtk + 4 * (lane >> 4)); \
            const bf16_t* R__ = RBg + (size_t)c__ * 4096; S_.R0 = *(const bf16x8*)(R__ + arow); S_.R1 = *(const bf16x8*)(R__ + arow + 512); \
            const int pos__ = 64 * c__ + 16 * mtk + (lane & 15), t__ = dir ? (T - 1 - pos__) : pos__; \
            S_.yoff = (size_t)t__ * DR + 4 * (lane >> 4) + 16 * ntg; S_.Y0 = *(const u32x2*)(Yg + S_.yoff); } while (0)
#define S_STEP(S_, ci_) do { if ((ci_) < 68) { \
            const bf16x8 h00 = frag_rm(HH, 16 * ntl, 0, lane), h01 = frag_rm(HH, 16 * ntl, 32, lane); \
            const bf16x8 l00 = frag_rm(HL, 16 * ntl, 0, lane), l01 = frag_rm(HL, 16 * ntl, 32, lane); \
            f32x4 a0 = Hm0 * S_.G + up4(S_.N0); \
            a0 = MFMA16(S_.A0, h00, a0); a0 = MFMA16(S_.A1, h01, a0); a0 = MFMA16(S_.A0, l00, a0); a0 = MFMA16(S_.A1, l01, a0); \
            if ((ci_) >= 4) { \
                f32x4 y0 = up4(S_.Y0); \
                y0 = MFMA16(h00, S_.R0, y0); y0 = MFMA16(h01, S_.R1, y0); y0 = MFMA16(l00, S_.R0, y0); y0 = MFMA16(l01, S_.R1, y0); \
                { u32x2 w; w.x = pk2(y0[0], y0[1]); w.y = pk2(y0[2], y0[3]); *(u32x2*)(Yg + S_.yoff) = w; } } \
            LBAR(); \
            Hm0 = a0; \
            { f32x4 hi, lo; \
              _Pragma("unroll") for (int q = 0; q < 4; ++q) { hi[q] = __uint_as_float(f2bf(a0[q]) << 16); lo[q] = a0[q] - hi[q]; } \
              st_img(HH, 16 * ntl, 16 * mtk, lane, hi); st_img(HL, 16 * ntl, 16 * mtk, lane, lo); } \
            LBAR(); } } while (0)
        SSet s0, s1, s2, s3;
        S_LOAD(s0, 0); S_LOAD(s1, 1); S_LOAD(s2, 2);
        for (int ci = 0; ci < 68; ci += 4) {
            S_LOAD(s3, ci + 3); S_STEP(s0, ci);
            S_LOAD(s0, ci + 4); S_STEP(s1, ci + 1);
            S_LOAD(s1, ci + 5); S_STEP(s2, ci + 2);
            S_LOAD(s2, ci + 6); S_STEP(s3, ci + 3);
        }
#undef S_LOAD
#undef S_STEP
    }
}

__device__ __forceinline__ void phase_out(const Params& p, LAS unsigned char* lds, int bid, int G, int wv) {
    const int tid_ = my_tid(wv), lane_ = tid_ & 63, wave = __builtin_amdgcn_readfirstlane(tid_ >> 6);
    const bf16_t* PX = (const bf16_t*)(p.ws + WS_PX); const bf16_t* YF = (const bf16_t*)(p.ws + WS_YF); const bf16_t* YB = (const bf16_t*)(p.ws + WS_YB);
    const float* BDOT = (const float*)(p.ws + WS_BDOT);
    bf16_t* AX = (bf16_t*)(p.ws + WS_AX);
    const float* mu = p.in[9];
    constexpr int SGS = 272;
    LAS unsigned char* SG = lds;
    LAS unsigned char* GW = lds + 64 * SGS + wave * IMG;
    const f32x4 fz = (f32x4){0.f, 0.f, 0.f, 0.f};
    bf16x8 gf[4][4];
    { const float* gu = p.in[17] + wave * 64 + (lane_ & 15);
#pragma unroll
      for (int ct = 0; ct < 4; ++ct)
#pragma unroll
          for (int ks = 0; ks < 4; ++ks) { float f[8];
#pragma unroll
              for (int e = 0; e < 8; ++e) f[e] = gu[(size_t)(32 * ks + 8 * (lane_ >> 4) + e) * DR + 16 * ct];
              gf[ct][ks] = __builtin_bit_cast(bf16x8, pack8(f)); } }
    const int tokl = lane_ >> 3, cs = lane_ & 7, cb = wave * 64 + cs * 8;
    float gng[8], gnb[8];
    { const f32x4 g0 = *(const f32x4*)(p.in[18] + cb), g1 = *(const f32x4*)(p.in[18] + cb + 4), b0 = *(const f32x4*)(p.in[19] + cb), b1 = *(const f32x4*)(p.in[19] + cb + 4);
      gng[0] = g0.x; gng[1] = g0.y; gng[2] = g0.z; gng[3] = g0.w; gng[4] = g1.x; gng[5] = g1.y; gng[6] = g1.z; gng[7] = g1.w;
      gnb[0] = b0.x; gnb[1] = b0.y; gnb[2] = b0.z; gnb[3] = b0.w; gnb[4] = b1.x; gnb[5] = b1.y; gnb[6] = b1.z; gnb[7] = b1.w; }
    for (int bq = bid; bq < MX / 64; bq += G) {
        const int bt = (G == 256) ? ((bq & 7) * 64 + ((bq & 255) >> 3) * 2 + (bq >> 8)) : bq;
        const int tok0 = bt * 64, b = tok0 >> 12, rowbase = b * T;
        LBAR();
        { const int tid = opq(tid_), tl = tid >> 3, sub = tid & 7; const int tok = tok0 + tl, t = tok & (T - 1);
          int nbr[4]; neighbours(t, false, rowbase, nbr);
          const Px5 q0 = px_load(PX, tok, nbr, 1664 + sub * 16), q1 = px_load(PX, tok, nbr, 1664 + sub * 16 + 8);
          float x0[8], x1[8]; px_lerp(q0, false, 1664 + sub * 16, mu, x0); px_lerp(q1, false, 1664 + sub * 16 + 8, mu, x1);
#pragma unroll
          for (int e = 0; e < 8; ++e) { x0[e] = fsigmoid(x0[e]); x1[e] = fsigmoid(x1[e]); }
          *(LAS u32x4*)(SG + tl * SGS + sub * 32) = pack8(x0); *(LAS u32x4*)(SG + tl * SGS + sub * 32 + 16) = pack8(x1); }
        LBAR();
        { const int lane = opq(lane_);
#pragma unroll
          for (int tt = 0; tt < 4; ++tt) { bf16x8 bs[4];
#pragma unroll
              for (int ks = 0; ks < 4; ++ks) bs[ks] = *(const LAS bf16x8*)(SG + (16 * tt + (lane & 15)) * SGS + (32 * ks + 8 * (lane >> 4)) * 2);
#pragma unroll
              for (int ct = 0; ct < 4; ++ct) { f32x4 acc = fz;
#pragma unroll
                  for (int ks = 0; ks < 4; ++ks) acc = MFMA16(gf[ct][ks], bs[ks], acc);
                  st_img(GW, 16 * tt, 16 * ct, lane, acc); } } }
        asm volatile("s_waitcnt lgkmcnt(0)" ::: "memory");
#pragma unroll 2
        for (int ps = 0; ps < 8; ++ps) {
            const int lane = opq(lane_); const int tl = 8 * ps + (lane >> 3), tok = tok0 + tl, t = tok & (T - 1);
            int nbr[4]; neighbours(t, false, rowbase, nbr);
            const Px5 qv = px_load(PX, tok, nbr, 1024 + cb);
            float yf[8], yb[8], y[8], g[8], v[8];
            unpack8(*(const u32x4*)(YF + (size_t)tok * DR + cb), yf); unpack8(*(const u32x4*)(YB + (size_t)tok * DR + cb), yb);
            const float bd = BDOT[(size_t)tok * NH + wave] + BDOT[((size_t)MX + tok) * NH + wave];
            unpack8(*(const LAS u32x4*)(GW + ioff(tl, 8 * (lane & 7))), g);
            px_lerp(qv, false, 1024 + cb, mu, v);
            float s1 = 0.f;
#pragma unroll
            for (int e = 0; e < 8; ++e) { y[e] = yf[e] + yb[e]; s1 += y[e]; }
            const float mean = red8(s1) * (1.f / 64.f);
            float s2 = 0.f;
#pragma unroll
            for (int e = 0; e < 8; ++e) { y[e] -= mean; s2 += y[e] * y[e]; }
            const float rstd = rsqrtf(red8(s2) * (1.f / 64.f) + 64e-5f);
            float ax[8];
#pragma unroll
            for (int e = 0; e < 8; ++e) ax[e] = (y[e] * rstd * gng[e] + gnb[e] + bd * v[e]) * g[e];
            *(u32x4*)(AX + (size_t)tok * D + cb) = pack8(ax);
        }
        { const float* cwp = p.in[20] + cb;
          const f32x4 w00 = *(const f32x4*)(cwp), w01 = *(const f32x4*)(cwp + 4), w10 = *(const f32x4*)(cwp + DR), w11 = *(const f32x4*)(cwp + DR + 4), w20 = *(const f32x4*)(cwp + 2 * DR), w21 = *(const f32x4*)(cwp + 2 * DR + 4);
          const float cw0[8] = {w00.x, w00.y, w00.z, w00.w, w01.x, w01.y, w01.z, w01.w}, cw1[8] = {w10.x, w10.y, w10.z, w10.w, w11.x, w11.y, w11.z, w11.w}, cw2[8] = {w20.x, w20.y, w20.z, w20.w, w21.x, w21.y, w21.z, w21.w};
#pragma unroll 2
          for (int ps = 0; ps < 8; ++ps) {
              const int lane = opq(lane_); const int tok = tok0 + 8 * ps + (lane >> 3), t = tok & (T - 1);
              float bg[8], c0[8], u0[8], cm[8], um[8], cp[8], up[8];
              const u32x4 z = (u32x4){0u, 0u, 0u, 0u};
              const bf16_t* pr = PX + (size_t)tok * DIN + RWC + cb;
              unpack8(*(const u32x4*)pr, bg); unpack8(*(const u32x4*)(pr + 512), c0); unpack8(*(const u32x4*)(pr + 1024), u0);
              unpack8(t > 0 ? *(const u32x4*)(pr - DIN + 512) : z, cm); unpack8(t > 0 ? *(const u32x4*)(pr - DIN + 1024) : z, um);
              unpack8(t < T - 1 ? *(const u32x4*)(pr + DIN + 512) : z, cp); unpack8(t < T - 1 ? *(const u32x4*)(pr + DIN + 1024) : z, up);
              float bx[8];
#pragma unroll
              for (int e = 0; e < 8; ++e) bx[e] = bg[e] * (cw0[e] * (cm[e] * um[e]) + cw1[e] * (c0[e] * u0[e]) + cw2[e] * (cp[e] * up[e]));
              *(u32x4*)(AX + (size_t)tok * D + DR + cb) = pack8(bx);
          } }
    }
}

__device__ __forceinline__ void phase_hx(const Params& p, LAS unsigned char* lds, int bid, int G, int wv) {
    const int tid = my_tid(wv), lane = tid & 63, wave = tid >> 6;
    const bf16_t* X1 = (const bf16_t*)(p.ws + WS_X1); const float* MOD = (const float*)(p.ws + WS_MOD); const float* n2g = p.in[7];
    unsigned char* HX = p.ws + WS_HX; float* AFF = (float*)(p.ws + WS_AFF);
    LAS float* RW = (LAS float*)lds;
    { const float* rw = p.in[22]; for (int i = tid; i < 1024 * 16; i += NTHR) RW[(i & 15) * 1024 + (i >> 4)] = rw[i]; }
    __syncthreads();
    const int gw = bid * NWAVES + wave, NGW = G * NWAVES;
    const bool u5 = (lane & 32) != 0, u4 = (lane & 16) != 0, u3 = (lane & 8) != 0, u2 = (lane & 4) != 0;
    const int emine = (u5 ? 8 : 0) + (u4 ? 4 : 0) + (u3 ? 2 : 0) + (u2 ? 1 : 0);
    for (int blk = gw; blk < MX / 16; blk += NGW) {
        const int tokb = blk * 16, b = tokb >> 12;
        const float* sh = MOD + (size_t)b * 6144 + 3072; const float* scp = sh + 1024;
        f32x4 ga[4], hb[4];
#pragma unroll
        for (int j = 0; j < 4; ++j) { const int col = 4 * (lane + 64 * j); ga[j] = *(const f32x4*)(n2g + col) * (*(const f32x4*)(scp + col) + 1.f); hb[j] = *(const f32x4*)(sh + col); }
        u32x2 xq[2][4];
#pragma unroll
        for (int tk = 0; tk < 2; ++tk)
#pragma unroll
            for (int j = 0; j < 4; ++j) xq[tk][j] = ((const u32x2*)(X1 + (size_t)(tokb + tk) * D))[lane + 64 * j];
        for (int it = 0; it < 8; ++it) {
            f32x4 yv[2][4]; float lg[2][16];
            u32x2 xn[2][4];
            { const int itn = it < 7 ? it + 1 : it;
#pragma unroll
              for (int tk = 0; tk < 2; ++tk)
#pragma unroll
                for (int j = 0; j < 4; ++j) xn[tk][j] = ((const u32x2*)(X1 + (size_t)(tokb + 2 * itn + tk) * D))[lane + 64 * j]; }
#pragma unroll
            for (int tk = 0; tk < 2; ++tk) { const int tok = tokb + 2 * it + tk;
                f32x4 v[4]; float ss = 0.f;
#pragma unroll
                for (int j = 0; j < 4; ++j) { v[j] = up4(xq[tk][j]); ss += (v[j].x * v[j].x + v[j].y * v[j].y) + (v[j].z * v[j].z + v[j].w * v[j].w); }
                const float rstd = rsqrtf(wave_sum(ss) * (1.f / D) + 1e-6f);
#pragma unroll
                for (int j = 0; j < 4; ++j) { const f32x4 y = v[j] * rstd * ga[j] + hb[j]; yv[tk][j] = y;
#if MOE_FP8
                    *(unsigned*)(HX + (size_t)tok * D + 4 * (lane + 64 * j)) = pk4_fp8_raw(y.x, y.y, y.z, y.w); } }
#else
                    u32x2 o; o.x = pk2(y.x, y.y); o.y = pk2(y.z, y.w);
                    *(u32x2*)((bf16_t*)HX + (size_t)tok * D + 4 * (lane + 64 * j)) = o; } }
#endif
            f32x2 yp[4][4];
#pragma unroll
            for (int j = 0; j < 4; ++j)
#pragma unroll
                for (int c = 0; c < 4; ++c) yp[j][c] = (f32x2){yv[0][j][c], yv[1][j][c]};
#pragma unroll
            for (int e = 0; e < 16; ++e) { f32x2 a = (f32x2){0.f, 0.f}, a2 = (f32x2){0.f, 0.f};
#pragma unroll
                for (int j = 0; j < 4; ++j) { const f32x4 w = *(const LAS f32x4*)(RW + e * 1024 + 4 * (lane + 64 * j));
                    a += yp[j][0] * (f32x2){w.x, w.x}; a2 += yp[j][1] * (f32x2){w.y, w.y}; a += yp[j][2] * (f32x2){w.z, w.z}; a2 += yp[j][3] * (f32x2){w.w, w.w}; }
                a += a2;
                float a0 = a.x, a1 = a.y;
                asm volatile("" : "+v"(a0), "+v"(a1) :: "memory");
                lg[0][e] = a0; lg[1][e] = a1; }
#pragma unroll
            for (int tk = 0; tk < 2; ++tk) { const int tok = tokb + 2 * it + tk, t = tok & (T - 1);
                float r8[8], r4[4], r2[2], r1;
#pragma unroll
                for (int k = 0; k < 8; ++k) { const float keep = u5 ? lg[tk][k + 8] : lg[tk][k], send = u5 ? lg[tk][k] : lg[tk][k + 8]; r8[k] = keep + __shfl_xor(send, 32); }
#pragma unroll
                for (int k = 0; k < 4; ++k) { const float keep = u4 ? r8[k + 4] : r8[k], send = u4 ? r8[k] : r8[k + 4]; r4[k] = keep + __shfl_xor(send, 16); }
#pragma unroll
                for (int k = 0; k < 2; ++k) { const float keep = u3 ? r4[k + 2] : r4[k], send = u3 ? r4[k] : r4[k + 2]; r2[k] = keep + __shfl_xor(send, 8); }
                { const float keep = u2 ? r2[1] : r2[0], send = u2 ? r2[0] : r2[1]; r1 = keep + __shfl_xor(send, 4); }
                r1 += __shfl_xor(r1, 1); r1 += __shfl_xor(r1, 2);
                float mx = r1;
                mx = fmaxf(mx, __shfl_xor(mx, 4)); mx = fmaxf(mx, __shfl_xor(mx, 8)); mx = fmaxf(mx, __shfl_xor(mx, 16)); mx = fmaxf(mx, __shfl_xor(mx, 32));
                const float ex = expf(r1 - mx);
                float den = ex;
                den += __shfl_xor(den, 4); den += __shfl_xor(den, 8); den += __shfl_xor(den, 16); den += __shfl_xor(den, 32);
                if ((lane & 3) == 0) AFF[((size_t)b * NE + emine) * T + t] = ex / den; }
#pragma unroll
            for (int tk = 0; tk < 2; ++tk)
#pragma unroll
                for (int j = 0; j < 4; ++j) xq[tk][j] = xn[tk][j];
        }
    }
}

__device__ __forceinline__ int block_scan512(int v, LAS int* sc, int tid, int& total) {
    const int lane = tid & 63, w = tid >> 6;
    int x = v;
#pragma unroll
    for (int o = 1; o < 64; o <<= 1) { const int y = __shfl_up(x, o); x += (lane >= o) ? y : 0; }
    if (lane == 63) sc[w] = x;
    __syncthreads();
    int base = 0, tot = 0;
#pragma unroll
    for (int i = 0; i < 8; ++i) { const int t = sc[i]; tot += t; base += (i < w) ? t : 0; }
    __syncthreads();
    total = tot; return base + x - v;
}
__device__ __forceinline__ void radix_round(const int (&bin)[8], const bool (&act)[8], int need, LAS int* hist, LAS int* sc, int tid, int& Bsel, int& aboveSel) {
#pragma unroll
    for (int q = 0; q < 8; ++q) hist[tid * 8 + q] = 0;
    __syncthreads();
#pragma unroll
    for (int q = 0; q < 8; ++q) if (act[q]) atomicAdd((int*)(hist + bin[q]), 1);
    __syncthreads();
    int c[8], ssum = 0;
#pragma unroll
    for (int q = 0; q < 8; ++q) { c[q] = hist[tid * 8 + q]; ssum += c[q]; }
    int total; const int P = block_scan512(ssum, sc, tid, total);
    int running = total - P - ssum;
#pragma unroll
    for (int q = 7; q >= 0; --q) { if (running < need && running + c[q] >= need) { sc[8] = tid * 8 + q; sc[9] = running; } running += c[q]; }
    __syncthreads();
    Bsel = sc[8]; aboveSel = sc[9];
    __syncthreads();
}
__device__ __forceinline__ void phase_topk(const Params& p, LAS unsigned char* lds, int bid, int G, int wv) {
    const int tid = my_tid(wv);
    const float* AFF = (const float*)(p.ws + WS_AFF);
    int* IDX = (int*)(p.ws + WS_IDX); float* VAL = (float*)(p.ws + WS_VAL); int* SEL = (int*)(p.ws + WS_SEL);
    LAS int* hist = (LAS int*)lds;
    LAS int* sc = (LAS int*)(lds + 16384);
    for (int item = bid; item < NB * NE; item += G) {
        const int b = item >> 4, e = item & 15;
        __syncthreads();
        const f32x4 v0 = ((const f32x4*)(AFF + (size_t)item * T))[2 * tid], v1 = ((const f32x4*)(AFF + (size_t)item * T))[2 * tid + 1];
        const float val[8] = {v0.x, v0.y, v0.z, v0.w, v1.x, v1.y, v1.z, v1.w};
        unsigned key[8]; int bin[8]; bool act[8];
#pragma unroll
        for (int q = 0; q < 8; ++q) { key[q] = __float_as_uint(val[q]); bin[q] = (int)(key[q] >> 20); act[q] = true; }
        int B1, ab1; radix_round(bin, act, CAP, hist, sc, tid, B1, ab1);
        const int need1 = CAP - ab1;
#pragma unroll
        for (int q = 0; q < 8; ++q) { act[q] = (int)(key[q] >> 20) == B1; bin[q] = (int)((key[q] >> 8) & 0xFFFu); }
        int B2, ab2; radix_round(bin, act, need1, hist, sc, tid, B2, ab2);
        const int need2 = need1 - ab2;
#pragma unroll
        for (int q = 0; q < 8; ++q) { act[q] = act[q] && (int)((key[q] >> 8) & 0xFFFu) == B2; bin[q] = (int)(key[q] & 0xFFu); }
        int B3, ab3; radix_round(bin, act, need2, hist, sc, tid, B3, ab3);
        const int need3 = need2 - ab3;
        const unsigned K = ((unsigned)B1 << 20) | ((unsigned)B2 << 8) | (unsigned)B3;
        int eqc = 0;
#pragma unroll
        for (int q = 0; q < 8; ++q) eqc += (key[q] == K) ? 1 : 0;
        int tot; int eqr = block_scan512(eqc, sc, tid, tot);
        bool selq[8]; int cnt = 0;
#pragma unroll
        for (int q = 0; q < 8; ++q) { const bool eq = key[q] == K; selq[q] = key[q] > K || (eq && eqr < need3); eqr += eq ? 1 : 0; cnt += selq[q] ? 1 : 0; }
        int slot = block_scan512(cnt, sc, tid, tot);
#pragma unroll
        for (int q = 0; q < 8; ++q) { const int tok = tid * 8 + q;
            SEL[(size_t)item * T + tok] = selq[q] ? slot : -1;
            if (selq[q]) { IDX[(e * NB + b) * CAP + slot] = b * T + tok; VAL[(e * NB + b) * CAP + slot] = val[q]; ++slot; } }
    }
}

__device__ __forceinline__ void phase_final(const Params& p, int bid, int G, int wv) {
    const int tid = my_tid(wv), lane = tid & 63, wave = tid >> 6;
    const bf16_t* X1 = (const bf16_t*)(p.ws + WS_X1); const bf16_t* DN = (const bf16_t*)(p.ws + WS_DN); const int* SEL = (const int*)(p.ws + WS_SEL);
    const float* fg = p.in[26];
    const int gw = bid * NWAVES + wave, NGW = G * NWAVES;
    for (int tok0 = gw; tok0 < MX; tok0 += 2 * NGW) {
        f32x4 v[2][4]; int sel[2]; unsigned long long mask[2];
#pragma unroll
        for (int tk = 0; tk < 2; ++tk) { const int tok = tok0 + tk * NGW, b = tok >> 12, t = tok & (T - 1);
            sel[tk] = lane < NE ? SEL[((size_t)b * NE + lane) * T + t] : -1;
#pragma unroll
            for (int j = 0; j < 4; ++j) v[tk][j] = up4(((const u32x2*)(X1 + (size_t)tok * D))[lane + 64 * j]); }
#pragma unroll
        for (int tk = 0; tk < 2; ++tk) mask[tk] = __ballot(sel[tk] >= 0);
#pragma unroll
        for (int tk = 0; tk < 2; ++tk) { const int tok = tok0 + tk * NGW, b = tok >> 12;
            unsigned long long m = mask[tk];
            while (m) {
#if MOE_FP8
                const unsigned char* rp[4]; float wg[4];
#pragma unroll
                for (int q = 0; q < 4; ++q) {
                    if (m) { const int e = __builtin_ctzll(m); m &= m - 1; const int s_ = __builtin_amdgcn_readlane(sel[tk], e);
                        rp[q] = (const unsigned char*)DN + ((size_t)(e * NB + b) * CAP + s_) * D; wg[q] = 1.f / 16.f; }
                    else { rp[q] = (const unsigned char*)DN; wg[q] = 0.f; } }
                unsigned w[4][4];
#pragma unroll
                for (int q = 0; q < 4; ++q)
#pragma unroll
                    for (int j = 0; j < 4; ++j) w[q][j] = *(const unsigned*)(rp[q] + 4 * (lane + 64 * j));
#pragma unroll
                for (int q = 0; q < 4; ++q)
#pragma unroll
                    for (int j = 0; j < 4; ++j) { const f32x2 lo = __builtin_amdgcn_cvt_pk_f32_fp8((int)w[q][j], false), hi = __builtin_amdgcn_cvt_pk_f32_fp8((int)w[q][j], true);
                        v[tk][j].x += wg[q] * lo.x; v[tk][j].y += wg[q] * lo.y; v[tk][j].z += wg[q] * hi.x; v[tk][j].w += wg[q] * hi.y; }
#else
                const bf16_t* rp[4]; float wg[4];
#pragma unroll
                for (int q = 0; q < 4; ++q) {
                    if (m) { const int e = __builtin_ctzll(m); m &= m - 1; const int s_ = __builtin_amdgcn_readlane(sel[tk], e);
                        rp[q] = DN + ((size_t)(e * NB + b) * CAP + s_) * D; wg[q] = 1.f; }
                    else { rp[q] = DN; wg[q] = 0.f; } }
                u32x2 w[4][4];
#pragma unroll
                for (int q = 0; q < 4; ++q)
#pragma unroll
                    for (int j = 0; j < 4; ++j) w[q][j] = *(const u32x2*)(rp[q] + 4 * (lane + 64 * j));
#pragma unroll
                for (int q = 0; q < 4; ++q)
#pragma unroll
                    for (int j = 0; j < 4; ++j) { v[tk][j].x += wg[q] * bflo(w[q][j].x); v[tk][j].y += wg[q] * bfhi(w[q][j].x); v[tk][j].z += wg[q] * bflo(w[q][j].y); v[tk][j].w += wg[q] * bfhi(w[q][j].y); }
#endif
            } }
#pragma unroll
        for (int tk = 0; tk < 2; ++tk) { const int tok = tok0 + tk * NGW;
            float ss = 0.f;
#pragma unroll
            for (int j = 0; j < 4; ++j) ss += (v[tk][j].x * v[tk][j].x + v[tk][j].y * v[tk][j].y) + (v[tk][j].z * v[tk][j].z + v[tk][j].w * v[tk][j].w);
            const float rstd = rsqrtf(wave_sum(ss) * (1.f / D) + 1e-6f);
#pragma unroll
            for (int j = 0; j < 4; ++j) { const int col = 4 * (lane + 64 * j); const f32x4 g = *(const f32x4*)(fg + col);
                *(f32x4*)(p.out + (size_t)tok * D + col) = v[tk][j] * rstd * g; } }
    }
}

#define XB_TMO      128
#define XB_XCNT(j)  (256  + 64 * (j))
#define XB_XSUB(j)  (1280 + 64 * (j))
#define XB_XGEN(j)  (2304 + 64 * (j))
#define XB_TOP      3328
#define XB_TOPGEN   3392
#define XCD_BAR_WORDS 3456
#define XB_SPIN_CAP (1u << 20)
__device__ __forceinline__ unsigned xb_ld(unsigned* p)              { return __hip_atomic_load(p, __ATOMIC_RELAXED, __HIP_MEMORY_SCOPE_AGENT); }
__device__ __forceinline__ unsigned xb_add(unsigned* p, unsigned v) { return __hip_atomic_fetch_add(p, v, __ATOMIC_RELAXED, __HIP_MEMORY_SCOPE_AGENT); }
__device__ __forceinline__ unsigned xb_xcc_id() { return (unsigned)__builtin_amdgcn_s_getreg((3 << 11) | 20) & 0xFu; }
#define XB_SPIN(cond, bar) do { unsigned _sp = 0; while (cond) { __builtin_amdgcn_s_sleep(1); \
    if ((++_sp & 255u) == 0u) { if (xb_ld(&(bar)[XB_TMO])) break; if (_sp > XB_SPIN_CAP) { atomicAdd(&(bar)[XB_TMO], 1u); break; } } } } while (0)
struct XcdBarrier { unsigned* bar; unsigned x; volatile LAS unsigned* st; int wv; };
__device__ __forceinline__ XcdBarrier xcd_barrier_post(unsigned* bar, volatile LAS unsigned* st, int wv) {
    XcdBarrier b; b.bar = bar; b.x = xb_xcc_id(); b.st = st; b.wv = wv;
    if (my_tid(wv) == 0) (void)xb_add(&bar[XB_XCNT(b.x)], 1u);
    return b;
}
__device__ __forceinline__ void xcd_barrier_complete(unsigned* bar, unsigned x, unsigned& nloc, unsigned& nx) {
    const unsigned G = gridDim.x * gridDim.y * gridDim.z;
    unsigned sum, cnt, mine, sp = 0u;
    for (;;) {
        sum = 0u; cnt = 0u; mine = 0u;
#pragma unroll
        for (unsigned j = 0; j < 16; ++j) { const unsigned c = xb_ld(&bar[XB_XCNT(j)]); sum += c; cnt += (c > 0u) ? 1u : 0u; mine = (j == x) ? c : mine; }
        if (sum == G) break;
        __builtin_amdgcn_s_sleep(1);
        if ((++sp & 255u) == 0u) { if (xb_ld(&bar[XB_TMO])) break; if (sp > XB_SPIN_CAP) { atomicAdd(&bar[XB_TMO], 1u); break; } }
    }
    nloc = mine > 0u ? mine : 1u; nx = cnt > 0u ? cnt : 1u;
}
__device__ __forceinline__ void xcd_barrier(const XcdBarrier& b) {
    asm volatile("s_waitcnt vmcnt(0)" ::: "memory");
    __syncthreads();
    if (my_tid(b.wv) == 0) {
        unsigned* bar = b.bar;
        __builtin_amdgcn_s_waitcnt(0);
        unsigned nloc = b.st[0], nx = b.st[1];
        if (nloc == 0u) { xcd_barrier_complete(bar, b.x, nloc, nx); b.st[0] = nloc; b.st[1] = nx; }
        const unsigned old = xb_add(&bar[XB_XSUB(b.x)], 1u);
        const unsigned gen = old / nloc;
        if (old + 1u == (gen + 1u) * nloc) {
            __builtin_amdgcn_fence(__ATOMIC_RELEASE, "agent");
            asm volatile("s_waitcnt vmcnt(0)" ::: "memory");
            const unsigned og = xb_add(&bar[XB_TOP], 1u);
            const unsigned tg = og / nx;
            if (og + 1u == (tg + 1u) * nx) xb_add(&bar[XB_TOPGEN], 1u);
            else XB_SPIN(xb_ld(&bar[XB_TOPGEN]) == tg, bar);
            __builtin_amdgcn_fence(__ATOMIC_ACQUIRE, "agent");
            xb_add(&bar[XB_XGEN(b.x)], 1u);
            asm volatile("s_waitcnt vmcnt(0)" ::: "memory");
        } else {
            XB_SPIN(xb_ld(&bar[XB_XGEN(b.x)]) == gen, bar);
            __builtin_amdgcn_fence(__ATOMIC_ACQUIRE, "agent");
            asm volatile("s_waitcnt vmcnt(0)" ::: "memory");
        }
    }
    __syncthreads();
}

constexpr int N_PHASES = 12;
__global__ void __launch_bounds__(NTHR, 2) mk_fwd(Params p) {
    extern __shared__ __attribute__((aligned(16))) unsigned char lds_raw[];
    LAS unsigned char* lds = (LAS unsigned char*)lds_raw;
    const int bid = blockIdx.x, G = gridDim.x;
    const int wv = __builtin_amdgcn_readfirstlane((int)threadIdx.x >> 6);
    const int lo = p.ph_lo, hi = p.ph_hi;
#if MK_FUSED
    volatile LAS unsigned* misc = (volatile LAS unsigned*)(lds + LDS_MISC);
    { const int t0 = my_tid(wv); if (t0 < 16) misc[t0] = 0u; }
    __syncthreads();
    const XcdBarrier xbar = xcd_barrier_post((unsigned*)(p.ws + WS_CTL) + 4096, misc, wv);
#define SEAM(k) do { if (lo <= (k) && (k) + 1 < hi) xcd_barrier(xbar); } while (0)
#else
#define SEAM(k) do { } while (0)
#endif
#ifndef PH_MASK
#define PH_MASK 0xFFF
#endif
#ifndef PH_REP
#define PH_REP 0
#endif
#define NREP(k) ((((PH_REP) >> (k)) & 1) ? 2 : 1)
#define IN(k) (((PH_MASK >> (k)) & 1) && lo <= (k) && (k) < hi)
    unsigned char* ws = sgpr_ptr(p.ws); unsigned char* outs = sgpr_ptr(p.out);
    if (IN(0)) { for (int r = 0; r < NREP(0); ++r) { phase0(p, lds, bid, G, wv); __syncthreads(); } SEAM(0); }
    if (IN(1)) { for (int r = 0; r < NREP(1); ++r) phase1(p, bid, G, wv); SEAM(1); }
    if (IN(2)) {
        pg8::Gemm g{(const bf16_t*)(ws + WS_XN), (const bf16_t*)(ws + WS_WINT), MALL, DIN, D, nullptr};
        pg8::InProjOrder S; S.init(G, bid);
        pg8::EpiBf16Plain E{(bf16_t*)(ws + WS_PX), DIN};
        pg8::gemm_phase<pg8::EpiBf16Plain, pg8::InProjOrder, true, true, false, false, PG8_BUF_IN>(lds, g, S, E, wv);
        SEAM(2);
    }
    for (int rep = 0; rep < NREP(4); ++rep) {
    if (IN(3)) { for (int r3 = 0; r3 < NREP(3); ++r3) phase_scanX(p, lds, bid, G, wv); SEAM(3); }
    if (IN(4)) { phase_scanS(p, lds, bid, G, wv); SEAM(4); }
    }
    if (IN(5)) { for (int r = 0; r < NREP(5); ++r) phase_out(p, lds, bid, G, wv); SEAM(5); }
    if (IN(6)) {
        pg8::Gemm g{(const bf16_t*)(ws + WS_AX), (const bf16_t*)(ws + WS_WOUTT), MX, D, D, nullptr};
        pg8::StaticOrder S; S.init(MX, D, G, bid);
        pg8::EpiResid E{p.in[0], (bf16_t*)(ws + WS_X1), (const float*)(ws + WS_MOD)};
        pg8::gemm_phase<pg8::EpiResid, pg8::StaticOrder, true, true, false, false, PG8_BUF_OUT>(lds, g, S, E, wv);
        SEAM(6);
    }
    if (IN(7)) { for (int r = 0; r < NREP(7); ++r) { phase_hx(p, lds, bid, G, wv); __syncthreads(); }
#if CVPOS == 0
        { const int tid = my_tid(wv), lane = tid & 63, gw = bid * NWAVES + (tid >> 6);
          for (int g = gw; g < 3 * 8192; g += G * NWAVES) { f32x4 cv[8]; xcvt_load(p, g, lane, cv); xcvt_store(p, g, lane, cv); } }
#endif
        SEAM(7); }
    if (IN(8)) { for (int r = 0; r < NREP(8); ++r) phase_topk(p, lds, bid, G, wv); SEAM(8); }
    if (IN(9)) {
        pg8::Gemm g{(const bf16_t*)(ws + WS_HX), (const bf16_t*)outs, NE * NB * CAP, NE * 2048, MOE_FP8 ? D / 2 : D, (const int*)(ws + WS_IDX)};
        pg8::ExpertOrder S; S.init(NE, 16, 8, G, bid);
        pg8::EpiSwiGLU E{ws + WS_HID};
        pg8::gemm_phase<pg8::EpiSwiGLU, pg8::ExpertOrder, true, true, true, MOE_FP8 != 0, PG8_BUF_MOE1>(lds, g, S, E, wv);
        SEAM(9);
    }
    if (IN(10)) {
        pg8::Gemm g{(const bf16_t*)(ws + WS_HID), (const bf16_t*)(outs + OUT_W2T), NE * NB * CAP, NE * 1024, MOE_FP8 ? DE / 2 : DE, nullptr};
        pg8::ExpertOrder S; S.init(NE, 16, 4, G, bid);
        pg8::EpiDown E{(bf16_t*)(ws + WS_DN), (const float*)(ws + WS_VAL), (const float*)(ws + WS_MOD)};
        pg8::gemm_phase<pg8::EpiDown, pg8::ExpertOrder, true, true, false, MOE_FP8 != 0, PG8_BUF_MOE2>(lds, g, S, E, wv);
        SEAM(10);
    }
    if (IN(11)) { for (int r = 0; r < NREP(11); ++r) phase_final(p, bid, G, wv); }
#undef IN
#undef SEAM
}

extern "C" void kernel_launch(void* const* d_in, const int* in_sizes, int n_in, void* d_out, int out_size, void* d_ws, size_t ws_size, hipStream_t stream) {
    static int grid = 0;
    if (grid == 0) {
        if (n_in != 27 || out_size != MX * D || ws_size < WS_END) { fprintf(stderr, "kernel_launch: unexpected shapes: n_in %d out %d ws %zu (need %zu)\n", n_in, out_size, ws_size, (size_t)WS_END); grid = -1; return; }
        int dev = 0, cus = 0, per_cu = 0;
        hipGetDevice(&dev); hipDeviceGetAttribute(&cus, hipDeviceAttributeMultiprocessorCount, dev);
        hipFuncSetAttribute((const void*)mk_fwd, hipFuncAttributeMaxDynamicSharedMemorySize, LDS_BYTES);
        hipOccupancyMaxActiveBlocksPerMultiprocessor(&per_cu, (const void*)mk_fwd, NTHR, LDS_BYTES);
        if (per_cu < 1) { fprintf(stderr, "kernel_launch: occupancy query says %d blocks per CU\n", per_cu); per_cu = 1; }
        (void)hipGetLastError();
        grid = cus;
    }
    if (grid < 0) return;
    Params p{};
    for (int i = 0; i < 27; ++i) p.in[i] = (const float*)d_in[i];
    p.out = (float*)d_out; p.ws = (unsigned char*)d_ws;
#if MK_FUSED
    (void)hipMemsetAsync((char*)d_ws + WS_CTL, 0, 65536, stream);
    p.ph_lo = 0; p.ph_hi = N_PHASES;
    void* args[] = {&p};
    hipError_t e = hipLaunchCooperativeKernel((const void*)mk_fwd, dim3(grid), dim3(NTHR), args, LDS_BYTES, stream);
    if (e != hipSuccess) fprintf(stderr, "cooperative launch failed: %s (grid %d)\n", hipGetErrorString(e), grid);
#else
    for (int ph = 0; ph < N_PHASES; ++ph) {
        p.ph_lo = ph; p.ph_hi = ph + 1;
        hipLaunchKernelGGL(mk_fwd, dim3(grid), dim3(NTHR), LDS_BYTES, stream, p);
    }
#endif
}
```

```cpp
#include <hip/hip_runtime.h>
#include <hip/hip_cooperative_groups.h>
#include <cstdio>
#include <cstdint>
namespace cg = cooperative_groups;

#ifndef MK_FUSED
#define MK_FUSED 1
#endif

#define LAS __attribute__((address_space(3)))
typedef unsigned short bf16_t;
typedef short bf16x8 __attribute__((ext_vector_type(8)));
typedef float f32x4 __attribute__((ext_vector_type(4)));
typedef unsigned u32x4 __attribute__((ext_vector_type(4)));
typedef unsigned u32x2 __attribute__((ext_vector_type(2)));
typedef int i32x8 __attribute__((ext_vector_type(8)));
typedef float f32x2 __attribute__((ext_vector_type(2)));
typedef int i32x4 __attribute__((ext_vector_type(4)));

#ifndef PG8_BUF_MOE1
#define PG8_BUF_MOE1 1
#endif
#ifndef PG8_BUF_MOE2
#define PG8_BUF_MOE2 1
#endif
#ifndef PG8_BUF_IN
#define PG8_BUF_IN 0
#endif
#ifndef PG8_BUF_OUT
#define PG8_BUF_OUT 0
#endif
#ifndef MOE_FP8
#define MOE_FP8 1
#endif
#ifndef XSCOPE
#define XSCOPE 0
#endif
#ifndef CVPOS
#define CVPOS 1
#endif
constexpr int NB = 8, T = 4096, D = 1024, CTXL = 256, DIN = 3328, RWC = 1792, NH = 8, HD = 64, DR = 512;
constexpr int NE = 16, CAP = 512, DE = 1024;
constexpr int MX = NB * T;
constexpr int MC = NB * CTXL;
constexpr int MALL = MX + MC;
constexpr int NWAVES = 8, NTHR = 512;
constexpr int LDS_BYTES = 163840;
constexpr int LDS_MISC = 154368;

constexpr size_t MiB = 1u << 20;
constexpr size_t WS_CTL = 0;
constexpr size_t WS_MOD = 1 * MiB;
constexpr size_t WS_BDOT = 2 * MiB;
constexpr size_t WS_AFF = 4 * MiB;
constexpr size_t WS_SEL = 6 * MiB;
constexpr size_t WS_GAM = 8 * MiB;
constexpr size_t WS_WOUTT = 11 * MiB;
constexpr size_t WS_IDX = 13 * MiB;
constexpr size_t WS_VAL = 13 * MiB + 256 * 1024;
constexpr size_t WS_MLR = 16 * MiB;
constexpr size_t WS_YF = 84 * MiB;
constexpr size_t WS_PX = 116 * MiB;
constexpr size_t WS_NT = 337 * MiB;
constexpr size_t WS_RB = 405 * MiB;
constexpr size_t WS_YB = 469 * MiB;
constexpr size_t WS_XN = 337 * MiB;
constexpr size_t WS_WINT = 405 * MiB;
constexpr size_t WS_AX = 337 * MiB;
constexpr size_t WS_X1 = 112 * MiB;
constexpr size_t WS_HX = 240 * MiB;
constexpr size_t WS_HID = 368 * MiB;
constexpr size_t WS_DN = 240 * MiB;
constexpr size_t WS_END = 501 * MiB;

struct Params { const float* in[27]; float* out; unsigned char* ws; int ph_lo, ph_hi; };

__device__ __forceinline__ unsigned f2bf(float f) { unsigned u = __float_as_uint(f); return (u + 0x7fffu + ((u >> 16) & 1u)) >> 16; }
typedef __bf16 hwbf16x2 __attribute__((ext_vector_type(2)));
typedef float f32x2_ __attribute__((ext_vector_type(2)));
__device__ __forceinline__ unsigned pk2(float lo, float hi) { const f32x2_ v = {lo, hi}; return __builtin_bit_cast(unsigned, __builtin_convertvector(v, hwbf16x2)); }
__device__ __forceinline__ float bflo(unsigned w) { return __uint_as_float(w << 16); }
__device__ __forceinline__ float bfhi(unsigned w) { return __uint_as_float(w & 0xffff0000u); }
__device__ __forceinline__ void unpack8(const u32x4 w, float (&f)[8]) {
    f[0] = bflo(w.x); f[1] = bfhi(w.x); f[2] = bflo(w.y); f[3] = bfhi(w.y); f[4] = bflo(w.z); f[5] = bfhi(w.z); f[6] = bflo(w.w); f[7] = bfhi(w.w); }
__device__ __forceinline__ u32x4 pack8(const float (&f)[8]) { u32x4 w; w.x = pk2(f[0], f[1]); w.y = pk2(f[2], f[3]); w.z = pk2(f[4], f[5]); w.w = pk2(f[6], f[7]); return w; }
__device__ __forceinline__ float wave_sum(float v) {
#pragma unroll
    for (int o = 1; o < 64; o <<= 1) v += __shfl_xor(v, o);
    return v;
}
__device__ __forceinline__ float wave_max(float v) {
#pragma unroll
    for (int o = 1; o < 64; o <<= 1) v = fmaxf(v, __shfl_xor(v, o));
    return v;
}
__device__ __forceinline__ float red8(float v) {
    v += __int_as_float(__builtin_amdgcn_update_dpp(0, __float_as_int(v), 0xB1, 0xF, 0xF, true));
    v += __int_as_float(__builtin_amdgcn_update_dpp(0, __float_as_int(v), 0x4E, 0xF, 0xF, true));
    v += __int_as_float(__builtin_amdgcn_update_dpp(0, __float_as_int(v), 0x141, 0xF, 0xF, true));
    return v;
}
__device__ __forceinline__ float sigmoidf_(float x) { return 1.f / (1.f + expf(-x)); }
__device__ __forceinline__ float fsigmoid(float x) { return __builtin_amdgcn_rcpf(1.f + __expf(-x)); }
__device__ __forceinline__ float ftanh(float x) { return 1.f - 2.f * __builtin_amdgcn_rcpf(1.f + __expf(2.f * x)); }

__device__ __forceinline__ float sat8(float x) { return __builtin_amdgcn_fmed3f(x, -448.f, 448.f); }
__device__ __forceinline__ unsigned pk4_fp8_raw(float a, float b, float c, float d) {
    int w = __builtin_amdgcn_cvt_pk_fp8_f32(a, b, 0, false); w = __builtin_amdgcn_cvt_pk_fp8_f32(c, d, w, true); return (unsigned)w; }
__device__ __forceinline__ unsigned pk4_fp8(float a, float b, float c, float d) { return pk4_fp8_raw(sat8(a), sat8(b), sat8(c), sat8(d)); }
constexpr float W8_SCALE = 64.f;
__device__ __forceinline__ int opq(int x) { asm volatile("" : "+v"(x)); return x; }
__device__ __forceinline__ int my_tid(int wv) { int l; asm volatile("v_mbcnt_lo_u32_b32 %0, -1, 0\n\tv_mbcnt_hi_u32_b32 %0, -1, %0" : "=v"(l)); return (wv << 6) | l; }
__device__ __forceinline__ unsigned char* sgpr_ptr(const void* q) {
    const unsigned long long v = (unsigned long long)(size_t)q;
    return (unsigned char*)(((unsigned long long)(unsigned)__builtin_amdgcn_readfirstlane((int)(v >> 32)) << 32) | (unsigned)__builtin_amdgcn_readfirstlane((int)(unsigned)v)); }
namespace pg8 {
#define PG8_LAS __attribute__((address_space(3)))
constexpr int BM = 256, BK = 64, HALF = 128, HTB = HALF * BK * 2, STAGE_BYTES = 8 * HTB, NXCD = 8, WGM = 8;
__host__ __device__ __forceinline__ int lds_byte(int r, int c) { const int st = (r >> 4) * 2 + (c >> 5), rr = r & 15, cc = c & 31, ob = rr * 64 + cc * 2; return st * 1024 + (ob ^ (((ob >> 9) & 1) << 5)); }
__host__ __device__ __forceinline__ void stage_rc(int b, int& R, int& C) { const int st = b / 1024, sb = b % 1024, swz = sb ^ (((sb >> 9) & 1) << 5); R = (st >> 1) * 16 + swz / 64; C = (st & 1) * 32 + (swz % 64) / 2; }
__host__ __device__ __forceinline__ int perm32(int rho) { const int n = rho >> 4, i = rho & 15; return 8 * (i >> 2) + 4 * n + (i & 3); }
struct Unit { int pm, pn; };
constexpr float WSC = MOE_FP8 ? 1.f / 64.f : 1.f;
struct Gemm { const bf16_t* A; const bf16_t* Bt; int M, N, K; const int* rowmap; };

__device__ __forceinline__ int xcd_remap(int wgid, int nwg) { const int q = nwg / NXCD, r = nwg % NXCD, xcd = wgid % NXCD, off = wgid / NXCD; return (xcd < r ? xcd * (q + 1) : r * (q + 1) + (xcd - r) * q) + off; }

struct StaticOrder {
    int nM, nN, nwg, G, c;
    __device__ void init(int M, int N, int G_, int c_) { nM = M / BM; nN = N / BM; nwg = nM * nN; G = G_; c = c_; }
    __device__ bool next(int i, Unit& u) const {
        const long L = (long)i * G + c; if (L >= nwg) return false;
        int wgid = xcd_remap((int)L, nwg);
        const int nig = WGM * nN, gid = wgid / nig, fm = gid * WGM, gsz = (nM - fm) < WGM ? (nM - fm) : WGM;
        u.pm = fm + ((wgid % nig) % gsz); u.pn = (wgid % nig) / gsz; return true;
    }
    __device__ __forceinline__ void a_ready(const Unit&) const {}
    __device__ __forceinline__ void done(const Unit&) const {}
};
struct InProjOrder {
    StaticOrder so; int G, c;
    __device__ void init(int G_, int c_) { so.init(MX, DIN, G_, c_); G = G_; c = c_; }
    __device__ bool next(int i, Unit& u) const {
        const long L = (long)i * G + c;
        if (L < so.nwg) return so.next(i, u);
        const int j = (int)(L - so.nwg); if (j >= 56) return false;
        u.pm = 128 + (j & 7); u.pn = j >> 3; return true;
    }
    __device__ __forceinline__ void a_ready(const Unit&) const {}
    __device__ __forceinline__ void done(const Unit&) const {}
};
struct ExpertOrder {
    int nPM, nPN, nwg, G, c;
    __device__ void init(int nE, int nPM_, int nPN_, int G_, int c_) { nPM = nPM_; nPN = nPN_; nwg = nE * nPM_ * nPN_; G = G_; c = c_; }
    __device__ bool next(int i, Unit& u) const {
        const long L = (long)i * G + c; if (L >= nwg) return false;
        const int wgid = xcd_remap((int)L, nwg);
        const int per = nPM * nPN, e = wgid / per, r = wgid % per;
        u.pm = e * nPM + (r % nPM); u.pn = e * nPN + (r / nPM); return true;
    }
    __device__ __forceinline__ void a_ready(const Unit&) const {}
    __device__ __forceinline__ void done(const Unit&) const {}
};

struct EpiBf16Plain {
    static constexpr bool PERM = true, AFTER_DRAIN = false;
    bf16_t* O; int ldc;
    __device__ __forceinline__ void operator()(const f32x4 (&acc)[2][2][4][2], const Unit& u, int wr, int wc, int fr, int fq) const {
        const int row0 = u.pm * BM + wr * 64 + fr, col0 = u.pn * BM + wc * 32 + 8 * fq;
#pragma unroll
        for (int ai = 0; ai < 2; ++ai)
#pragma unroll
            for (int m = 0; m < 4; ++m) { bf16_t* rowp = O + (size_t)(row0 + ai * HALF + m * 16) * ldc + col0;
#pragma unroll
                for (int bj = 0; bj < 2; ++bj) { const f32x4 v0 = acc[ai][bj][m][0], v1 = acc[ai][bj][m][1];
                    u32x4 w; w.x = pk2(v0[0], v0[1]); w.y = pk2(v0[2], v0[3]); w.z = pk2(v1[0], v1[1]); w.w = pk2(v1[2], v1[3]);
                    *(u32x4*)(rowp + bj * HALF) = w; } }
    }
};
struct EpiResid {
    static constexpr bool PERM = true, AFTER_DRAIN = false;
    const float* x; bf16_t* X1; const float* mod;
    __device__ __forceinline__ void operator()(const f32x4 (&acc)[2][2][4][2], const Unit& u, int wr, int wc, int fr, int fq) const {
        const int row0 = u.pm * BM + wr * 64 + fr, col0 = u.pn * BM + wc * 32 + 8 * fq;
        const float* g1 = mod + (size_t)(u.pm >> 4) * 6144 + 2048;
        f32x4 gv[2][2];
#pragma unroll
        for (int bj = 0; bj < 2; ++bj)
#pragma unroll
            for (int n = 0; n < 2; ++n) gv[bj][n] = *(const f32x4*)(g1 + col0 + bj * HALF + n * 4);
#pragma unroll
        for (int ai = 0; ai < 2; ++ai) { f32x4 xr[4][2][2];
#pragma unroll
            for (int m = 0; m < 4; ++m) { const size_t off = (size_t)(row0 + ai * HALF + m * 16) * D + col0;
#pragma unroll
                for (int bj = 0; bj < 2; ++bj) { xr[m][bj][0] = *(const f32x4*)(x + off + bj * HALF); xr[m][bj][1] = *(const f32x4*)(x + off + bj * HALF + 4); } }
#pragma unroll
            for (int m = 0; m < 4; ++m) { const size_t off = (size_t)(row0 + ai * HALF + m * 16) * D + col0;
#pragma unroll
                for (int bj = 0; bj < 2; ++bj) { const f32x4 v0 = xr[m][bj][0] + gv[bj][0] * acc[ai][bj][m][0], v1 = xr[m][bj][1] + gv[bj][1] * acc[ai][bj][m][1];
                    u32x4 w; w.x = pk2(v0[0], v0[1]); w.y = pk2(v0[2], v0[3]); w.z = pk2(v1[0], v1[1]); w.w = pk2(v1[2], v1[3]);
                    *(u32x4*)(X1 + off + bj * HALF) = w; } } }
    }
};
struct EpiSwiGLU {
    static constexpr bool PERM = true, AFTER_DRAIN = false;
    unsigned char* H;
    __device__ __forceinline__ void operator()(const f32x4 (&acc)[2][2][4][2], const Unit& u, int wr, int wc, int fr, int fq) const {
        const int row0 = u.pm * BM + wr * 64 + fr, col0 = (u.pn & 7) * 128 + wc * 32 + 8 * fq;
        const __amdgpu_buffer_rsrc_t rsH = __builtin_amdgcn_make_buffer_rsrc((void*)H, 0, 0x80000000u, 0x00020000);
#pragma unroll
        for (int ai = 0; ai < 2; ++ai)
#pragma unroll
            for (int m = 0; m < 4; ++m) { float h[8];
#pragma unroll
                for (int n = 0; n < 2; ++n)
#pragma unroll
                    for (int q = 0; q < 4; ++q) { const float g = acc[ai][0][m][n][q] * WSC, up = acc[ai][1][m][n][q] * WSC; h[n * 4 + q] = g / (1.f + __expf(-g)) * up; }
#if MOE_FP8
                u32x2 w; w.x = pk4_fp8(h[0], h[1], h[2], h[3]); w.y = pk4_fp8(h[4], h[5], h[6], h[7]);
                __builtin_amdgcn_raw_buffer_store_b64(w, rsH, (unsigned)((row0 + ai * HALF + m * 16) * DE + col0), 0, 0); }
#else
                u32x4 w; w.x = pk2(h[0], h[1]); w.y = pk2(h[2], h[3]); w.z = pk2(h[4], h[5]); w.w = pk2(h[6], h[7]);
                *(u32x4*)((bf16_t*)H + (size_t)(row0 + ai * HALF + m * 16) * DE + col0) = w; }
#endif
    }
};
struct EpiDown {
    static constexpr bool PERM = true, AFTER_DRAIN = false;
    bf16_t* O; const float* val; const float* mod;
    __device__ __forceinline__ void operator()(const f32x4 (&acc)[2][2][4][2], const Unit& u, int wr, int wc, int fr, int fq) const {
        const int row0 = u.pm * BM + wr * 64 + fr, col0 = (u.pn & 3) * BM + wc * 32 + 8 * fq;
        const int b = (u.pm & 15) >> 1;
        const unsigned char* mods = sgpr_ptr(mod); const unsigned char* vals_ = sgpr_ptr(val); unsigned char* Os = sgpr_ptr(O);
        f32x4 gv[2][2];
#pragma unroll
        for (int bj = 0; bj < 2; ++bj)
#pragma unroll
            for (int n = 0; n < 2; ++n) gv[bj][n] = *(const f32x4*)(mods + (size_t)(unsigned)((b * 6144 + 5120 + col0 + bj * HALF + n * 4) * 4));
        float vals[2][4];
#pragma unroll
        for (int ai = 0; ai < 2; ++ai)
#pragma unroll
            for (int m = 0; m < 4; ++m) vals[ai][m] = *(const float*)(vals_ + (size_t)(unsigned)((row0 + ai * HALF + m * 16) * 4));
#pragma unroll
        for (int ai = 0; ai < 2; ++ai)
#pragma unroll
#if MOE_FP8
            for (int m = 0; m < 4; ++m) { const int row = row0 + ai * HALF + m * 16; const float vv = vals[ai][m] * 0.25f; unsigned char* rowp = Os + (size_t)(unsigned)(row * D + col0);
#pragma unroll
                for (int bj = 0; bj < 2; ++bj) { const f32x4 v0 = acc[ai][bj][m][0] * gv[bj][0] * vv, v1 = acc[ai][bj][m][1] * gv[bj][1] * vv;
                    u32x2 w; w.x = pk4_fp8(v0[0], v0[1], v0[2], v0[3]); w.y = pk4_fp8(v1[0], v1[1], v1[2], v1[3]);
                    *(u32x2*)(Os + (size_t)(unsigned)(row * D + col0 + bj * HALF)) = w; } }
#else
            for (int m = 0; m < 4; ++m) { const int row = row0 + ai * HALF + m * 16; const float vv = vals[ai][m] * WSC; bf16_t* rowp = (bf16_t*)Os + (size_t)row * D + col0;
#pragma unroll
                for (int bj = 0; bj < 2; ++bj) { const f32x4 v0 = acc[ai][bj][m][0] * gv[bj][0] * vv, v1 = acc[ai][bj][m][1] * gv[bj][1] * vv;
                    u32x4 w; w.x = pk2(v0[0], v0[1]); w.y = pk2(v0[2], v0[3]); w.z = pk2(v1[0], v1[1]); w.w = pk2(v1[2], v1[3]);
                    *(u32x4*)(rowp + bj * HALF) = w; } }
#endif
    }
};

template <class Epi, class Sched, bool ALIGN_EPI = false, bool SP2 = false, bool GATHER = false, bool FP8 = false, int BUF = 0>
__device__ __forceinline__ void gemm_phase(PG8_LAS unsigned char* lds, const Gemm g, const Sched& S, const Epi& E, int wv) {
    const int tid = my_tid(wv), wid = __builtin_amdgcn_readfirstlane(tid >> 6), lane = tid & 63, wr = wid >> 2, wc = wid & 3, fr = lane & 15, fq = lane >> 4;
    const int K = g.K, nt = K / BK;
    unsigned voffA[2], voffB[2]; int gR[2]; unsigned gC[2];
#pragma unroll
    for (int i = 0; i < 2; ++i) { int R, C; stage_rc(tid * 16 + i * 8192, R, C); const int Rb = Epi::PERM ? ((R & ~31) + perm32(R & 31)) : R;
        voffA[i] = (unsigned)(R * K + C) * 2u; voffB[i] = (unsigned)(Rb * K + C) * 2u; gR[i] = R; gC[i] = (unsigned)C * 2u; }
    const __amdgpu_buffer_rsrc_t rsM = __builtin_amdgcn_make_buffer_rsrc((void*)g.rowmap, 0, 0x80000000u, 0x00020000);
    unsigned gAc[2][2], gAn[2][2];
#define PG8_GLOAD(dst, pm_) do { const int _t = my_tid(wv); _Pragma("unroll") for (int _i = 0; _i < 2; ++_i) { int _R, _C; stage_rc(_t * 16 + _i * 8192, _R, _C);     \
        _Pragma("unroll") for (int _h = 0; _h < 2; ++_h) dst[_h][_i] = (unsigned)__builtin_amdgcn_raw_buffer_load_b32(rsM, (unsigned)(((pm_) * BM + _h * HALF + _R) * 4), 0, 0) * (unsigned)(K * 2) + (unsigned)_C * 2u; } } while (0)
    const unsigned kstep = (unsigned)(BK * 2);
    const unsigned hstep = (unsigned)(HALF * K * 2);
    const unsigned tstep = 2u * hstep;
    const unsigned long long uA = ((unsigned long long)(unsigned)__builtin_amdgcn_readfirstlane((int)((unsigned long long)(size_t)g.A >> 32)) << 32) | (unsigned)__builtin_amdgcn_readfirstlane((int)(unsigned)(size_t)g.A);
    const unsigned long long uB = ((unsigned long long)(unsigned)__builtin_amdgcn_readfirstlane((int)((unsigned long long)(size_t)g.Bt >> 32)) << 32) | (unsigned)__builtin_amdgcn_readfirstlane((int)(unsigned)(size_t)g.Bt);
    const __amdgpu_buffer_rsrc_t rsA = __builtin_amdgcn_make_buffer_rsrc((void*)uA, 0, 0x80000000u, 0x00020000);
    const __amdgpu_buffer_rsrc_t rsB = __builtin_amdgcn_make_buffer_rsrc((void*)uB, 0, 0x80000000u, 0x00020000);
    const unsigned ldsw = (unsigned)wid * 1024u;
    const int aoff = lds_byte(wr * 64 + fr, fq * 8), boff = lds_byte(wc * 32 + fr, fq * 8);
#define PG8_SA(b, h) (((b) * 2 + (h)) * HTB)
#define PG8_SB(b, h) ((4 + (b) * 2 + (h)) * HTB)
#define PG8_GLDS(ldsp, v32, gp) asm volatile("s_mov_b32 m0, %0\n\ts_nop 0\n\tglobal_load_lds_dwordx4 %1, %2" :: "s"(__builtin_amdgcn_readfirstlane((int)(size_t)(ldsp))), "v"(v32), "s"(gp) : "memory", "m0")
#define PG8_STAGE(bufoff, goff, voff) do { _Pragma("unroll") for (int _i = 0; _i < 2; ++_i) { \
        if constexpr (BUF == 1 || BUF == 3) __builtin_amdgcn_raw_ptr_buffer_load_lds(rsB, (PG8_LAS void*)(lds + (bufoff) + ldsw + _i * 8192), 16, (voff)[_i], (goff), 0, 0); \
        else if constexpr (BUF == 2) PG8_GLDS(lds + (bufoff) + ldsw + _i * 8192, (voff)[_i] + (unsigned)__builtin_amdgcn_readfirstlane((int)(goff)), (const char*)uB); \
        else __builtin_amdgcn_global_load_lds((const unsigned*)((const char*)g.Bt + (size_t)((goff) + (voff)[_i])), (PG8_LAS unsigned*)(lds + (bufoff) + ldsw + _i * 8192), 16, 0, 0); } } while (0)
#define PG8_STA(bufoff, koff, h, nx) do { _Pragma("unroll") for (int _i = 0; _i < 2; ++_i) { \
        const unsigned _v = GATHER ? ((nx) ? gAn[h][_i] : gAc[h][_i]) : voffA[_i]; const unsigned _s = GATHER ? (koff) : (koff) + (unsigned)(h) * hstep; \
        if constexpr (BUF == 1) __builtin_amdgcn_raw_ptr_buffer_load_lds(rsA, (PG8_LAS void*)(lds + (bufoff) + ldsw + _i * 8192), 16, _v, _s, 0, 0); \
        else if constexpr (BUF == 2 || BUF == 3) PG8_GLDS(lds + (bufoff) + ldsw + _i * 8192, _v + (unsigned)__builtin_amdgcn_readfirstlane((int)_s), (const char*)uA); \
        else __builtin_amdgcn_global_load_lds((const unsigned*)((const char*)g.A + (size_t)(_s + _v)), (PG8_LAS unsigned*)(lds + (bufoff) + ldsw + _i * 8192), 16, 0, 0); } } while (0)
#define PG8_LDA(dst, b, h) do { _Pragma("unroll") for (int m = 0; m < 4; ++m) _Pragma("unroll") for (int k = 0; k < 2; ++k) dst[m][k] = *(const PG8_LAS bf16x8*)(lds + PG8_SA(b, h) + aoff + m * 2048 + k * 1024); } while (0)
#define PG8_LDB(dst, b, h) do { _Pragma("unroll") for (int n = 0; n < 2; ++n) _Pragma("unroll") for (int k = 0; k < 2; ++k) dst[n][k] = *(const PG8_LAS bf16x8*)(lds + PG8_SB(b, h) + boff + n * 2048 + k * 1024); } while (0)
#define PG8_CAT(f) __builtin_shufflevector(__builtin_bit_cast(i32x4, (f)[0]), __builtin_bit_cast(i32x4, (f)[1]), 0, 1, 2, 3, 4, 5, 6, 7)
#define PG8_MMA(ai, bj, At, Bt) do { __builtin_amdgcn_s_setprio(1); \
        if constexpr (FP8) { _Pragma("unroll") for (int m = 0; m < 4; ++m) _Pragma("unroll") for (int n = 0; n < 2; ++n) \
            acc[ai][bj][m][n] = __builtin_amdgcn_mfma_scale_f32_16x16x128_f8f6f4(PG8_CAT(Bt[n]), PG8_CAT(At[m]), acc[ai][bj][m][n], 0, 0, 0, 0, 0, 0); } \
        else { _Pragma("unroll") for (int m = 0; m < 4; ++m) _Pragma("unroll") for (int n = 0; n < 2; ++n) _Pragma("unroll") for (int k = 0; k < 2; ++k) \
            acc[ai][bj][m][n] = __builtin_amdgcn_mfma_f32_16x16x32_bf16(Bt[n][k], At[m][k], acc[ai][bj][m][n], 0, 0, 0); } \
        __builtin_amdgcn_s_setprio(0); } while (0)
#define PG8_WAIT_V(n) asm volatile("s_waitcnt vmcnt(" #n ")" ::: "memory")
#define PG8_WAIT_L(n) asm volatile("s_waitcnt lgkmcnt(" #n ")" ::: "memory")
#define PG8_BAR __builtin_amdgcn_s_barrier()
#define PG8_SCHED __builtin_amdgcn_sched_barrier(0)
    Unit cur, nxt; int ui = 0;
    if (!S.next(0, cur)) return;
    f32x4 acc[2][2][4][2];
#pragma unroll
    for (int a = 0; a < 2; ++a)
#pragma unroll
        for (int b = 0; b < 2; ++b)
#pragma unroll
            for (int m = 0; m < 4; ++m)
#pragma unroll
                for (int n = 0; n < 2; ++n) { acc[a][b][m][n] = (f32x4){0.f, 0.f, 0.f, 0.f}; if constexpr (FP8) asm volatile("" : "+v"(acc[a][b][m][n])); }
    bf16x8 At[4][2], B0[2][2], B1[2][2];
    unsigned cA = GATHER ? 0u : (unsigned)cur.pm * tstep, cB = (unsigned)cur.pn * tstep;
    if constexpr (GATHER) { PG8_GLOAD(gAc, cur.pm); }
    S.a_ready(cur);
    if constexpr (SP2) {
        PG8_STAGE(PG8_SB(0, 0), cB, voffB); PG8_STAGE(PG8_SB(0, 1), cB + hstep, voffB); PG8_STA(PG8_SA(0, 0), cA, 0, false); PG8_STA(PG8_SA(0, 1), cA, 1, false);
        if (wr == 1) PG8_BAR;
        PG8_WAIT_V(2); PG8_BAR;
        PG8_STAGE(PG8_SB(1, 0), cB + kstep, voffB); PG8_STA(PG8_SA(1, 0), cA + kstep, 0, false); PG8_STAGE(PG8_SB(1, 1), cB + hstep + kstep, voffB);
        PG8_WAIT_V(6); PG8_BAR;
    } else {
        PG8_STAGE(PG8_SB(0, 0), cB, voffB); PG8_STA(PG8_SA(0, 0), cA, 0, false); PG8_STAGE(PG8_SB(0, 1), cB + hstep, voffB); PG8_STA(PG8_SA(0, 1), cA, 1, false);
        if (wr == 1) PG8_BAR;
        PG8_WAIT_V(4); PG8_BAR;
        PG8_STAGE(PG8_SB(1, 0), cB + kstep, voffB); PG8_STA(PG8_SA(1, 0), cA + kstep, 0, false); PG8_STAGE(PG8_SB(1, 1), cB + hstep + kstep, voffB);
        PG8_WAIT_V(6); PG8_BAR;
    }
    for (;;) {
        const bool has_next = S.next(ui + 1, nxt);
        const unsigned nA = GATHER ? cA : (has_next ? (unsigned)nxt.pm * tstep : cA), nB = has_next ? (unsigned)nxt.pn * tstep : cB;
        if constexpr (GATHER) { if (has_next) { PG8_GLOAD(gAn, nxt.pm); } else {
#pragma unroll
            for (int _h = 0; _h < 2; ++_h)
#pragma unroll
                for (int _i = 0; _i < 2; ++_i) gAn[_h][_i] = gAc[_h][_i]; } }
#pragma unroll 1
        for (int t = 0; t < nt; t += 2) {
            const bool last = (t == nt - 2);
            const unsigned a1 = cA + (unsigned)(t + 1) * kstep;
            const unsigned a2 = last ? nA : cA + (unsigned)(t + 2) * kstep, b2 = last ? nB : cB + (unsigned)(t + 2) * kstep;
            const unsigned a3 = a2 + kstep, b3 = b2 + kstep;
            if (last && has_next) S.a_ready(nxt);
            if constexpr (SP2) {
            PG8_LDB(B0, 0, 0); PG8_LDB(B1, 0, 1); PG8_SCHED; PG8_LDA(At, 0, 0); PG8_STA(PG8_SA(1, 1), a1, 1, false);
            PG8_WAIT_V(8); PG8_WAIT_L(0); PG8_BAR; PG8_MMA(0, 0, At, B0); PG8_MMA(0, 1, At, B1); PG8_BAR; PG8_SCHED;
            PG8_LDA(At, 0, 1); PG8_STAGE(PG8_SB(0, 0), b2, voffB); PG8_STAGE(PG8_SB(0, 1), b2 + hstep, voffB); PG8_STA(PG8_SA(0, 0), a2, 0, last);
            PG8_WAIT_V(8); PG8_WAIT_L(0); PG8_BAR; PG8_MMA(1, 0, At, B0); PG8_MMA(1, 1, At, B1); PG8_BAR; PG8_SCHED;
            PG8_LDB(B0, 1, 0); PG8_LDB(B1, 1, 1); PG8_SCHED; PG8_LDA(At, 1, 0); PG8_STA(PG8_SA(0, 1), a2, 1, last);
            PG8_WAIT_V(8); PG8_WAIT_L(0); PG8_BAR; PG8_MMA(0, 0, At, B0); PG8_MMA(0, 1, At, B1); PG8_BAR; PG8_SCHED;
            PG8_LDA(At, 1, 1); PG8_STAGE(PG8_SB(1, 0), b3, voffB); PG8_STAGE(PG8_SB(1, 1), b3 + hstep, voffB); PG8_STA(PG8_SA(1, 0), a3, 0, last);
            PG8_WAIT_V(8); PG8_WAIT_L(0); PG8_BAR; PG8_MMA(1, 0, At, B0); PG8_MMA(1, 1, At, B1); PG8_BAR; PG8_SCHED;
            } else {
            PG8_LDB(B0, 0, 0); PG8_SCHED; PG8_LDA(At, 0, 0); PG8_STA(PG8_SA(1, 1), a1, 1, false);
            PG8_WAIT_L(8); PG8_BAR; PG8_WAIT_L(0); PG8_MMA(0, 0, At, B0); PG8_BAR; PG8_SCHED;
            PG8_LDB(B1, 0, 1); PG8_STAGE(PG8_SB(0, 0), b2, voffB);
            PG8_BAR; PG8_WAIT_L(0); PG8_MMA(0, 1, At, B1); PG8_BAR;
            PG8_LDA(At, 0, 1); PG8_STA(PG8_SA(0, 0), a2, 0, last);
            PG8_BAR; PG8_WAIT_L(0); PG8_MMA(1, 0, At, B0); PG8_BAR; PG8_SCHED;
            PG8_STAGE(PG8_SB(0, 1), b2 + hstep, voffB);
            PG8_WAIT_V(6); PG8_BAR; PG8_MMA(1, 1, At, B1); PG8_BAR;
            PG8_LDB(B0, 1, 0); PG8_SCHED; PG8_LDA(At, 1, 0); PG8_STA(PG8_SA(0, 1), a2, 1, last);
            PG8_WAIT_L(8); PG8_BAR; PG8_WAIT_L(0); PG8_MMA(0, 0, At, B0); PG8_BAR; PG8_SCHED;
            PG8_LDB(B1, 1, 1); PG8_STAGE(PG8_SB(1, 0), b3, voffB);
            PG8_BAR; PG8_WAIT_L(0); PG8_MMA(0, 1, At, B1); PG8_BAR;
            PG8_LDA(At, 1, 1); PG8_STA(PG8_SA(1, 0), a3, 0, last);
            PG8_BAR; PG8_WAIT_L(0); PG8_MMA(1, 0, At, B0); PG8_BAR; PG8_SCHED;
            PG8_STAGE(PG8_SB(1, 1), b3 + hstep, voffB);
            PG8_WAIT_V(6); PG8_BAR; PG8_MMA(1, 1, At, B1); PG8_BAR;
            }
        }
        if constexpr (ALIGN_EPI) { if (wr == 0) PG8_BAR; }
        if constexpr (!Epi::AFTER_DRAIN) { const int _l = my_tid(wv) & 63; E(acc, cur, wr, wc, _l & 15, _l >> 4); S.done(cur); }
        if (!has_next) break;
#pragma unroll
        for (int a = 0; a < 2; ++a)
#pragma unroll
            for (int b = 0; b < 2; ++b)
#pragma unroll
                for (int m = 0; m < 4; ++m)
#pragma unroll
                    for (int n = 0; n < 2; ++n) { acc[a][b][m][n] = (f32x4){0.f, 0.f, 0.f, 0.f}; if constexpr (FP8) asm volatile("" : "+v"(acc[a][b][m][n])); }
        cur = nxt; cA = nA; cB = nB; ++ui;
        if constexpr (GATHER) {
#pragma unroll
            for (int _h = 0; _h < 2; ++_h)
#pragma unroll
                for (int _i = 0; _i < 2; ++_i) gAc[_h][_i] = gAn[_h][_i]; }
        if constexpr (ALIGN_EPI) { if (wr == 1) PG8_BAR; }
    }
    PG8_WAIT_V(0);
    if constexpr (!ALIGN_EPI) { if (wr == 0) PG8_BAR; }
    PG8_BAR;
#undef PG8_SA
#undef PG8_SB
#undef PG8_STAGE
#undef PG8_STA
#undef PG8_GLDS
#undef PG8_GLOAD
#undef PG8_LDA
#undef PG8_LDB
#undef PG8_MMA
#undef PG8_CAT
#undef PG8_WAIT_V
#undef PG8_WAIT_L
#undef PG8_BAR
#undef PG8_SCHED
}
}

#define LDS_WAIT() asm volatile("s_waitcnt lgkmcnt(0)" ::: "memory")
#define LBAR() do { asm volatile("s_waitcnt lgkmcnt(0)" ::: "memory"); __builtin_amdgcn_s_barrier(); asm volatile("" ::: "memory"); } while (0)

__device__ __forceinline__ void cvt_item(const float* W, int K, int N, bf16_t* WT, int mode, int item, int lane) {
    const int nblk = N / 64, kb = item / nblk, nb = item % nblk, k0 = 64 * kb, n0 = 64 * nb;
    const int rbase = mode == 0 ? n0 : ((n0 >> 7) * 256 + (n0 & 127) + (mode == 2 ? 128 : 0));
    const int r = lane >> 4, c4 = lane & 15;
    const float* src = W + (size_t)(k0 + 16 * r) * N + n0 + 4 * c4;
    f32x4 v[16];
#pragma unroll
    for (int i = 0; i < 16; ++i) v[i] = *(const f32x4*)(src + (size_t)i * N);
    bf16_t* dst = WT + (size_t)(rbase + 4 * c4) * K + k0 + 16 * r;
#pragma unroll
    for (int q = 0; q < 4; ++q)
#pragma unroll
        for (int hh = 0; hh < 2; ++hh) { u32x4 o;
            o.x = pk2(v[8 * hh + 0][q], v[8 * hh + 1][q]); o.y = pk2(v[8 * hh + 2][q], v[8 * hh + 3][q]); o.z = pk2(v[8 * hh + 4][q], v[8 * hh + 5][q]); o.w = pk2(v[8 * hh + 6][q], v[8 * hh + 7][q]);
            *(u32x4*)(dst + (size_t)q * K + 8 * hh) = o; }
}

__device__ __forceinline__ void phase0(const Params& p, LAS unsigned char* lds, int bid, int G, int wv) {
    const int tid = my_tid(wv), lane = tid & 63, wave = tid >> 6;
    unsigned char* ws = p.ws;
    if (bid < 192) {
        LAS float* sc = (LAS float*)lds;
        LAS float* part = sc + 9 * 1024;
        const float* c = p.in[1]; const float* cctx = p.in[3]; const float* ada_w = p.in[4]; const float* ada_b = p.in[5];
        float* MOD = (float*)(ws + WS_MOD);
        for (int i = tid; i < 9 * 1024; i += NTHR) { const int r = i >> 10, k = i & 1023; const float v = r < 8 ? c[r * 1024 + k] : cctx[k]; sc[i] = v / (1.f + expf(-v)); }
        __syncthreads();
        for (int it = bid; it < 192; it += G) {
            const int col = tid & 31, kg = tid >> 5;
            float acc[9];
#pragma unroll
            for (int r = 0; r < 9; ++r) acc[r] = 0.f;
            const float* w = ada_w + (size_t)(kg * 64) * 6144 + it * 32 + col;
#pragma unroll 16
            for (int k = 0; k < 64; ++k) { const float wv = w[(size_t)k * 6144];
#pragma unroll
                for (int r = 0; r < 9; ++r) acc[r] += sc[r * 1024 + kg * 64 + k] * wv; }
#pragma unroll
            for (int r = 0; r < 9; ++r) part[(kg * 9 + r) * 32 + col] = acc[r];
            __syncthreads();
            for (int o = tid; o < 288; o += NTHR) { const int r = o >> 5, cc = o & 31; float s_ = ada_b[it * 32 + cc];
#pragma unroll
                for (int q = 0; q < 16; ++q) s_ += part[(q * 9 + r) * 32 + cc];
                MOD[r * 6144 + it * 32 + cc] = s_; }
            __syncthreads();
        }
    }
    {
        const int gw = bid * NWAVES + wave, NGW = G * NWAVES;
        constexpr int I_IN = 16 * (DIN / 64), I_OUT = 16 * 16;
        for (int it = gw; it < I_IN + I_OUT; it += NGW) {
            if (it < I_IN) cvt_item(p.in[8], D, DIN, (bf16_t*)(ws + WS_WINT), 0, it, lane);
            else cvt_item(p.in[21], D, D, (bf16_t*)(ws + WS_WOUTT), 0, it - I_IN, lane);
        }
    }
}
constexpr size_t OUT_W2T = (MOE_FP8 ? 32 : 64) * MiB;
__device__ __forceinline__ void xcvt_load(const Params& p, int g, int lane, f32x4 (&v)[8]) {
    const int which = g >> 13, r = g & 8191, e = r >> 9, kb = (r >> 4) & 31, nb = r & 15;
    const float* W = which == 0 ? p.in[23] : (which == 1 ? p.in[24] : p.in[25]);
    const __amdgpu_buffer_rsrc_t rs = __builtin_amdgcn_make_buffer_rsrc((void*)W, 0, 64 << 20, 0x00020000);
    const unsigned vo = (unsigned)(((lane >> 4) * 8 * 1024 + (lane & 15) * 4) * 4);
    const unsigned so = (unsigned)(((e * 1024 + kb * 32) * 1024 + nb * 64) * 4);
#pragma unroll
    for (int i = 0; i < 8; ++i) v[i] = __builtin_bit_cast(f32x4, __builtin_amdgcn_raw_buffer_load_b128(rs, vo, so + (unsigned)i * 4096u, 0));
}
__device__ __forceinline__ void xcvt_store(const Params& p, int g, int lane, const f32x4 (&v)[8]) {
    const int which = g >> 13, r = g & 8191, e = r >> 9, kb = (r >> 4) & 31, nb = r & 15, n0 = nb * 64;
    const int rbase = which == 2 ? n0 : ((n0 >> 7) * 256 + (n0 & 127) + (which == 1 ? 128 : 0));
#if MOE_FP8
    const unsigned so = which == 2 ? (unsigned)OUT_W2T + (unsigned)((e * 1024 + rbase) * 1024 + kb * 32) : (unsigned)((e * 2048 + rbase) * 1024 + kb * 32);
    const __amdgpu_buffer_rsrc_t rs = __builtin_amdgcn_make_buffer_rsrc((void*)p.out, 0, 48 << 20, 0x00020000);
    const unsigned vo = (unsigned)((lane & 15) * 4 * 1024 + (lane >> 4) * 8);
#pragma unroll
    for (int q = 0; q < 4; ++q) { u32x2 o;
        o.x = pk4_fp8_raw(v[0][q] * W8_SCALE, v[1][q] * W8_SCALE, v[2][q] * W8_SCALE, v[3][q] * W8_SCALE); o.y = pk4_fp8_raw(v[4][q] * W8_SCALE, v[5][q] * W8_SCALE, v[6][q] * W8_SCALE, v[7][q] * W8_SCALE);
        __builtin_amdgcn_raw_buffer_store_b64(o, rs, vo, so + (unsigned)q * 1024u, 0); }
#else
    const unsigned so = which == 2 ? (unsigned)OUT_W2T + (unsigned)(((e * 1024 + rbase) * 1024 + kb * 32) * 2) : (unsigned)(((e * 2048 + rbase) * 1024 + kb * 32) * 2);
    const __amdgpu_buffer_rsrc_t rs = __builtin_amdgcn_make_buffer_rsrc((void*)p.out, 0, 96 << 20, 0x00020000);
    const unsigned vo = (unsigned)(((lane & 15) * 4 * 1024 + (lane >> 4) * 8) * 2);
#pragma unroll
    for (int q = 0; q < 4; ++q) { u32x4 o;
        o.x = pk2(v[0][q], v[1][q]); o.y = pk2(v[2][q], v[3][q]); o.z = pk2(v[4][q], v[5][q]); o.w = pk2(v[6][q], v[7][q]);
        __builtin_amdgcn_raw_buffer_store_b128(o, rs, vo, so + (unsigned)q * 2048u, 0); }
#endif
}

__device__ __forceinline__ void phase1(const Params& p, int bid, int G, int wv) {
    const int tid = my_tid(wv), lane = tid & 63, wave = tid >> 6;
    const int gw = bid * NWAVES + wave, NGW = G * NWAVES;
    const float* MOD = (const float*)(p.ws + WS_MOD); const float* n1g = p.in[6];
    bf16_t* XN = (bf16_t*)(p.ws + WS_XN);
    f32x4 g[4];
#pragma unroll
    for (int j = 0; j < 4; ++j) g[j] = *(const f32x4*)(n1g + 4 * (lane + 64 * j));
    for (int m0 = gw; m0 < MALL; m0 += 2 * NGW) {
        f32x4 v[2][4]; float ss[2]; int mrow[2];
#pragma unroll
        for (int tk = 0; tk < 2; ++tk) { const int m = m0 + tk * NGW < MALL ? m0 + tk * NGW : m0;
            const float* src = m < MX ? p.in[0] + (size_t)m * D : p.in[2] + (size_t)(m - MX) * D; mrow[tk] = m;
            ss[tk] = 0.f;
#pragma unroll
            for (int j = 0; j < 4; ++j) { v[tk][j] = ((const f32x4*)src)[lane + 64 * j]; ss[tk] += (v[tk][j].x * v[tk][j].x + v[tk][j].y * v[tk][j].y) + (v[tk][j].z * v[tk][j].z + v[tk][j].w * v[tk][j].w); } }
#pragma unroll
        for (int tk = 0; tk < 2; ++tk) { const int m = mrow[tk], mr = m < MX ? (m >> 12) : 8;
            const float* sh = MOD + (size_t)mr * 6144; const float* scp = sh + 1024;
            const float rstd = rsqrtf(wave_sum(ss[tk]) * (1.f / D) + 1e-6f);
#pragma unroll
            for (int j = 0; j < 4; ++j) { const int col = 4 * (lane + 64 * j);
                const f32x4 s_ = *(const f32x4*)(scp + col), h = *(const f32x4*)(sh + col);
                const f32x4 y = v[tk][j] * rstd * g[j] * (s_ + 1.f) + h;
                u32x2 o; o.x = pk2(y.x, y.y); o.y = pk2(y.z, y.w);
                *(u32x2*)(XN + (size_t)m * D + col) = o; } }
    }
}

struct Px5 { u32x4 s, n0, n1, n2, n3; };
__device__ __forceinline__ Px5 px_load(const bf16_t* PX, int row, const int (&nbr)[4], int cb) {
    const __amdgpu_buffer_rsrc_t rs = __builtin_amdgcn_make_buffer_rsrc((void*)PX, 0, MALL * DIN * 2, 0x00020000);
    const unsigned cbb = (unsigned)cb * 2u, OOB = 0xFFFFF000u;
    Px5 q;
    q.s = __builtin_bit_cast(u32x4, __builtin_amdgcn_raw_buffer_load_b128(rs, (unsigned)row * (DIN * 2) + cbb, 0, 0));
    q.n0 = __builtin_bit_cast(u32x4, __builtin_amdgcn_raw_buffer_load_b128(rs, nbr[0] >= 0 ? (unsigned)nbr[0] * (DIN * 2) + cbb : OOB, 0, 0));
    q.n1 = __builtin_bit_cast(u32x4, __builtin_amdgcn_raw_buffer_load_b128(rs, nbr[1] >= 0 ? (unsigned)nbr[1] * (DIN * 2) + cbb : OOB, 0, 0));
    q.n2 = __builtin_bit_cast(u32x4, __builtin_amdgcn_raw_buffer_load_b128(rs, nbr[2] >= 0 ? (unsigned)nbr[2] * (DIN * 2) + cbb : OOB, 0, 0));
    q.n3 = __builtin_bit_cast(u32x4, __builtin_amdgcn_raw_buffer_load_b128(rs, nbr[3] >= 0 ? (unsigned)nbr[3] * (DIN * 2) + cbb : OOB, 0, 0));
    return q; }
__device__ __forceinline__ void px_lerp(const Px5& q, bool isctx, int cb, const float* mu, float (&out)[8]) {
    u32x4 sh;
    if (isctx) { sh.x = (q.n0.x & 0xffffu) | (q.n1.x & 0xffff0000u); sh.y = (q.n0.y & 0xffffu) | (q.n1.y & 0xffff0000u); sh.z = (q.n0.z & 0xffffu) | (q.n1.z & 0xffff0000u); sh.w = (q.n0.w & 0xffffu) | (q.n1.w & 0xffff0000u); }
    else { sh.x = (q.n0.x & 0xffffu) | (q.n1.x & 0xffff0000u); sh.y = (q.n2.y & 0xffffu) | (q.n3.y & 0xffff0000u); sh.z = (q.n0.z & 0xffffu) | (q.n1.z & 0xffff0000u); sh.w = (q.n2.w & 0xffffu) | (q.n3.w & 0xffff0000u); }
    float s[8], sv[8];
    unpack8(q.s, s); unpack8(sh, sv);
    const f32x4 m0 = *(const f32x4*)(mu + cb), m1 = *(const f32x4*)(mu + cb + 4);
    const float mv[8] = {m0.x, m0.y, m0.z, m0.w, m1.x, m1.y, m1.z, m1.w};
#pragma unroll
    for (int e = 0; e < 8; ++e) out[e] = s[e] + mv[e] * (sv[e] - s[e]);
}
__device__ __forceinline__ void neighbours(int t, bool isctx, int rowbase, int (&nbr)[4]) {
    if (isctx) { nbr[0] = t > 0 ? rowbase + t - 1 : -1; nbr[1] = t < CTXL - 1 ? rowbase + t + 1 : -1; nbr[2] = -1; nbr[3] = -1; }
    else { const int cg_ = t & 63, rg = t >> 6;
        nbr[0] = cg_ > 0 ? rowbase + t - 1 : -1; nbr[1] = cg_ < 63 ? rowbase + t + 1 : -1; nbr[2] = rg > 0 ? rowbase + t - 64 : -1; nbr[3] = rg < 63 ? rowbase + t + 64 : -1; }
}

typedef short s16x4 __attribute__((ext_vector_type(4)));
constexpr int RS = 128;
constexpr int IMG = 64 * RS;
__device__ __forceinline__ int ioff(int row, int col) { return row * RS + ((col * 2) ^ (((row & 2) | ((row >> 1) & 4)) << 4)); }
constexpr int I_AT = 0, I_BT = IMG, I_KT = 2 * IMG, I_RT = 3 * IMG, I_BH = 4 * IMG, I_KH = 5 * IMG, I_VV = 6 * IMG;
constexpr int I_LBT = 7 * IMG, I_LAK = 8 * IMG, I_PRB = 9 * IMG, I_PRK = 10 * IMG, I_TM = 11 * IMG, I_Q = 12 * IMG;
constexpr int I_E = 13 * IMG;
constexpr int I_LT = 13 * IMG + 4608;
constexpr int I_WUP = I_LT + 17408, I_AUP = I_WUP + IMG;
constexpr int I_PAR = I_AUP + IMG;
constexpr int I_VV2 = I_PAR + 1280;
constexpr int X_END = I_VV2 + IMG;
constexpr int I_W1 = I_LBT, I_W2 = I_LAK;
constexpr int I_XW = I_Q, I_XA = I_TM;
constexpr int I_DW = I_AT, I_DA = I_LT;
constexpr int I_G = I_PRB, I_GT = I_E;
static_assert(I_DW + 17408 <= I_RT && I_PRK == I_PRB + IMG && X_END + 64 <= LDS_BYTES && X_END == LDS_MISC, "scan LDS map");

__device__ __forceinline__ bf16x8 frag_rm(const LAS unsigned char* img, int row0, int k0, int lane) {
    return *(const LAS bf16x8*)(img + ioff(row0 + (lane & 15), k0 + 8 * (lane >> 4))); }
__device__ __forceinline__ bf16x8 frag_tr(const LAS unsigned char* img, int k0, int col0, int lane) {
    LAS unsigned char* a = (LAS unsigned char*)img + ioff(k0 + 8 * (lane >> 4) + ((lane & 15) >> 2), col0 + 4 * (lane & 3));
    const s16x4 lo = __builtin_amdgcn_ds_read_tr16_b64_v4i16((LAS s16x4*)a);
    const s16x4 hi = __builtin_amdgcn_ds_read_tr16_b64_v4i16((LAS s16x4*)(a + 4 * RS));
    return __builtin_shufflevector(lo, hi, 0, 1, 2, 3, 4, 5, 6, 7); }
#define MFMA16(a, b, c) __builtin_amdgcn_mfma_f32_16x16x32_bf16((a), (b), (c), 0, 0, 0)
__device__ __forceinline__ void st_img(LAS unsigned char* img, int n0, int m0, int lane, const f32x4 v) {
    u32x2 w; w.x = pk2(v[0], v[1]); w.y = pk2(v[2], v[3]);
    *(LAS u32x2*)(img + ioff(n0 + (lane & 15), m0 + 4 * (lane >> 4))) = w; }
__device__ __forceinline__ f32x4 up4(const u32x2 w) { return (f32x4){bflo(w.x), bfhi(w.x), bflo(w.y), bfhi(w.y)}; }

__device__ __forceinline__ void phase_scanX(const Params& p, LAS unsigned char* lds, int bid, int G, int wv) {
    const int tid_ = my_tid(wv), lane_ = tid_ & 63, wave = __builtin_amdgcn_readfirstlane(tid_ >> 6);
    const bf16_t* PX = (const bf16_t*)(p.ws + WS_PX);
    const float* mu = p.in[9];
    const f32x4 fz = (f32x4){0.f, 0.f, 0.f, 0.f};
    for (int it_ = bid; it_ < NB * NH * 2 * 2; it_ += G) {
        const int item = (G == 256) ? ((it_ & 7) * 32 + (it_ >> 3)) : it_;
        const int bhd = item >> 1, dir = bhd & 1, h = (bhd >> 1) & 7, b = bhd >> 4;
        LBAR();
        { const int tid = opq(tid_), j = tid >> 3, k0 = (tid & 7) * 8;
          const float* wu = p.in[11] + (size_t)dir * 64 * DR + (size_t)j * DR + h * 64 + k0; const float* au = p.in[13] + (size_t)dir * 64 * DR + (size_t)j * DR + h * 64 + k0;
          const f32x4 w0 = *(const f32x4*)wu, w1 = *(const f32x4*)(wu + 4), a0 = *(const f32x4*)au, a1 = *(const f32x4*)(au + 4);
          const float wf[8] = {w0.x, w0.y, w0.z, w0.w, w1.x, w1.y, w1.z, w1.w}, af[8] = {a0.x, a0.y, a0.z, a0.w, a1.x, a1.y, a1.z, a1.w};
          *(LAS u32x4*)(lds + I_WUP + ioff(j, k0)) = pack8(wf); *(LAS u32x4*)(lds + I_AUP + ioff(j, k0)) = pack8(af); }
        { const int k0_ = (opq(tid_) & 7) * 8, hc_ = h * 64 + k0_; LAS float* PARw = (LAS float*)(lds + I_PAR) + k0_;
#pragma unroll
          for (int e = 0; e < 8; ++e) { PARw[e] = p.in[10][dir * DR + hc_ + e]; PARw[64 + e] = p.in[12][dir * DR + hc_ + e]; PARw[128 + e] = p.in[14][hc_ + e]; PARw[192 + e] = p.in[15][hc_ + e]; PARw[256 + e] = p.in[16][hc_ + e]; } }
#define XCI(cc_) ((item & 1) * 34 + 33 - (cc_))
#define X_PXLOAD(ci_) do { const int tid__ = opq(tid_), j__ = tid__ >> 3, k0__ = (tid__ & 7) * 8; const int ci__ = (ci_); const bool ctx__ = ci__ < 4; const int c__ = ctx__ ? ci__ : ci__ - 4; \
            const int L__ = ctx__ ? CTXL : T, rb__ = ctx__ ? MX + b * CTXL : b * T, pos__ = 64 * c__ + j__, t__ = dir ? (L__ - 1 - pos__) : pos__; \
            int nbr__[4]; neighbours(t__, ctx__, rb__, nbr__); \
            qv = px_load(PX, rb__ + t__, nbr__, 1024 + h * 64 + k0__); qw = px_load(PX, rb__ + t__, nbr__, 1536 + k0__); qa = px_load(PX, rb__ + t__, nbr__, 1600 + k0__); \
            qr = px_load(PX, rb__ + t__, nbr__, h * 64 + k0__); qk = px_load(PX, rb__ + t__, nbr__, 512 + h * 64 + k0__); } while (0)
#define X_LERP(ci_, par_, rd_, kd_) do { const int tid__ = opq(tid_), j__ = tid__ >> 3, k0__ = (tid__ & 7) * 8; const bool ctx__ = (ci_) < 4; \
            { float v__[8]; px_lerp(qv, ctx__, 1024 + h * 64 + k0__, mu, v__); *(LAS u32x4*)(lds + ((par_) ? I_VV2 : I_VV) + ioff(j__, k0__)) = pack8(v__); } \
            { float xw__[8]; px_lerp(qw, ctx__, 1536 + k0__, mu, xw__); \
              _Pragma("unroll") for (int e = 0; e < 8; ++e) xw__[e] = ftanh(xw__[e]); \
              *(LAS u32x4*)(lds + I_XW + ioff(j__, k0__)) = pack8(xw__); } \
            { float xa__[8]; px_lerp(qa, ctx__, 1600 + k0__, mu, xa__); *(LAS u32x4*)(lds + I_XA + ioff(j__, k0__)) = pack8(xa__); } \
            px_lerp(qr, ctx__, h * 64 + k0__, mu, rd_); px_lerp(qk, ctx__, 512 + h * 64 + k0__, mu, kd_); } while (0)
#define X_LORA() do { const int lane = opq(lane_); const int pr = wave >> 2, nt = wave & 3; \
            const LAS unsigned char* Ximg = lds + (pr ? I_XA : I_XW); const LAS unsigned char* Wimg = lds + (pr ? I_AUP : I_WUP); \
            LAS float* Dout = (LAS float*)(lds + (pr ? I_DA : I_DW)); \
            const bf16x8 b0 = frag_rm(Ximg, 16 * nt, 0, lane), b1 = frag_rm(Ximg, 16 * nt, 32, lane); \
            bf16x8 wa[4][2]; \
            _Pragma("unroll") for (int mt = 0; mt < 4; ++mt) { wa[mt][0] = frag_tr(Wimg, 0, 16 * mt, lane); wa[mt][1] = frag_tr(Wimg, 32, 16 * mt, lane); } \
            _Pragma("unroll") for (int mt = 0; mt < 4; ++mt) { const f32x4 acc = MFMA16(wa[mt][1], b1, MFMA16(wa[mt][0], b0, fz)); \
                *(LAS f32x4*)(Dout + (16 * nt + (lane & 15)) * 68 + 16 * mt + 4 * (lane >> 4)) = acc; } } while (0)
        float r[8], k[8];
#if XSCOPE
        { Px5 qv, qw, qa, qr, qk; X_PXLOAD(XCI(0));
          X_LERP(XCI(0), 0, r, k); }
#else
        Px5 qv, qw, qa, qr, qk;
        X_PXLOAD(XCI(0));
        X_LERP(XCI(0), 0, r, k);
#endif
        LBAR();
        X_LORA();
        for (int cc = 0; cc < 34; ++cc) {
            const int tid = opq(tid_), j = tid >> 3, sub = tid & 7, k0 = sub * 8;
#if XSCOPE
            Px5 qv, qw, qa, qr, qk;
#endif
            const int ci = XCI(cc);
            const bool isctx = ci < 4; const int c = isctx ? ci : ci - 4;
            const int u = bhd * 68 + ci;
            const int L = isctx ? CTXL : T, rowbase = isctx ? MX + b * CTXL : b * T;
            const int pos = 64 * c + j, t = dir ? (L - 1 - pos) : pos;
            const LAS unsigned char* vvimg = lds + ((cc & 1) ? I_VV2 : I_VV);
            LBAR();
            if (cc + 1 < 34) X_PXLOAD(XCI(cc + 1));
            float kkn[8], ab[8], kd[8];
            { const LAS float* DW = (const LAS float*)(lds + I_DW) + j * 68 + k0; const LAS float* DA = (const LAS float*)(lds + I_DA) + j * 68 + k0;
              const f32x4 d0 = *(const LAS f32x4*)DW, d1 = *(const LAS f32x4*)(DW + 4), e0 = *(const LAS f32x4*)DA, e1 = *(const LAS f32x4*)(DA + 4);
              const float dw[8] = {d0.x, d0.y, d0.z, d0.w, d1.x, d1.y, d1.z, d1.w}, da[8] = {e0.x, e0.y, e0.z, e0.w, e1.x, e1.y, e1.z, e1.w};
              const LAS float* PAR = (const LAS float*)(lds + I_PAR) + k0;
              const LAS float* w0p = PAR; const LAS float* a0p = PAR + 64; const LAS float* kkp = PAR + 128; const LAS float* kap = PAR + 192; const LAS float* rkp = PAR + 256;
              float ss = 0.f, bd = 0.f, lw[8];
#pragma unroll
              for (int e = 0; e < 8; ++e) {
                  kkn[e] = k[e] * kkp[e]; ss += kkn[e] * kkn[e];
                  const float z = w0p[e] + dw[e];
                  lw[e] = -0.60653066f * fsigmoid(z);
                  const float as = fsigmoid(a0p[e] + da[e]);
                  kd[e] = k[e] * (1.f + (as - 1.f) * kap[e]);
                  bd += r[e] * kd[e] * rkp[e];
                  ab[e] = as; }
              ss = red8(ss); bd = red8(bd);
              const float inv = __builtin_amdgcn_rcpf(fmaxf(__builtin_amdgcn_sqrtf(ss), 1e-12f));
#pragma unroll
              for (int e = 0; e < 8; ++e) { kkn[e] *= inv; ab[e] *= kkn[e]; }
              LAS float* Gs = (LAS float*)(lds + I_G) + j * 64 + k0;
              *(LAS f32x4*)Gs = (f32x4){lw[0], lw[1], lw[2], lw[3]}; *(LAS f32x4*)(Gs + 4) = (f32x4){lw[4], lw[5], lw[6], lw[7]};
              if (!isctx && sub == 0) *(float*)(p.ws + (size_t)(unsigned)(WS_BDOT + ((dir * MX + rowbase + t) * NH + h) * 4)) = bd; }
            LBAR();
            { const int kap = tid & 63, jq = tid >> 6; LAS float* Gs = (LAS float*)(lds + I_G); LAS float* GT = (LAS float*)(lds + I_GT);
              float pf[8], run = 0.f;
#pragma unroll
              for (int e = 0; e < 8; ++e) { run += Gs[(8 * jq + e) * 64 + kap]; pf[e] = run; }
              GT[jq * 64 + kap] = run;
              LBAR();
              float off = 0.f;
#pragma unroll
              for (int q = 0; q < 7; ++q) off += (q < jq) ? GT[q * 64 + kap] : 0.f;
#pragma unroll
              for (int e = 0; e < 8; ++e) Gs[(8 * jq + e) * 64 + kap] = pf[e] + off; }
            LBAR();
            { const LAS float* Gs = (const LAS float*)(lds + I_G);
              const f32x4 g0 = *(const LAS f32x4*)(Gs + j * 64 + k0), g1 = *(const LAS f32x4*)(Gs + j * 64 + k0 + 4);
              const f32x4 c0 = *(const LAS f32x4*)(Gs + 63 * 64 + k0), c1 = *(const LAS f32x4*)(Gs + 63 * 64 + k0 + 4);
              f32x4 m0 = fz, m1 = fz; if (j > 0) { m0 = *(const LAS f32x4*)(Gs + (j - 1) * 64 + k0); m1 = *(const LAS f32x4*)(Gs + (j - 1) * 64 + k0 + 4); }
              const float g[8] = {g0.x, g0.y, g0.z, g0.w, g1.x, g1.y, g1.z, g1.w}, gm[8] = {m0.x, m0.y, m0.z, m0.w, m1.x, m1.y, m1.z, m1.w}, gc[8] = {c0.x, c0.y, c0.z, c0.w, c1.x, c1.y, c1.z, c1.w};
              float at[8], bt[8], kt[8], rt[8], bh[8], kh[8];
#pragma unroll
              for (int e = 0; e < 8; ++e) { const float eg = __expf(g[e]), em = __expf(gm[e]), ei = __expf(-g[e]), eh = __expf(gc[e] - g[e]);
                  at[e] = -kkn[e] * em; bt[e] = ab[e] * ei; kt[e] = kd[e] * ei; rt[e] = r[e] * eg; bh[e] = ab[e] * eh; kh[e] = kd[e] * eh; }
              const int o = ioff(j, k0);
              *(LAS u32x4*)(lds + I_AT + o) = pack8(at); *(LAS u32x4*)(lds + I_BT + o) = pack8(bt); *(LAS u32x4*)(lds + I_KT + o) = pack8(kt);
              *(LAS u32x4*)(lds + I_RT + o) = pack8(rt); *(LAS u32x4*)(lds + I_BH + o) = pack8(bh); *(LAS u32x4*)(lds + I_KH + o) = pack8(kh);
              if (j == 0) { float* GAM = (float*)(p.ws + (size_t)(unsigned)(WS_GAM + (u * 64 + k0) * 4));
#pragma unroll
                  for (int e = 0; e < 8; ++e) GAM[e] = __expf(gc[e]); } }
            LBAR();
            const int cvitem = __builtin_amdgcn_readfirstlane(opq((CVPOS != 0 && cc < 32 && wave >= 5) ? item * 96 + cc * 3 + (wave - 5) : -1));
            f32x4 cv[8];
#if CVPOS == 1
            if (cvitem >= 0) xcvt_load(p, cvitem, opq(lane_), cv);
#endif
            { const int lane = opq(lane_); const int nt = wave >> 1, mb = (wave & 1) * 2;
              const bf16x8 bB0 = frag_rm(lds + I_BT, 16 * nt, 0, lane), bB1 = frag_rm(lds + I_BT, 16 * nt, 32, lane);
              const int n = 16 * nt + (lane & 15);
#pragma unroll
              for (int mi = 0; mi < 2; ++mi) { const int mt = mb + mi, m0 = 16 * mt + 4 * (lane >> 4);
                  const bf16x8 aA0 = frag_rm(lds + I_AT, 16 * mt, 0, lane), aA1 = frag_rm(lds + I_AT, 16 * mt, 32, lane);
                  f32x4 lt = MFMA16(aA1, bB1, MFMA16(aA0, bB0, fz));
#pragma unroll
                  for (int q = 0; q < 4; ++q) lt[q] = (m0 + q > n) ? lt[q] : 0.f;
                  *(LAS f32x4*)((LAS float*)(lds + I_LT) + n * 68 + m0) = lt;
                  st_img(lds + I_LBT, 16 * nt, 16 * mt, lane, lt); } }
            LBAR();
            if (wave == 0) {
                const int lane = opq(lane_); const int a16 = lane >> 4, il = lane & 15;
                const LAS float* LT = (const LAS float*)(lds + I_LT);
                typedef float f32x2v __attribute__((ext_vector_type(2)));
                f32x2v tp[8];
#pragma unroll
                for (int i = 0; i < 8; ++i) tp[i] = (f32x2v){0.f, 0.f};
                f32x4 Lc[4], Ln[4];
#pragma unroll
                for (int q4 = 0; q4 < 4; ++q4) { Lc[q4] = fz; Ln[q4] = fz; }
                Lc[3] = *(const LAS f32x4*)(LT + (16 * a16 + 14) * 68 + 16 * a16 + 12);
                tp[7].y = (il == 15) ? 1.f : 0.f;
#pragma unroll
                for (int jl = 14; jl >= 0; --jl) {
                    if (jl > 0) { const LAS float* Lrow = LT + (16 * a16 + jl - 1) * 68 + 16 * a16;
#pragma unroll
                        for (int q4 = 0; q4 < 4; ++q4) if (4 * q4 + 3 > jl - 1) Ln[q4] = *(const LAS f32x4*)(Lrow + 4 * q4); }
                    f32x2v s01 = (f32x2v){(il == jl) ? 1.f : 0.f, 0.f}, s23 = (f32x2v){0.f, 0.f};
#pragma unroll
                    for (int q4 = 0; q4 < 4; ++q4) if (4 * q4 + 3 > jl) { const f32x4 Lv = Lc[q4];
                        s01 += tp[2 * q4] * (f32x2v){Lv.x, Lv.y}; s23 += tp[2 * q4 + 1] * (f32x2v){Lv.z, Lv.w}; }
                    float tv_ = (s01.x + s01.y) + (s23.x + s23.y);
                    asm volatile("" : "+v"(tv_) :: "memory");
                    if (jl & 1) tp[jl >> 1].y = tv_; else tp[jl >> 1].x = tv_;
#pragma unroll
                    for (int q4 = 0; q4 < 4; ++q4) Lc[q4] = Ln[q4];
                }
                LAS unsigned char* tmi = lds + I_TM;
                const u32x4 z4 = (u32x4){0u, 0u, 0u, 0u};
#pragma unroll
                for (int c8 = 0; c8 < 2; ++c8) { const float tv[8] = {tp[4 * c8].x, tp[4 * c8].y, tp[4 * c8 + 1].x, tp[4 * c8 + 1].y, tp[4 * c8 + 2].x, tp[4 * c8 + 2].y, tp[4 * c8 + 3].x, tp[4 * c8 + 3].y};
                    *(LAS u32x4*)(tmi + ioff(lane, 16 * a16 + 8 * c8)) = pack8(tv); }
                if ((a16 & 1) == 0) {
#pragma unroll
                    for (int c8 = 0; c8 < 2; ++c8) *(LAS u32x4*)(tmi + ioff(lane, 16 * (a16 + 1) + 8 * c8)) = z4; }
                if (a16 < 2) {
#pragma unroll
                    for (int c8 = 0; c8 < 4; ++c8) *(LAS u32x4*)(tmi + ioff(lane, 32 + 8 * c8)) = z4; }
                asm volatile("s_waitcnt lgkmcnt(0)" ::: "memory");
                const bf16x8 zf = (bf16x8){0, 0, 0, 0, 0, 0, 0, 0};
                const bool khi = (lane & 32) != 0;
#pragma unroll
                for (int pq = 0; pq < 2; ++pq) {
                    bf16x8 fa = frag_tr(lds + I_TM, 32 * pq, 32 * pq, lane), fb = frag_tr(lds + I_LBT, 32 * pq, 32 * pq + 16, lane);
                    fa = khi ? zf : fa; fb = khi ? zf : fb;
                    st_img(lds + I_E, 16 * pq, 0, lane, MFMA16(fa, fb, fz)); }
                asm volatile("s_waitcnt lgkmcnt(0)" ::: "memory");
#pragma unroll
                for (int pq = 0; pq < 2; ++pq) {
                    bf16x8 fa = frag_tr(lds + I_E, 16 * pq, 0, lane), fb = frag_rm(lds + I_TM, 32 * pq + 16, 32 * pq + 16, lane);
                    fa = khi ? zf : fa; fb = khi ? zf : fb;
                    st_img(lds + I_TM, 32 * pq + 16, 32 * pq, lane, MFMA16(fa, fb, fz)); }
                asm volatile("s_waitcnt lgkmcnt(0)" ::: "memory");
                { f32x4 ea[4];
#pragma unroll
                  for (int tq = 0; tq < 4; ++tq) { const int nt2 = tq >> 1, mt2 = tq & 1;
                      ea[tq] = MFMA16(frag_tr(lds + I_TM, 0, 16 * mt2, lane), frag_tr(lds + I_LBT, 0, 32 + 16 * nt2, lane), fz); }
#pragma unroll
                  for (int tq = 0; tq < 4; ++tq) st_img(lds + I_E, 16 * (tq >> 1), 16 * (tq & 1), lane, ea[tq]); }
                asm volatile("s_waitcnt lgkmcnt(0)" ::: "memory");
                { f32x4 ta[4];
#pragma unroll
                  for (int tq = 0; tq < 4; ++tq) { const int nt2 = tq >> 1, mt2 = tq & 1;
                      ta[tq] = MFMA16(frag_tr(lds + I_E, 0, 16 * mt2, lane), frag_rm(lds + I_TM, 32 + 16 * nt2, 32, lane), fz); }
#pragma unroll
                  for (int tq = 0; tq < 4; ++tq) st_img(lds + I_TM, 32 + 16 * (tq >> 1), 16 * (tq & 1), lane, ta[tq]); }
            } else if (wave < 5) {
                const int lane = opq(lane_); const int nt = wave - 1, n = 16 * nt + (lane & 15);
                const bf16x8 bA0 = frag_rm(lds + I_AT, 16 * nt, 0, lane), bA1 = frag_rm(lds + I_AT, 16 * nt, 32, lane);
                const bf16x8 bR0 = frag_rm(lds + I_RT, 16 * nt, 0, lane), bR1 = frag_rm(lds + I_RT, 16 * nt, 32, lane);
                bf16x8 fk[4][2], fb[4][2];
#pragma unroll
                for (int mt = 0; mt < 4; ++mt) { fk[mt][0] = frag_rm(lds + I_KT, 16 * mt, 0, lane); fk[mt][1] = frag_rm(lds + I_KT, 16 * mt, 32, lane);
                                                 fb[mt][0] = frag_rm(lds + I_BT, 16 * mt, 0, lane); fb[mt][1] = frag_rm(lds + I_BT, 16 * mt, 32, lane); }
                f32x4 laks[4], prbs[4];
#pragma unroll
                for (int mt = 0; mt < 4; ++mt) { const int m0 = 16 * mt + 4 * (lane >> 4);
                    f32x4 lak = MFMA16(fk[mt][1], bA1, MFMA16(fk[mt][0], bA0, fz)), prb = MFMA16(fb[mt][1], bR1, MFMA16(fb[mt][0], bR0, fz));
#pragma unroll
                    for (int q = 0; q < 4; ++q) { lak[q] = (m0 + q < n) ? lak[q] : 0.f; prb[q] = (m0 + q <= n) ? prb[q] : 0.f; }
                    laks[mt] = lak; prbs[mt] = prb; }
#pragma unroll
                for (int mt = 0; mt < 4; ++mt) { st_img(lds + I_LAK, 16 * nt, 16 * mt, lane, laks[mt]); st_img(lds + I_PRB, 16 * nt, 16 * mt, lane, prbs[mt]); }
                bf16x8 fv[4][2];
#pragma unroll
                for (int mt = 0; mt < 4; ++mt) { fv[mt][0] = frag_tr(vvimg, 0, 16 * mt, lane); fv[mt][1] = frag_tr(vvimg, 32, 16 * mt, lane); }
                asm volatile("s_waitcnt lgkmcnt(0)" ::: "memory");
                const bf16x8 bL0 = frag_rm(lds + I_LAK, 16 * nt, 0, lane), bL1 = frag_rm(lds + I_LAK, 16 * nt, 32, lane);
                f32x4 qs[4];
#pragma unroll
                for (int mt = 0; mt < 4; ++mt) qs[mt] = MFMA16(fv[mt][1], bL1, MFMA16(fv[mt][0], bL0, fz));
#pragma unroll
                for (int mt = 0; mt < 4; ++mt) st_img(lds + I_Q, 16 * nt, 16 * mt, lane, qs[mt]);
            } else {
                const int lane = opq(lane_);
#if CVPOS == 3
                if (cvitem >= 0) xcvt_load(p, cvitem, lane, cv);
#endif
#pragma unroll
                for (int bt = 0; bt < 2; ++bt) { bf16x8 fa[3][2], fr[3][2]; f32x4 accs[3];
#pragma unroll
                    for (int k3 = 0; k3 < 3; ++k3) { const int tq = (wave - 5) + 3 * (3 * bt + k3); const int tqc = tq < 16 ? tq : 15, nt = tqc >> 2, mt = tqc & 3;
                        fa[k3][0] = frag_rm(lds + I_KT, 16 * mt, 0, lane); fa[k3][1] = frag_rm(lds + I_KT, 16 * mt, 32, lane);
                        fr[k3][0] = frag_rm(lds + I_RT, 16 * nt, 0, lane); fr[k3][1] = frag_rm(lds + I_RT, 16 * nt, 32, lane); }
#pragma unroll
                    for (int k3 = 0; k3 < 3; ++k3) { const int tq = (wave - 5) + 3 * (3 * bt + k3); const int tqc = tq < 16 ? tq : 15, nt = tqc >> 2, mt = tqc & 3, n = 16 * nt + (lane & 15), m0 = 16 * mt + 4 * (lane >> 4);
                        f32x4 acc = MFMA16(fa[k3][1], fr[k3][1], MFMA16(fa[k3][0], fr[k3][0], fz));
#pragma unroll
                        for (int q = 0; q < 4; ++q) acc[q] = (m0 + q <= n) ? acc[q] : 0.f;
                        accs[k3] = acc; }
#pragma unroll
                    for (int k3 = 0; k3 < 3; ++k3) { const int tq = (wave - 5) + 3 * (3 * bt + k3); const int tqc = tq < 16 ? tq : 15, nt = tqc >> 2, mt = tqc & 3;
                        st_img(lds + I_PRK, 16 * nt, 16 * mt, lane, accs[k3]); } }
#if CVPOS == 2
                if (cvitem >= 0) xcvt_load(p, cvitem, lane, cv);
#endif
                if (cvitem >= 0) xcvt_store(p, cvitem, lane, cv);
            }
            LBAR();
            { const int lane = opq(lane_); const int pr = wave >> 2, nt = wave & 3; const LAS unsigned char* Aimg = lds + (pr ? I_Q : I_AT); LAS unsigned char* Oimg = lds + (pr ? I_W2 : I_W1);
              const bf16x8 bT0 = frag_rm(lds + I_TM, 16 * nt, 0, lane), bT1 = frag_rm(lds + I_TM, 16 * nt, 32, lane);
#pragma unroll
              for (int mt = 0; mt < 4; ++mt) { f32x4 acc = MFMA16(frag_tr(Aimg, 0, 16 * mt, lane), bT0, fz); acc = MFMA16(frag_tr(Aimg, 32, 16 * mt, lane), bT1, acc);
                  st_img(Oimg, 16 * nt, 16 * mt, lane, acc); } }
            LBAR();
            float rn[8], kn[8];
            if (cc + 1 < 34) { X_LERP(XCI(cc + 1), (cc + 1) & 1, rn, kn); LBAR(); X_LORA(); }
            { const int lane = opq(lane_); const int nt = wave >> 1, mb = (wave & 1) * 2;
              const int n = 16 * nt + (lane & 15);
              const bf16x8 bBh0 = frag_tr(lds + I_BH, 0, 16 * nt, lane), bBh1 = frag_tr(lds + I_BH, 32, 16 * nt, lane);
              const bf16x8 bW20 = frag_tr(lds + I_W2, 0, 16 * nt, lane), bW21 = frag_tr(lds + I_W2, 32, 16 * nt, lane);
              const bf16x8 bVv0 = frag_tr(vvimg, 0, 16 * nt, lane), bVv1 = frag_tr(vvimg, 32, 16 * nt, lane);
              const bf16x8 bPb0 = frag_rm(lds + I_PRB, 16 * nt, 0, lane), bPb1 = frag_rm(lds + I_PRB, 16 * nt, 32, lane);
              const bf16x8 bPk0 = frag_rm(lds + I_PRK, 16 * nt, 0, lane), bPk1 = frag_rm(lds + I_PRK, 16 * nt, 32, lane);
              const unsigned MLRo = (unsigned)WS_MLR + (unsigned)u * 8192u, NTo = (unsigned)WS_NT + (unsigned)u * 8192u, RBo = (unsigned)WS_RB + (unsigned)(bhd * 64 + c) * 8192u;
              const int posn = 64 * c + n, tn = dir ? (T - 1 - posn) : posn;
              const unsigned Yo = (unsigned)(dir ? WS_YB : WS_YF) + (unsigned)(((b * T + tn) * DR + h * 64) * 2);
#pragma unroll
              for (int mi = 0; mi < 2; ++mi) { const int mt = mb + mi, m0 = 16 * mt + 4 * (lane >> 4);
                  const bf16x8 aW10 = frag_tr(lds + I_W1, 0, 16 * mt, lane), aW11 = frag_tr(lds + I_W1, 32, 16 * mt, lane);
                  const bf16x8 aBh0 = frag_tr(lds + I_BH, 0, 16 * mt, lane), aBh1 = frag_tr(lds + I_BH, 32, 16 * mt, lane);
                  const bf16x8 aKh0 = frag_tr(lds + I_KH, 0, 16 * mt, lane), aKh1 = frag_tr(lds + I_KH, 32, 16 * mt, lane);
                  const f32x4 mlr = MFMA16(aW11, bBh1, MFMA16(aW10, bBh0, fz));
                  const f32x4 ntv = MFMA16(aKh1, bVv1, MFMA16(aKh0, bVv0, MFMA16(aBh1, bW21, MFMA16(aBh0, bW20, fz))));
                  const int fo = ((nt * 2 + (mt >> 1)) * 64 + (lane & 15) + 16 * (2 * (mt & 1) + (lane >> 5))) * 8 + 4 * ((lane >> 4) & 1);
                  { u32x2 w; w.x = pk2(mlr[0], mlr[1]); w.y = pk2(mlr[2], mlr[3]); *(u32x2*)(p.ws + (size_t)(MLRo + 2u * (unsigned)fo)) = w; }
                  { u32x2 w; w.x = pk2(ntv[0], ntv[1]); w.y = pk2(ntv[2], ntv[3]); *(u32x2*)(p.ws + (size_t)(NTo + 8u * (unsigned)((nt * 4 + mt) * 64 + lane))) = w; }
                  if (!isctx) {
                      const bf16x8 aW20 = frag_tr(lds + I_W2, 0, 16 * mt, lane), aW21 = frag_tr(lds + I_W2, 32, 16 * mt, lane);
                      const bf16x8 aVv0 = frag_tr(vvimg, 0, 16 * mt, lane), aVv1 = frag_tr(vvimg, 32, 16 * mt, lane);
                      f32x4 rb = MFMA16(aW11, bPb1, MFMA16(aW10, bPb0, fz));
                      const f32x4 y0 = MFMA16(aVv1, bPk1, MFMA16(aVv0, bPk0, MFMA16(aW21, bPb1, MFMA16(aW20, bPb0, fz))));
                      rb += up4(*(const LAS u32x2*)(lds + I_RT + ioff(n, m0)));
                      { u32x2 w; w.x = pk2(rb[0], rb[1]); w.y = pk2(rb[2], rb[3]); *(u32x2*)(p.ws + (size_t)(RBo + 2u * (unsigned)fo)) = w; }
                      { u32x2 w; w.x = pk2(y0[0], y0[1]); w.y = pk2(y0[2], y0[3]); *(u32x2*)(p.ws + (size_t)(Yo + 2u * (unsigned)m0)) = w; }
                  } } }
#if XSCOPE
#pragma unroll
            for (int e = 0; e < 8; ++e) { r[e] = rn[e]; k[e] = kn[e]; }
#else
            if (cc + 1 < 34) {
#pragma unroll
                for (int e = 0; e < 8; ++e) { r[e] = rn[e]; k[e] = kn[e]; } }
#endif
        }
    }
}
#undef X_PXLOAD
#undef XCI
#undef X_LERP
#undef X_LORA

struct SSet { bf16x8 A0, A1, R0, R1; u32x2 N0, Y0; f32x4 G; size_t yoff; };
__device__ __forceinline__ void phase_scanS(const Params& p, LAS unsigned char* lds, int bid, int G, int wv) {
    const int tid = my_tid(wv), lane = tid & 63, wave = __builtin_amdgcn_readfirstlane(tid >> 6);
    LAS unsigned char* HH = lds; LAS unsigned char* HL = lds + IMG;
    const int mtk = wave >> 1, ntl = wave & 1;
    const f32x4 fz = (f32x4){0.f, 0.f, 0.f, 0.f};
    for (int it = bid; it < NB * NH * 2 * 2; it += G) {
        const int item = it & 127, half = it >> 7, ntg = 2 * half + ntl;
        const int dir = item & 1, h = (item >> 1) & 7, b = item >> 4;
        f32x4 Hm0 = fz;
        LBAR();
        st_img(HH, 16 * ntl, 16 * mtk, lane, fz); st_img(HL, 16 * ntl, 16 * mtk, lane, fz);
        LBAR();
        const bf16_t* MLRg = (const bf16_t*)(p.ws + WS_MLR) + (size_t)item * 68 * 4096; const bf16_t* NTg = (const bf16_t*)(p.ws + WS_NT) + (size_t)item * 68 * 4096;
        const float* GAMg = (const float*)(p.ws + WS_GAM) + (size_t)item * 68 * 64; const bf16_t* RBg = (const bf16_t*)(p.ws + WS_RB) + (size_t)item * 64 * 4096;
        bf16_t* Yg = (bf16_t*)(p.ws + (dir ? WS_YB : WS_YF)) + (size_t)b * T * DR + h * 64;
        const int arow = (mtk * 2 * 64 + lane) * 8;
#define S_LOAD(S_, ci_) do { const int ci__ = (ci_) < 68 ? (ci_) : 67; const int c__ = ci__ >= 4 ? ci__ - 4 : 0; \
            const bf16_t* M__ = MLRg + (size_t)ci__ * 4096; S_.A0 = *(const bf16x8*)(M__ + arow); S_.A1 = *(const bf16x8*)(M__ + arow + 512); \
            S_.N0 = *(const u32x2*)(NTg + (size_t)ci__ * 4096 + lane * 4 + (ntg * 4 + mtk) * 256); \
            S_.G = *(const f32x4*)(GAMg + ci__ * 64 + 16 * mtk + 4 * (lane >> 4)); \
            const bf16_t* R__ = RBg + (size_t)c__ * 4096; S_.R0 = *(const bf16x8*)(R__ + arow); S_.R1 = *(const bf16x8*)(R__ + arow + 512); \
            const int pos__ = 64 * c__ + 16 * mtk + (lane & 15), t__ = dir ? (T - 1 - pos__) : pos__; \
            S_.yoff = (size_t)t__ * DR + 4 * (lane >> 4) + 16 * ntg; S_.Y0 = *(const u32x2*)(Yg + S_.yoff); } while (0)
#define S_STEP(S_, ci_) do { if ((ci_) < 68) { \
            const bf16x8 h00 = frag_rm(HH, 16 * ntl, 0, lane), h01 = frag_rm(HH, 16 * ntl, 32, lane); \
            const bf16x8 l00 = frag_rm(HL, 16 * ntl, 0, lane), l01 = frag_rm(HL, 16 * ntl, 32, lane); \
            f32x4 a0 = Hm0 * S_.G + up4(S_.N0); \
            a0 = MFMA16(S_.A0, h00, a0); a0 = MFMA16(S_.A1, h01, a0); a0 = MFMA16(S_.A0, l00, a0); a0 = MFMA16(S_.A1, l01, a0); \
            if ((ci_) >= 4) { \
                f32x4 y0 = up4(S_.Y0); \
                y0 = MFMA16(h00, S_.R0, y0); y0 = MFMA16(h01, S_.R1, y0); y0 = MFMA16(l00, S_.R0, y0); y0 = MFMA16(l01, S_.R1, y0); \
                { u32x2 w; w.x = pk2(y0[0], y0[1]); w.y = pk2(y0[2], y0[3]); *(u32x2*)(Yg + S_.yoff) = w; } } \
            LBAR(); \
            Hm0 = a0; \
            { f32x4 hi, lo; \
              _Pragma("unroll") for (int q = 0; q < 4; ++q) { hi[q] = __uint_as_float(f2bf(a0[q]) << 16); lo[q] = a0[q] - hi[q]; } \
              st_img(HH, 16 * ntl, 16 * mtk, lane, hi); st_img(HL, 16 * ntl, 16 * mtk, lane, lo); } \
            LBAR(); } } while (0)
        SSet s0, s1, s2, s3;
        S_LOAD(s0, 0); S_LOAD(s1, 1); S_LOAD(s2, 2);
        for (int ci = 0; ci < 68; ci += 4) {
            S_LOAD(s3, ci + 3); S_STEP(s0, ci);
            S_LOAD(s0, ci + 4); S_STEP(s1, ci + 1);
            S_LOAD(s1, ci + 5); S_STEP(s2, ci + 2);
            S_LOAD(s2, ci + 6); S_STEP(s3, ci + 3);
        }
#undef S_LOAD
#undef S_STEP
    }
}

__device__ __forceinline__ void phase_out(const Params& p, LAS unsigned char* lds, int bid, int G, int wv) {
    const int tid_ = my_tid(wv), lane_ = tid_ & 63, wave = __builtin_amdgcn_readfirstlane(tid_ >> 6);
    const bf16_t* PX = (const bf16_t*)(p.ws + WS_PX); const bf16_t* YF = (const bf16_t*)(p.ws + WS_YF); const bf16_t* YB = (const bf16_t*)(p.ws + WS_YB);
    const float* BDOT = (const float*)(p.ws + WS_BDOT);
    bf16_t* AX = (bf16_t*)(p.ws + WS_AX);
    const float* mu = p.in[9];
    constexpr int SGS = 272;
    LAS unsigned char* SG = lds;
    LAS unsigned char* GW = lds + 64 * SGS + wave * IMG;
    const f32x4 fz = (f32x4){0.f, 0.f, 0.f, 0.f};
    bf16x8 gf[4][4];
    { const float* gu = p.in[17] + wave * 64 + (lane_ & 15);
#pragma unroll
      for (int ct = 0; ct < 4; ++ct)
#pragma unroll
          for (int ks = 0; ks < 4; ++ks) { float f[8];
#pragma unroll
              for (int e = 0; e < 8; ++e) f[e] = gu[(size_t)(32 * ks + 8 * (lane_ >> 4) + e) * DR + 16 * ct];
              gf[ct][ks] = __builtin_bit_cast(bf16x8, pack8(f)); } }
    const int tokl = lane_ >> 3, cs = lane_ & 7, cb = wave * 64 + cs * 8;
    float gng[8], gnb[8];
    { const f32x4 g0 = *(const f32x4*)(p.in[18] + cb), g1 = *(const f32x4*)(p.in[18] + cb + 4), b0 = *(const f32x4*)(p.in[19] + cb), b1 = *(const f32x4*)(p.in[19] + cb + 4);
      gng[0] = g0.x; gng[1] = g0.y; gng[2] = g0.z; gng[3] = g0.w; gng[4] = g1.x; gng[5] = g1.y; gng[6] = g1.z; gng[7] = g1.w;
      gnb[0] = b0.x; gnb[1] = b0.y; gnb[2] = b0.z; gnb[3] = b0.w; gnb[4] = b1.x; gnb[5] = b1.y; gnb[6] = b1.z; gnb[7] = b1.w; }
    for (int bq = bid; bq < MX / 64; bq += G) {
        const int bt = (G == 256) ? ((bq & 7) * 64 + ((bq & 255) >> 3) * 2 + (bq >> 8)) : bq;
        const int tok0 = bt * 64, b = tok0 >> 12, rowbase = b * T;
        LBAR();
        { const int tid = opq(tid_), tl = tid >> 3, sub = tid & 7; const int tok = tok0 + tl, t = tok & (T - 1);
          int nbr[4]; neighbours(t, false, rowbase, nbr);
          const Px5 q0 = px_load(PX, tok, nbr, 1664 + sub * 16), q1 = px_load(PX, tok, nbr, 1664 + sub * 16 + 8);
          float x0[8], x1[8]; px_lerp(q0, false, 1664 + sub * 16, mu, x0); px_lerp(q1, false, 1664 + sub * 16 + 8, mu, x1);
#pragma unroll
          for (int e = 0; e < 8; ++e) { x0[e] = fsigmoid(x0[e]); x1[e] = fsigmoid(x1[e]); }
          *(LAS u32x4*)(SG + tl * SGS + sub * 32) = pack8(x0); *(LAS u32x4*)(SG + tl * SGS + sub * 32 + 16) = pack8(x1); }
        LBAR();
        { const int lane = opq(lane_);
#pragma unroll
          for (int tt = 0; tt < 4; ++tt) { bf16x8 bs[4];
#pragma unroll
              for (int ks = 0; ks < 4; ++ks) bs[ks] = *(const LAS bf16x8*)(SG + (16 * tt + (lane & 15)) * SGS + (32 * ks + 8 * (lane >> 4)) * 2);
#pragma unroll
              for (int ct = 0; ct < 4; ++ct) { f32x4 acc = fz;
#pragma unroll
                  for (int ks = 0; ks < 4; ++ks) acc = MFMA16(gf[ct][ks], bs[ks], acc);
                  st_img(GW, 16 * tt, 16 * ct, lane, acc); } } }
        asm volatile("s_waitcnt lgkmcnt(0)" ::: "memory");
#pragma unroll 2
        for (int ps = 0; ps < 8; ++ps) {
            const int lane = opq(lane_); const int tl = 8 * ps + (lane >> 3), tok = tok0 + tl, t = tok & (T - 1);
            int nbr[4]; neighbours(t, false, rowbase, nbr);
            const Px5 qv = px_load(PX, tok, nbr, 1024 + cb);
            float yf[8], yb[8], y[8], g[8], v[8];
            unpack8(*(const u32x4*)(YF + (size_t)tok * DR + cb), yf); unpack8(*(const u32x4*)(YB + (size_t)tok * DR + cb), yb);
            const float bd = BDOT[(size_t)tok * NH + wave] + BDOT[((size_t)MX + tok) * NH + wave];
            unpack8(*(const LAS u32x4*)(GW + ioff(tl, 8 * (lane & 7))), g);
            px_lerp(qv, false, 1024 + cb, mu, v);
            float s1 = 0.f;
#pragma unroll
            for (int e = 0; e < 8; ++e) { y[e] = yf[e] + yb[e]; s1 += y[e]; }
            const float mean = red8(s1) * (1.f / 64.f);
            float s2 = 0.f;
#pragma unroll
            for (int e = 0; e < 8; ++e) { y[e] -= mean; s2 += y[e] * y[e]; }
            const float rstd = rsqrtf(red8(s2) * (1.f / 64.f) + 64e-5f);
            float ax[8];
#pragma unroll
            for (int e = 0; e < 8; ++e) ax[e] = (y[e] * rstd * gng[e] + gnb[e] + bd * v[e]) * g[e];
            *(u32x4*)(AX + (size_t)tok * D + cb) = pack8(ax);
        }
        { const float* cwp = p.in[20] + cb;
          const f32x4 w00 = *(const f32x4*)(cwp), w01 = *(const f32x4*)(cwp + 4), w10 = *(const f32x4*)(cwp + DR), w11 = *(const f32x4*)(cwp + DR + 4), w20 = *(const f32x4*)(cwp + 2 * DR), w21 = *(const f32x4*)(cwp + 2 * DR + 4);
          const float cw0[8] = {w00.x, w00.y, w00.z, w00.w, w01.x, w01.y, w01.z, w01.w}, cw1[8] = {w10.x, w10.y, w10.z, w10.w, w11.x, w11.y, w11.z, w11.w}, cw2[8] = {w20.x, w20.y, w20.z, w20.w, w21.x, w21.y, w21.z, w21.w};
#pragma unroll 2
          for (int ps = 0; ps < 8; ++ps) {
              const int lane = opq(lane_); const int tok = tok0 + 8 * ps + (lane >> 3), t = tok & (T - 1);
              float bg[8], c0[8], u0[8], cm[8], um[8], cp[8], up[8];
              const u32x4 z = (u32x4){0u, 0u, 0u, 0u};
              const bf16_t* pr = PX + (size_t)tok * DIN + RWC + cb;
              unpack8(*(const u32x4*)pr, bg); unpack8(*(const u32x4*)(pr + 512), c0); unpack8(*(const u32x4*)(pr + 1024), u0);
              unpack8(t > 0 ? *(const u32x4*)(pr - DIN + 512) : z, cm); unpack8(t > 0 ? *(const u32x4*)(pr - DIN + 1024) : z, um);
              unpack8(t < T - 1 ? *(const u32x4*)(pr + DIN + 512) : z, cp); unpack8(t < T - 1 ? *(const u32x4*)(pr + DIN + 1024) : z, up);
              float bx[8];
#pragma unroll
              for (int e = 0; e < 8; ++e) bx[e] = bg[e] * (cw0[e] * (cm[e] * um[e]) + cw1[e] * (c0[e] * u0[e]) + cw2[e] * (cp[e] * up[e]));
              *(u32x4*)(AX + (size_t)tok * D + DR + cb) = pack8(bx);
          } }
    }
}

__device__ __forceinline__ void phase_hx(const Params& p, LAS unsigned char* lds, int bid, int G, int wv) {
    const int tid = my_tid(wv), lane = tid & 63, wave = tid >> 6;
    const bf16_t* X1 = (const bf16_t*)(p.ws + WS_X1); const float* MOD = (const float*)(p.ws + WS_MOD); const float* n2g = p.in[7];
    unsigned char* HX = p.ws + WS_HX; float* AFF = (float*)(p.ws + WS_AFF);
    LAS float* RW = (LAS float*)lds;
    { const float* rw = p.in[22]; for (int i = tid; i < 1024 * 16; i += NTHR) RW[(i & 15) * 1024 + (i >> 4)] = rw[i]; }
    __syncthreads();
    const int gw = bid * NWAVES + wave, NGW = G * NWAVES;
    const bool u5 = (lane & 32) != 0, u4 = (lane & 16) != 0, u3 = (lane & 8) != 0, u2 = (lane & 4) != 0;
    const int emine = (u5 ? 8 : 0) + (u4 ? 4 : 0) + (u3 ? 2 : 0) + (u2 ? 1 : 0);
    for (int blk = gw; blk < MX / 16; blk += NGW) {
        const int tokb = blk * 16, b = tokb >> 12;
        const float* sh = MOD + (size_t)b * 6144 + 3072; const float* scp = sh + 1024;
        f32x4 ga[4], hb[4];
#pragma unroll
        for (int j = 0; j < 4; ++j) { const int col = 4 * (lane + 64 * j); ga[j] = *(const f32x4*)(n2g + col) * (*(const f32x4*)(scp + col) + 1.f); hb[j] = *(const f32x4*)(sh + col); }
        u32x2 xq[2][4];
#pragma unroll
        for (int tk = 0; tk < 2; ++tk)
#pragma unroll
            for (int j = 0; j < 4; ++j) xq[tk][j] = ((const u32x2*)(X1 + (size_t)(tokb + tk) * D))[lane + 64 * j];
        for (int it = 0; it < 8; ++it) {
            f32x4 yv[2][4]; float lg[2][16];
            u32x2 xn[2][4];
            { const int itn = it < 7 ? it + 1 : it;
#pragma unroll
              for (int tk = 0; tk < 2; ++tk)
#pragma unroll
                for (int j = 0; j < 4; ++j) xn[tk][j] = ((const u32x2*)(X1 + (size_t)(tokb + 2 * itn + tk) * D))[lane + 64 * j]; }
#pragma unroll
            for (int tk = 0; tk < 2; ++tk) { const int tok = tokb + 2 * it + tk;
                f32x4 v[4]; float ss = 0.f;
#pragma unroll
                for (int j = 0; j < 4; ++j) { v[j] = up4(xq[tk][j]); ss += (v[j].x * v[j].x + v[j].y * v[j].y) + (v[j].z * v[j].z + v[j].w * v[j].w); }
                const float rstd = rsqrtf(wave_sum(ss) * (1.f / D) + 1e-6f);
#pragma unroll
                for (int j = 0; j < 4; ++j) { const f32x4 y = v[j] * rstd * ga[j] + hb[j]; yv[tk][j] = y;
#if MOE_FP8
                    *(unsigned*)(HX + (size_t)tok * D + 4 * (lane + 64 * j)) = pk4_fp8_raw(y.x, y.y, y.z, y.w); } }
#else
                    u32x2 o; o.x = pk2(y.x, y.y); o.y = pk2(y.z, y.w);
                    *(u32x2*)((bf16_t*)HX + (size_t)tok * D + 4 * (lane + 64 * j)) = o; } }
#endif
            f32x2 yp[4][4];
#pragma unroll
            for (int j = 0; j < 4; ++j)
#pragma unroll
                for (int c = 0; c < 4; ++c) yp[j][c] = (f32x2){yv[0][j][c], yv[1][j][c]};
#pragma unroll
            for (int e = 0; e < 16; ++e) { f32x2 a = (f32x2){0.f, 0.f}, a2 = (f32x2){0.f, 0.f};
#pragma unroll
                for (int j = 0; j < 4; ++j) { const f32x4 w = *(const LAS f32x4*)(RW + e * 1024 + 4 * (lane + 64 * j));
                    a += yp[j][0] * (f32x2){w.x, w.x}; a2 += yp[j][1] * (f32x2){w.y, w.y}; a += yp[j][2] * (f32x2){w.z, w.z}; a2 += yp[j][3] * (f32x2){w.w, w.w}; }
                a += a2;
                float a0 = a.x, a1 = a.y;
                asm volatile("" : "+v"(a0), "+v"(a1) :: "memory");
                lg[0][e] = a0; lg[1][e] = a1; }
#pragma unroll
            for (int tk = 0; tk < 2; ++tk) { const int tok = tokb + 2 * it + tk, t = tok & (T - 1);
                float r8[8], r4[4], r2[2], r1;
#pragma unroll
                for (int k = 0; k < 8; ++k) { const float keep = u5 ? lg[tk][k + 8] : lg[tk][k], send = u5 ? lg[tk][k] : lg[tk][k + 8]; r8[k] = keep + __shfl_xor(send, 32); }
#pragma unroll
                for (int k = 0; k < 4; ++k) { const float keep = u4 ? r8[k + 4] : r8[k], send = u4 ? r8[k] : r8[k + 4]; r4[k] = keep + __shfl_xor(send, 16); }
#pragma unroll
                for (int k = 0; k < 2; ++k) { const float keep = u3 ? r4[k + 2] : r4[k], send = u3 ? r4[k] : r4[k + 2]; r2[k] = keep + __shfl_xor(send, 8); }
                { const float keep = u2 ? r2[1] : r2[0], send = u2 ? r2[0] : r2[1]; r1 = keep + __shfl_xor(send, 4); }
                r1 += __shfl_xor(r1, 1); r1 += __shfl_xor(r1, 2);
                float mx = r1;
                mx = fmaxf(mx, __shfl_xor(mx, 4)); mx = fmaxf(mx, __shfl_xor(mx, 8)); mx = fmaxf(mx, __shfl_xor(mx, 16)); mx = fmaxf(mx, __shfl_xor(mx, 32));
                const float ex = expf(r1 - mx);
                float den = ex;
                den += __shfl_xor(den, 4); den += __shfl_xor(den, 8); den += __shfl_xor(den, 16); den += __shfl_xor(den, 32);
                if ((lane & 3) == 0) AFF[((size_t)b * NE + emine) * T + t] = ex / den; }
#pragma unroll
            for (int tk = 0; tk < 2; ++tk)
#pragma unroll
                for (int j = 0; j < 4; ++j) xq[tk][j] = xn[tk][j];
        }
    }
}

__device__ __forceinline__ int block_scan512(int v, LAS int* sc, int tid, int& total) {
    const int lane = tid & 63, w = tid >> 6;
    int x = v;
#pragma unroll
    for (int o = 1; o < 64; o <<= 1) { const int y = __shfl_up(x, o); x += (lane >= o) ? y : 0; }
    if (lane == 63) sc[w] = x;
    __syncthreads();
    int base = 0, tot = 0;
#pragma unroll
    for (int i = 0; i < 8; ++i) { const int t = sc[i]; tot += t; base += (i < w) ? t : 0; }
    __syncthreads();
    total = tot; return base + x - v;
}
__device__ __forceinline__ void radix_round(const int (&bin)[8], const bool (&act)[8], int need, LAS int* hist, LAS int* sc, int tid, int& Bsel, int& aboveSel) {
#pragma unroll
    for (int q = 0; q < 8; ++q) hist[tid * 8 + q] = 0;
    __syncthreads();
#pragma unroll
    for (int q = 0; q < 8; ++q) if (act[q]) atomicAdd((int*)(hist + bin[q]), 1);
    __syncthreads();
    int c[8], ssum = 0;
#pragma unroll
    for (int q = 0; q < 8; ++q) { c[q] = hist[tid * 8 + q]; ssum += c[q]; }
    int total; const int P = block_scan512(ssum, sc, tid, total);
    int running = total - P - ssum;
#pragma unroll
    for (int q = 7; q >= 0; --q) { if (running < need && running + c[q] >= need) { sc[8] = tid * 8 + q; sc[9] = running; } running += c[q]; }
    __syncthreads();
    Bsel = sc[8]; aboveSel = sc[9];
    __syncthreads();
}
__device__ __forceinline__ void phase_topk(const Params& p, LAS unsigned char* lds, int bid, int G, int wv) {
    const int tid = my_tid(wv);
    const float* AFF = (const float*)(p.ws + WS_AFF);
    int* IDX = (int*)(p.ws + WS_IDX); float* VAL = (float*)(p.ws + WS_VAL); int* SEL = (int*)(p.ws + WS_SEL);
    LAS int* hist = (LAS int*)lds;
    LAS int* sc = (LAS int*)(lds + 16384);
    for (int item = bid; item < NB * NE; item += G) {
        const int b = item >> 4, e = item & 15;
        __syncthreads();
        const f32x4 v0 = ((const f32x4*)(AFF + (size_t)item * T))[2 * tid], v1 = ((const f32x4*)(AFF + (size_t)item * T))[2 * tid + 1];
        const float val[8] = {v0.x, v0.y, v0.z, v0.w, v1.x, v1.y, v1.z, v1.w};
        unsigned key[8]; int bin[8]; bool act[8];
#pragma unroll
        for (int q = 0; q < 8; ++q) { key[q] = __float_as_uint(val[q]); bin[q] = (int)(key[q] >> 20); act[q] = true; }
        int B1, ab1; radix_round(bin, act, CAP, hist, sc, tid, B1, ab1);
        const int need1 = CAP - ab1;
#pragma unroll
        for (int q = 0; q < 8; ++q) { act[q] = (int)(key[q] >> 20) == B1; bin[q] = (int)((key[q] >> 8) & 0xFFFu); }
        int B2, ab2; radix_round(bin, act, need1, hist, sc, tid, B2, ab2);
        const int need2 = need1 - ab2;
#pragma unroll
        for (int q = 0; q < 8; ++q) { act[q] = act[q] && (int)((key[q] >> 8) & 0xFFFu) == B2; bin[q] = (int)(key[q] & 0xFFu); }
        int B3, ab3; radix_round(bin, act, need2, hist, sc, tid, B3, ab3);
        const int need3 = need2 - ab3;
        const unsigned K = ((unsigned)B1 << 20) | ((unsigned)B2 << 8) | (unsigned)B3;
        int eqc = 0;
#pragma unroll
        for (int q = 0; q < 8; ++q) eqc += (key[q] == K) ? 1 : 0;
        int tot; int eqr = block_scan512(eqc, sc, tid, tot);
        bool selq[8]; int cnt = 0;
#pragma unroll
        for (int q = 0; q < 8; ++q) { const bool eq = key[q] == K; selq[q] = key[q] > K || (eq && eqr < need3); eqr += eq ? 1 : 0; cnt += selq[q] ? 1 : 0; }
        int slot = block_scan512(cnt, sc, tid, tot);
#pragma unroll
        for (int q = 0; q < 8; ++q) { const int tok = tid * 8 + q;
            SEL[(size_t)item * T + tok] = selq[q] ? slot : -1;
            if (selq[q]) { IDX[(e * NB + b) * CAP + slot] = b * T + tok; VAL[(e * NB + b) * CAP + slot] = val[q]; ++slot; } }
    }
}

__device__ __forceinline__ void phase_final(const Params& p, int bid, int G, int wv) {
    const int tid = my_tid(wv), lane = tid & 63, wave = tid >> 6;
    const bf16_t* X1 = (const bf16_t*)(p.ws + WS_X1); const bf16_t* DN = (const bf16_t*)(p.ws + WS_DN); const int* SEL = (const int*)(p.ws + WS_SEL);
    const float* fg = p.in[26];
    const int gw = bid * NWAVES + wave, NGW = G * NWAVES;
    for (int tok0 = gw; tok0 < MX; tok0 += 2 * NGW) {
        f32x4 v[2][4]; int sel[2]; unsigned long long mask[2];
#pragma unroll
        for (int tk = 0; tk < 2; ++tk) { const int tok = tok0 + tk * NGW, b = tok >> 12, t = tok & (T - 1);
            sel[tk] = lane < NE ? SEL[((size_t)b * NE + lane) * T + t] : -1;
#pragma unroll
            for (int j = 0; j < 4; ++j) v[tk][j] = up4(((const u32x2*)(X1 + (size_t)tok * D))[lane + 64 * j]); }
#pragma unroll
        for (int tk = 0; tk < 2; ++tk) mask[tk] = __ballot(sel[tk] >= 0);
#pragma unroll
        for (int tk = 0; tk < 2; ++tk) { const int tok = tok0 + tk * NGW, b = tok >> 12;
            unsigned long long m = mask[tk];
            while (m) {
#if MOE_FP8
                const unsigned char* rp[4]; float wg[4];
#pragma unroll
                for (int q = 0; q < 4; ++q) {
                    if (m) { const int e = __builtin_ctzll(m); m &= m - 1; const int s_ = __builtin_amdgcn_readlane(sel[tk], e);
                        rp[q] = (const unsigned char*)DN + ((size_t)(e * NB + b) * CAP + s_) * D; wg[q] = 1.f / 16.f; }
                    else { rp[q] = (const unsigned char*)DN; wg[q] = 0.f; } }
                unsigned w[4][4];
#pragma unroll
                for (int q = 0; q < 4; ++q)
#pragma unroll
                    for (int j = 0; j < 4; ++j) w[q][j] = *(const unsigned*)(rp[q] + 4 * (lane + 64 * j));
#pragma unroll
                for (int q = 0; q < 4; ++q)
#pragma unroll
                    for (int j = 0; j < 4; ++j) { const f32x2 lo = __builtin_amdgcn_cvt_pk_f32_fp8((int)w[q][j], false), hi = __builtin_amdgcn_cvt_pk_f32_fp8((int)w[q][j], true);
                        v[tk][j].x += wg[q] * lo.x; v[tk][j].y += wg[q] * lo.y; v[tk][j].z += wg[q] * hi.x; v[tk][j].w += wg[q] * hi.y; }
#else
                const bf16_t* rp[4]; float wg[4];
#pragma unroll
                for (int q = 0; q < 4; ++q) {
                    if (m) { const int e = __builtin_ctzll(m); m &= m - 1; const int s_ = __builtin_amdgcn_readlane(sel[tk], e);
                        rp[q] = DN + ((size_t)(e * NB + b) * CAP + s_) * D; wg[q] = 1.f; }
                    else { rp[q] = DN; wg[q] = 0.f; } }
                u32x2 w[4][4];
#pragma unroll
                for (int q = 0; q < 4; ++q)
#pragma unroll
                    for (int j = 0; j < 4; ++j) w[q][j] = *(const u32x2*)(rp[q] + 4 * (lane + 64 * j));
#pragma unroll
                for (int q = 0; q < 4; ++q)
#pragma unroll
                    for (int j = 0; j < 4; ++j) { v[tk][j].x += wg[q] * bflo(w[q][j].x); v[tk][j].y += wg[q] * bfhi(w[q][j].x); v[tk][j].z += wg[q] * bflo(w[q][j].y); v[tk][j].w += wg[q] * bfhi(w[q][j].y); }
#endif
            } }
#pragma unroll
        for (int tk = 0; tk < 2; ++tk) { const int tok = tok0 + tk * NGW;
            float ss = 0.f;
#pragma unroll
            for (int j = 0; j < 4; ++j) ss += (v[tk][j].x * v[tk][j].x + v[tk][j].y * v[tk][j].y) + (v[tk][j].z * v[tk][j].z + v[tk][j].w * v[tk][j].w);
            const float rstd = rsqrtf(wave_sum(ss) * (1.f / D) + 1e-6f);
#pragma unroll
            for (int j = 0; j < 4; ++j) { const int col = 4 * (lane + 64 * j); const f32x4 g = *(const f32x4*)(fg + col);
                *(f32x4*)(p.out + (size_t)tok * D + col) = v[tk][j] * rstd * g; } }
    }
}

#define XB_TMO      128
#define XB_XCNT(j)  (256  + 64 * (j))
#define XB_XSUB(j)  (1280 + 64 * (j))
#define XB_XGEN(j)  (2304 + 64 * (j))
#define XB_TOP      3328
#define XB_TOPGEN   3392
#define XCD_BAR_WORDS 3456
#define XB_SPIN_CAP (1u << 20)
__device__ __forceinline__ unsigned xb_ld(unsigned* p)              { return __hip_atomic_load(p, __ATOMIC_RELAXED, __HIP_MEMORY_SCOPE_AGENT); }
__device__ __forceinline__ unsigned xb_add(unsigned* p, unsigned v) { return __hip_atomic_fetch_add(p, v, __ATOMIC_RELAXED, __HIP_MEMORY_SCOPE_AGENT); }
__device__ __forceinline__ unsigned xb_xcc_id() { return (unsigned)__builtin_amdgcn_s_getreg((3 << 11) | 20) & 0xFu; }
#define XB_SPIN(cond, bar) do { unsigned _sp = 0; while (cond) { __builtin_amdgcn_s_sleep(1); \
    if ((++_sp & 255u) == 0u) { if (xb_ld(&(bar)[XB_TMO])) break; if (_sp > XB_SPIN_CAP) { atomicAdd(&(bar)[XB_TMO], 1u); break; } } } } while (0)
struct XcdBarrier { unsigned* bar; unsigned x; volatile LAS unsigned* st; int wv; };
__device__ __forceinline__ XcdBarrier xcd_barrier_post(unsigned* bar, volatile LAS unsigned* st, int wv) {
    XcdBarrier b; b.bar = bar; b.x = xb_xcc_id(); b.st = st; b.wv = wv;
    if (my_tid(wv) == 0) (void)xb_add(&bar[XB_XCNT(b.x)], 1u);
    return b;
}
__device__ __forceinline__ void xcd_barrier_complete(unsigned* bar, unsigned x, unsigned& nloc, unsigned& nx) {
    const unsigned G = gridDim.x * gridDim.y * gridDim.z;
    unsigned sum, cnt, mine, sp = 0u;
    for (;;) {
        sum = 0u; cnt = 0u; mine = 0u;
#pragma unroll
        for (unsigned j = 0; j < 16; ++j) { const unsigned c = xb_ld(&bar[XB_XCNT(j)]); sum += c; cnt += (c > 0u) ? 1u : 0u; mine = (j == x) ? c : mine; }
        if (sum == G) break;
        __builtin_amdgcn_s_sleep(1);
        if ((++sp & 255u) == 0u) { if (xb_ld(&bar[XB_TMO])) break; if (sp > XB_SPIN_CAP) { atomicAdd(&bar[XB_TMO], 1u); break; } }
    }
    nloc = mine > 0u ? mine : 1u; nx = cnt > 0u ? cnt : 1u;
}
__device__ __forceinline__ void xcd_barrier(const XcdBarrier& b) {
    asm volatile("s_waitcnt vmcnt(0)" ::: "memory");
    __syncthreads();
    if (my_tid(b.wv) == 0) {
        unsigned* bar = b.bar;
        __builtin_amdgcn_s_waitcnt(0);
        unsigned nloc = b.st[0], nx = b.st[1];
        if (nloc == 0u) { xcd_barrier_complete(bar, b.x, nloc, nx); b.st[0] = nloc; b.st[1] = nx; }
        const unsigned old = xb_add(&bar[XB_XSUB(b.x)], 1u);
        const unsigned gen = old / nloc;
        if (old + 1u == (gen + 1u) * nloc) {
            __builtin_amdgcn_fence(__ATOMIC_RELEASE, "agent");
            asm volatile("s_waitcnt vmcnt(0)" ::: "memory");
            const unsigned og = xb_add(&bar[XB_TOP], 1u);
            const unsigned tg = og / nx;
            if (og + 1u == (tg + 1u) * nx) xb_add(&bar[XB_TOPGEN], 1u);
            else XB_SPIN(xb_ld(&bar[XB_TOPGEN]) == tg, bar);
            __builtin_amdgcn_fence(__ATOMIC_ACQUIRE, "agent");
            xb_add(&bar[XB_XGEN(b.x)], 1u);
            asm volatile("s_waitcnt vmcnt(0)" ::: "memory");
        } else {
            XB_SPIN(xb_ld(&bar[XB_XGEN(b.x)]) == gen, bar);
            __builtin_amdgcn_fence(__ATOMIC_ACQUIRE, "agent");
            asm volatile("s_waitcnt vmcnt(0)" ::: "memory");
        }
    }
    __syncthreads();
}

constexpr int N_PHASES = 12;
__global__ void __launch_bounds__(NTHR, 2) mk_fwd(Params p) {
    extern __shared__ __attribute__((aligned(16))) unsigned char lds_raw[];
    LAS unsigned char* lds = (LAS unsigned char*)lds_raw;
    const int bid = blockIdx.x, G = gridDim.x;
    const int wv = __builtin_amdgcn_readfirstlane((int)threadIdx.x >> 6);
    const int lo = p.ph_lo, hi = p.ph_hi;
#if MK_FUSED
    volatile LAS unsigned* misc = (volatile LAS unsigned*)(lds + LDS_MISC);
    { const int t0 = my_tid(wv); if (t0 < 16) misc[t0] = 0u; }
    __syncthreads();
    const XcdBarrier xbar = xcd_barrier_post((unsigned*)(p.ws + WS_CTL) + 4096, misc, wv);
#define SEAM(k) do { if (lo <= (k) && (k) + 1 < hi) xcd_barrier(xbar); } while (0)
#else
#define SEAM(k) do { } while (0)
#endif
#ifndef PH_MASK
#define PH_MASK 0xFFF
#endif
#ifndef PH_REP
#define PH_REP 0
#endif
#define NREP(k) ((((PH_REP) >> (k)) & 1) ? 2 : 1)
#define IN(k) (((PH_MASK >> (k)) & 1) && lo <= (k) && (k) < hi)
    unsigned char* ws = sgpr_ptr(p.ws); unsigned char* outs = sgpr_ptr(p.out);
    if (IN(0)) { for (int r = 0; r < NREP(0); ++r) { phase0(p, lds, bid, G, wv); __syncthreads(); } SEAM(0); }
    if (IN(1)) { for (int r = 0; r < NREP(1); ++r) phase1(p, bid, G, wv); SEAM(1); }
    if (IN(2)) {
        pg8::Gemm g{(const bf16_t*)(ws + WS_XN), (const bf16_t*)(ws + WS_WINT), MALL, DIN, D, nullptr};
        pg8::InProjOrder S; S.init(G, bid);
        pg8::EpiBf16Plain E{(bf16_t*)(ws + WS_PX), DIN};
        pg8::gemm_phase<pg8::EpiBf16Plain, pg8::InProjOrder, true, true, false, false, PG8_BUF_IN>(lds, g, S, E, wv);
        SEAM(2);
    }
    for (int rep = 0; rep < NREP(4); ++rep) {
    if (IN(3)) { for (int r3 = 0; r3 < NREP(3); ++r3) phase_scanX(p, lds, bid, G, wv); SEAM(3); }
    if (IN(4)) { phase_scanS(p, lds, bid, G, wv); SEAM(4); }
    }
    if (IN(5)) { for (int r = 0; r < NREP(5); ++r) phase_out(p, lds, bid, G, wv); SEAM(5); }
    if (IN(6)) {
        pg8::Gemm g{(const bf16_t*)(ws + WS_AX), (const bf16_t*)(ws + WS_WOUTT), MX, D, D, nullptr};
        pg8::StaticOrder S; S.init(MX, D, G, bid);
        pg8::EpiResid E{p.in[0], (bf16_t*)(ws + WS_X1), (const float*)(ws + WS_MOD)};
        pg8::gemm_phase<pg8::EpiResid, pg8::StaticOrder, true, true, false, false, PG8_BUF_OUT>(lds, g, S, E, wv);
        SEAM(6);
    }
    if (IN(7)) { for (int r = 0; r < NREP(7); ++r) { phase_hx(p, lds, bid, G, wv); __syncthreads(); }
#if CVPOS == 0
        { const int tid = my_tid(wv), lane = tid & 63, gw = bid * NWAVES + (tid >> 6);
          for (int g = gw; g < 3 * 8192; g += G * NWAVES) { f32x4 cv[8]; xcvt_load(p, g, lane, cv); xcvt_store(p, g, lane, cv); } }
#endif
        SEAM(7); }
    if (IN(8)) { for (int r = 0; r < NREP(8); ++r) phase_topk(p, lds, bid, G, wv); SEAM(8); }
    if (IN(9)) {
        pg8::Gemm g{(const bf16_t*)(ws + WS_HX), (const bf16_t*)outs, NE * NB * CAP, NE * 2048, MOE_FP8 ? D / 2 : D, (const int*)(ws + WS_IDX)};
        pg8::ExpertOrder S; S.init(NE, 16, 8, G, bid);
        pg8::EpiSwiGLU E{ws + WS_HID};
        pg8::gemm_phase<pg8::EpiSwiGLU, pg8::ExpertOrder, true, true, true, MOE_FP8 != 0, PG8_BUF_MOE1>(lds, g, S, E, wv);
        SEAM(9);
    }
    if (IN(10)) {
        pg8::Gemm g{(const bf16_t*)(ws + WS_HID), (const bf16_t*)(outs + OUT_W2T), NE * NB * CAP, NE * 1024, MOE_FP8 ? DE / 2 : DE, nullptr};
        pg8::ExpertOrder S; S.init(NE, 16, 4, G, bid);
        pg8::EpiDown E{(bf16_t*)(ws + WS_DN), (const float*)(ws + WS_VAL), (const float*)(ws + WS_MOD)};
        pg8::gemm_phase<pg8::EpiDown, pg8::ExpertOrder, true, true, false, MOE_FP8 != 0, PG8_BUF_MOE2>(lds, g, S, E, wv);
        SEAM(10);
    }
    if (IN(11)) { for (int r = 0; r < NREP(11); ++r) phase_final(p, bid, G, wv); }
#undef IN
#undef SEAM
}

extern "C" void kernel_launch(void* const* d_in, const int* in_sizes, int n_in, void* d_out, int out_size, void* d_ws, size_t ws_size, hipStream_t stream) {
    static int grid = 0;
    if (grid == 0) {
        if (n_in != 27 || out_size != MX * D || ws_size < WS_END) { fprintf(stderr, "kernel_launch: unexpected shapes: n_in %d out %d ws %zu (need %zu)\n", n_in, out_size, ws_size, (size_t)WS_END); grid = -1; return; }
        int dev = 0, cus = 0, per_cu = 0;
        hipGetDevice(&dev); hipDeviceGetAttribute(&cus, hipDeviceAttributeMultiprocessorCount, dev);
        hipFuncSetAttribute((const void*)mk_fwd, hipFuncAttributeMaxDynamicSharedMemorySize, LDS_BYTES);
        hipOccupancyMaxActiveBlocksPerMultiprocessor(&per_cu, (const void*)mk_fwd, NTHR, LDS_BYTES);
        if (per_cu < 1) { fprintf(stderr, "kernel_launch: occupancy query says %d blocks per CU\n", per_cu); per_cu = 1; }
        (void)hipGetLastError();
        grid = cus;
    }
    if (grid < 0) return;
    Params p{};
    for (int i = 0; i < 27; ++i) p.in[i] = (const float*)d_in[i];
    p.out = (float*)d_out; p.ws = (unsigned char*)d_ws;
#if MK_FUSED
    (void)hipMemsetAsync((char*)d_ws + WS_CTL, 0, 65536, stream);
    p.ph_lo = 0; p.ph_hi = N_PHASES;
    void* args[] = {&p};
    hipError_t e = hipLaunchCooperativeKernel((const void*)mk_fwd, dim3(grid), dim3(NTHR), args, LDS_BYTES, stream);
    if (e != hipSuccess) fprintf(stderr, "cooperative launch failed: %s (grid %d)\n", hipGetErrorString(e), grid);
#else
    for (int ph = 0; ph < N_PHASES; ++ph) {
        p.ph_lo = ph; p.ph_hi = ph + 1;
        hipLaunchKernelGGL(mk_fwd, dim3(grid), dim3(NTHR), LDS_BYTES, stream, p);
    }
#endif
}
```

```cpp
#include <hip/hip_runtime.h>
#include <hip/hip_cooperative_groups.h>
#include <cstdio>
#include <cstdint>
namespace cg = cooperative_groups;

#ifndef MK_FUSED
#define MK_FUSED 1
#endif

#define LAS __attribute__((address_space(3)))
typedef unsigned short bf16_t;
typedef short bf16x8 __attribute__((ext_vector_type(8)));
typedef float f32x4 __attribute__((ext_vector_type(4)));
typedef unsigned u32x4 __attribute__((ext_vector_type(4)));
typedef unsigned u32x2 __attribute__((ext_vector_type(2)));
typedef int i32x8 __attribute__((ext_vector_type(8)));
typedef float f32x2 __attribute__((ext_vector_type(2)));
typedef int i32x4 __attribute__((ext_vector_type(4)));

#ifndef PG8_BUF_MOE1
#define PG8_BUF_MOE1 1
#endif
#ifndef PG8_BUF_MOE2
#define PG8_BUF_MOE2 1
#endif
#ifndef PG8_BUF_IN
#define PG8_BUF_IN 0
#endif
#ifndef PG8_BUF_OUT
#define PG8_BUF_OUT 0
#endif
#ifndef MOE_FP8
#define MOE_FP8 1
#endif
#ifndef XSCOPE
#define XSCOPE 0
#endif
#ifndef CVPOS
#define CVPOS 1
#endif
constexpr int NB = 8, T = 4096, D = 1024, CTXL = 256, DIN = 3328, RWC = 1792, NH = 8, HD = 64, DR = 512;
constexpr int NE = 16, CAP = 512, DE = 1024;
constexpr int MX = NB * T;
constexpr int MC = NB * CTXL;
constexpr int MALL = MX + MC;
constexpr int NWAVES = 8, NTHR = 512;
constexpr int LDS_BYTES = 163840;
constexpr int LDS_MISC = 154368;

constexpr size_t MiB = 1u << 20;
constexpr size_t WS_CTL = 0;
constexpr size_t WS_MOD = 1 * MiB;
constexpr size_t WS_BDOT = 2 * MiB;
constexpr size_t WS_AFF = 4 * MiB;
constexpr size_t WS_SEL = 6 * MiB;
constexpr size_t WS_GAM = 8 * MiB;
constexpr size_t WS_WOUTT = 11 * MiB;
constexpr size_t WS_IDX = 13 * MiB;
constexpr size_t WS_VAL = 13 * MiB + 256 * 1024;
constexpr size_t WS_MLR = 16 * MiB;
constexpr size_t WS_YF = 84 * MiB;
constexpr size_t WS_PX = 116 * MiB;
constexpr size_t WS_NT = 337 * MiB;
constexpr size_t WS_RB = 405 * MiB;
constexpr size_t WS_YB = 469 * MiB;
constexpr size_t WS_XN = 337 * MiB;
constexpr size_t WS_WINT = 405 * MiB;
constexpr size_t WS_AX = 337 * MiB;
constexpr size_t WS_X1 = 112 * MiB;
constexpr size_t WS_HX = 240 * MiB;
constexpr size_t WS_HID = 368 * MiB;
constexpr size_t WS_DN = 240 * MiB;
constexpr size_t WS_END = 501 * MiB;

struct Params { const float* in[27]; float* out; unsigned char* ws; int ph_lo, ph_hi; };

__device__ __forceinline__ unsigned f2bf(float f) { unsigned u = __float_as_uint(f); return (u + 0x7fffu + ((u >> 16) & 1u)) >> 16; }
typedef __bf16 hwbf16x2 __attribute__((ext_vector_type(2)));
typedef float f32x2_ __attribute__((ext_vector_type(2)));
__device__ __forceinline__ unsigned pk2(float lo, float hi) { const f32x2_ v = {lo, hi}; return __builtin_bit_cast(unsigned, __builtin_convertvector(v, hwbf16x2)); }
__device__ __forceinline__ float bflo(unsigned w) { return __uint_as_float(w << 16); }
__device__ __forceinline__ float bfhi(unsigned w) { return __uint_as_float(w & 0xffff0000u); }
__device__ __forceinline__ void unpack8(const u32x4 w, float (&f)[8]) {
    f[0] = bflo(w.x); f[1] = bfhi(w.x); f[2] = bflo(w.y); f[3] = bfhi(w.y); f[4] = bflo(w.z); f[5] = bfhi(w.z); f[6] = bflo(w.w); f[7] = bfhi(w.w); }
__device__ __forceinline__ u32x4 pack8(const float (&f)[8]) { u32x4 w; w.x = pk2(f[0], f[1]); w.y = pk2(f[2], f[3]); w.z = pk2(f[4], f[5]); w.w = pk2(f[6], f[7]); return w; }
__device__ __forceinline__ float wave_sum(float v) {
#pragma unroll
    for (int o = 1; o < 64; o <<= 1) v += __shfl_xor(v, o);
    return v;
}
__device__ __forceinline__ float wave_max(float v) {
#pragma unroll
    for (int o = 1; o < 64; o <<= 1) v = fmaxf(v, __shfl_xor(v, o));
    return v;
}
__device__ __forceinline__ float red8(float v) {
    v += __int_as_float(__builtin_amdgcn_update_dpp(0, __float_as_int(v), 0xB1, 0xF, 0xF, true));
    v += __int_as_float(__builtin_amdgcn_update_dpp(0, __float_as_int(v), 0x4E, 0xF, 0xF, true));
    v += __int_as_float(__builtin_amdgcn_update_dpp(0, __float_as_int(v), 0x141, 0xF, 0xF, true));
    return v;
}
__device__ __forceinline__ float sigmoidf_(float x) { return 1.f / (1.f + expf(-x)); }
__device__ __forceinline__ float fsigmoid(float x) { return __builtin_amdgcn_rcpf(1.f + __expf(-x)); }
__device__ __forceinline__ float ftanh(float x) { return 1.f - 2.f * __builtin_amdgcn_rcpf(1.f + __expf(2.f * x)); }

__device__ __forceinline__ float sat8(float x) { return __builtin_amdgcn_fmed3f(x, -448.f, 448.f); }
__device__ __forceinline__ unsigned pk4_fp8_raw(float a, float b, float c, float d) {
    int w = __builtin_amdgcn_cvt_pk_fp8_f32(a, b, 0, false); w = __builtin_amdgcn_cvt_pk_fp8_f32(c, d, w, true); return (unsigned)w; }
__device__ __forceinline__ unsigned pk4_fp8(float a, float b, float c, float d) { return pk4_fp8_raw(sat8(a), sat8(b), sat8(c), sat8(d)); }
constexpr float W8_SCALE = 64.f;
__device__ __forceinline__ int opq(int x) { asm volatile("" : "+v"(x)); return x; }
__device__ __forceinline__ int my_tid(int wv) { int l; asm volatile("v_mbcnt_lo_u32_b32 %0, -1, 0\n\tv_mbcnt_hi_u32_b32 %0, -1, %0" : "=v"(l)); return (wv << 6) | l; }
__device__ __forceinline__ unsigned char* sgpr_ptr(const void* q) {
    const unsigned long long v = (unsigned long long)(size_t)q;
    return (unsigned char*)(((unsigned long long)(unsigned)__builtin_amdgcn_readfirstlane((int)(v >> 32)) << 32) | (unsigned)__builtin_amdgcn_readfirstlane((int)(unsigned)v)); }
namespace pg8 {
#define PG8_LAS __attribute__((address_space(3)))
constexpr int BM = 256, BK = 64, HALF = 128, HTB = HALF * BK * 2, STAGE_BYTES = 8 * HTB, NXCD = 8, WGM = 8;
__host__ __device__ __forceinline__ int lds_byte(int r, int c) { const int st = (r >> 4) * 2 + (c >> 5), rr = r & 15, cc = c & 31, ob = rr * 64 + cc * 2; return st * 1024 + (ob ^ (((ob >> 9) & 1) << 5)); }
__host__ __device__ __forceinline__ void stage_rc(int b, int& R, int& C) { const int st = b / 1024, sb = b % 1024, swz = sb ^ (((sb >> 9) & 1) << 5); R = (st >> 1) * 16 + swz / 64; C = (st & 1) * 32 + (swz % 64) / 2; }
__host__ __device__ __forceinline__ int perm32(int rho) { const int n = rho >> 4, i = rho & 15; return 8 * (i >> 2) + 4 * n + (i & 3); }
struct Unit { int pm, pn; };
constexpr float WSC = MOE_FP8 ? 1.f / 64.f : 1.f;
struct Gemm { const bf16_t* A; const bf16_t* Bt; int M, N, K; const int* rowmap; };

__device__ __forceinline__ int xcd_remap(int wgid, int nwg) { const int q = nwg / NXCD, r = nwg % NXCD, xcd = wgid % NXCD, off = wgid / NXCD; return (xcd < r ? xcd * (q + 1) : r * (q + 1) + (xcd - r) * q) + off; }

struct StaticOrder {
    int nM, nN, nwg, G, c;
    __device__ void init(int M, int N, int G_, int c_) { nM = M / BM; nN = N / BM; nwg = nM * nN; G = G_; c = c_; }
    __device__ bool next(int i, Unit& u) const {
        const long L = (long)i * G + c; if (L >= nwg) return false;
        int wgid = xcd_remap((int)L, nwg);
        const int nig = WGM * nN, gid = wgid / nig, fm = gid * WGM, gsz = (nM - fm) < WGM ? (nM - fm) : WGM;
        u.pm = fm + ((wgid % nig) % gsz); u.pn = (wgid % nig) / gsz; return true;
    }
    __device__ __forceinline__ void a_ready(const Unit&) const {}
    __device__ __forceinline__ void done(const Unit&) const {}
};
struct InProjOrder {
    StaticOrder so; int G, c;
    __device__ void init(int G_, int c_) { so.init(MX, DIN, G_, c_); G = G_; c = c_; }
    __device__ bool next(int i, Unit& u) const {
        const long L = (long)i * G + c;
        if (L < so.nwg) return so.next(i, u);
        const int j = (int)(L - so.nwg); if (j >= 56) return false;
        u.pm = 128 + (j & 7); u.pn = j >> 3; return true;
    }
    __device__ __forceinline__ void a_ready(const Unit&) const {}
    __device__ __forceinline__ void done(const Unit&) const {}
};
struct ExpertOrder {
    int nPM, nPN, nwg, G, c;
    __device__ void init(int nE, int nPM_, int nPN_, int G_, int c_) { nPM = nPM_; nPN = nPN_; nwg = nE * nPM_ * nPN_; G = G_; c = c_; }
    __device__ bool next(int i, Unit& u) const {
        const long L = (long)i * G + c; if (L >= nwg) return false;
        const int wgid = xcd_remap((int)L, nwg);
        const int per = nPM * nPN, e = wgid / per, r = wgid % per;
        u.pm = e * nPM + (r % nPM); u.pn = e * nPN + (r / nPM); return true;
    }
    __device__ __forceinline__ void a_ready(const Unit&) const {}
    __device__ __forceinline__ void done(const Unit&) const {}
};

struct EpiBf16Plain {
    static constexpr bool PERM = true, AFTER_DRAIN = false;
    bf16_t* O; int ldc;
    __device__ __forceinline__ void operator()(const f32x4 (&acc)[2][2][4][2], const Unit& u, int wr, int wc, int fr, int fq) const {
        const int row0 = u.pm * BM + wr * 64 + fr, col0 = u.pn * BM + wc * 32 + 8 * fq;
#pragma unroll
        for (int ai = 0; ai < 2; ++ai)
#pragma unroll
            for (int m = 0; m < 4; ++m) { bf16_t* rowp = O + (size_t)(row0 + ai * HALF + m * 16) * ldc + col0;
#pragma unroll
                for (int bj = 0; bj < 2; ++bj) { const f32x4 v0 = acc[ai][bj][m][0], v1 = acc[ai][bj][m][1];
                    u32x4 w; w.x = pk2(v0[0], v0[1]); w.y = pk2(v0[2], v0[3]); w.z = pk2(v1[0], v1[1]); w.w = pk2(v1[2], v1[3]);
                    *(u32x4*)(rowp + bj * HALF) = w; } }
    }
};
struct EpiResid {
    static constexpr bool PERM = true, AFTER_DRAIN = false;
    const float* x; bf16_t* X1; const float* mod;
    __device__ __forceinline__ void operator()(const f32x4 (&acc)[2][2][4][2], const Unit& u, int wr, int wc, int fr, int fq) const {
        const int row0 = u.pm * BM + wr * 64 + fr, col0 = u.pn * BM + wc * 32 + 8 * fq;
        const float* g1 = mod + (size_t)(u.pm >> 4) * 6144 + 2048;
        f32x4 gv[2][2];
#pragma unroll
        for (int bj = 0; bj < 2; ++bj)
#pragma unroll
            for (int n = 0; n < 2; ++n) gv[bj][n] = *(const f32x4*)(g1 + col0 + bj * HALF + n * 4);
#pragma unroll
        for (int ai = 0; ai < 2; ++ai) { f32x4 xr[4][2][2];
#pragma unroll
            for (int m = 0; m < 4; ++m) { const size_t off = (size_t)(row0 + ai * HALF + m * 16) * D + col0;
#pragma unroll
                for (int bj = 0; bj < 2; ++bj) { xr[m][bj][0] = *(const f32x4*)(x + off + bj * HALF); xr[m][bj][1] = *(const f32x4*)(x + off + bj * HALF + 4); } }
#pragma unroll
            for (int m = 0; m < 4; ++m) { const size_t off = (size_t)(row0 + ai * HALF + m * 16) * D + col0;
#pragma unroll
                for (int bj = 0; bj < 2; ++bj) { const f32x4 v0 = xr[m][bj][0] + gv[bj][0] * acc[ai][bj][m][0], v1 = xr[m][bj][1] + gv[bj][1] * acc[ai][bj][m][1];
                    u32x4 w; w.x = pk2(v0[0], v0[1]); w.y = pk2(v0[2], v0[3]); w.z = pk2(v1[0], v1[1]); w.w = pk2(v1[2], v1[3]);
                    *(u32x4*)(X1 + off + bj * HALF) = w; } } }
    }
};
struct EpiSwiGLU {
    static constexpr bool PERM = true, AFTER_DRAIN = false;
    unsigned char* H;
    __device__ __forceinline__ void operator()(const f32x4 (&acc)[2][2][4][2], const Unit& u, int wr, int wc, int fr, int fq) const {
        const int row0 = u.pm * BM + wr * 64 + fr, col0 = (u.pn & 7) * 128 + wc * 32 + 8 * fq;
        const __amdgpu_buffer_rsrc_t rsH = __builtin_amdgcn_make_buffer_rsrc((void*)H, 0, 0x80000000u, 0x00020000);
#pragma unroll
        for (int ai = 0; ai < 2; ++ai)
#pragma unroll
            for (int m = 0; m < 4; ++m) { float h[8];
#pragma unroll
                for (int n = 0; n < 2; ++n)
#pragma unroll
                    for (int q = 0; q < 4; ++q) { const float g = acc[ai][0][m][n][q] * WSC, up = acc[ai][1][m][n][q] * WSC; h[n * 4 + q] = g / (1.f + __expf(-g)) * up; }
#if MOE_FP8
                u32x2 w; w.x = pk4_fp8(h[0], h[1], h[2], h[3]); w.y = pk4_fp8(h[4], h[5], h[6], h[7]);
                __builtin_amdgcn_raw_buffer_store_b64(w, rsH, (unsigned)((row0 + ai * HALF + m * 16) * DE + col0), 0, 0); }
#else
                u32x4 w; w.x = pk2(h[0], h[1]); w.y = pk2(h[2], h[3]); w.z = pk2(h[4], h[5]); w.w = pk2(h[6], h[7]);
                *(u32x4*)((bf16_t*)H + (size_t)(row0 + ai * HALF + m * 16) * DE + col0) = w; }
#endif
    }
};
struct EpiDown {
    static constexpr bool PERM = true, AFTER_DRAIN = false;
    bf16_t* O; const float* val; const float* mod;
    __device__ __forceinline__ void operator()(const f32x4 (&acc)[2][2][4][2], const Unit& u, int wr, int wc, int fr, int fq) const {
        const int row0 = u.pm * BM + wr * 64 + fr, col0 = (u.pn & 3) * BM + wc * 32 + 8 * fq;
        const int b = (u.pm & 15) >> 1;
        const unsigned char* mods = sgpr_ptr(mod); const unsigned char* vals_ = sgpr_ptr(val); unsigned char* Os = sgpr_ptr(O);
        f32x4 gv[2][2];
#pragma unroll
        for (int bj = 0; bj < 2; ++bj)
#pragma unroll
            for (int n = 0; n < 2; ++n) gv[bj][n] = *(const f32x4*)(mods + (size_t)(unsigned)((b * 6144 + 5120 + col0 + bj * HALF + n * 4) * 4));
        float vals[2][4];
#pragma unroll
        for (int ai = 0; ai < 2; ++ai)
#pragma unroll
            for (int m = 0; m < 4; ++m) vals[ai][m] = *(const float*)(vals_ + (size_t)(unsigned)((row0 + ai * HALF + m * 16) * 4));
#pragma unroll
        for (int ai = 0; ai < 2; ++ai)
#pragma unroll
#if MOE_FP8
            for (int m = 0; m < 4; ++m) { const int row = row0 + ai * HALF + m * 16; const float vv = vals[ai][m] * 0.25f; unsigned char* rowp = Os + (size_t)(unsigned)(row * D + col0);
#pragma unroll
                for (int bj = 0; bj < 2; ++bj) { const f32x4 v0 = acc[ai][bj][m][0] * gv[bj][0] * vv, v1 = acc[ai][bj][m][1] * gv[bj][1] * vv;
                    u32x2 w; w.x = pk4_fp8(v0[0], v0[1], v0[2], v0[3]); w.y = pk4_fp8(v1[0], v1[1], v1[2], v1[3]);
                    *(u32x2*)(Os + (size_t)(unsigned)(row * D + col0 + bj * HALF)) = w; } }
#else
            for (int m = 0; m < 4; ++m) { const int row = row0 + ai * HALF + m * 16; const float vv = vals[ai][m] * WSC; bf16_t* rowp = (bf16_t*)Os + (size_t)row * D + col0;
#pragma unroll
                for (int bj = 0; bj < 2; ++bj) { const f32x4 v0 = acc[ai][bj][m][0] * gv[bj][0] * vv, v1 = acc[ai][bj][m][1] * gv[bj][1] * vv;
                    u32x4 w; w.x = pk2(v0[0], v0[1]); w.y = pk2(v0[2], v0[3]); w.z = pk2(v1[0], v1[1]); w.w = pk2(v1[2], v1[3]);
                    *(u32x4*)(rowp + bj * HALF) = w; } }
#endif
    }
};

template <class Epi, class Sched, bool ALIGN_EPI = false, bool SP2 = false, bool GATHER = false, bool FP8 = false, int BUF = 0>
__device__ __forceinline__ void gemm_phase(PG8_LAS unsigned char* lds, const Gemm g, const Sched& S, const Epi& E, int wv) {
    const int tid = my_tid(wv), wid = __builtin_amdgcn_readfirstlane(tid >> 6), lane = tid & 63, wr = wid >> 2, wc = wid & 3, fr = lane & 15, fq = lane >> 4;
    const int K = g.K, nt = K / BK;
    unsigned voffA[2], voffB[2]; int gR[2]; unsigned gC[2];
#pragma unroll
    for (int i = 0; i < 2; ++i) { int R, C; stage_rc(tid * 16 + i * 8192, R, C); const int Rb = Epi::PERM ? ((R & ~31) + perm32(R & 31)) : R;
        voffA[i] = (unsigned)(R * K + C) * 2u; voffB[i] = (unsigned)(Rb * K + C) * 2u; gR[i] = R; gC[i] = (unsigned)C * 2u; }
    const __amdgpu_buffer_rsrc_t rsM = __builtin_amdgcn_make_buffer_rsrc((void*)g.rowmap, 0, 0x80000000u, 0x00020000);
    unsigned gAc[2][2], gAn[2][2];
#define PG8_GLOAD(dst, pm_) do { const int _t = my_tid(wv); _Pragma("unroll") for (int _i = 0; _i < 2; ++_i) { int _R, _C; stage_rc(_t * 16 + _i * 8192, _R, _C);     \
        _Pragma("unroll") for (int _h = 0; _h < 2; ++_h) dst[_h][_i] = (unsigned)__builtin_amdgcn_raw_buffer_load_b32(rsM, (unsigned)(((pm_) * BM + _h * HALF + _R) * 4), 0, 0) * (unsigned)(K * 2) + (unsigned)_C * 2u; } } while (0)
    const unsigned kstep = (unsigned)(BK * 2);
    const unsigned hstep = (unsigned)(HALF * K * 2);
    const unsigned tstep = 2u * hstep;
    const unsigned long long uA = ((unsigned long long)(unsigned)__builtin_amdgcn_readfirstlane((int)((unsigned long long)(size_t)g.A >> 32)) << 32) | (unsigned)__builtin_amdgcn_readfirstlane((int)(unsigned)(size_t)g.A);
    const unsigned long long uB = ((unsigned long long)(unsigned)__builtin_amdgcn_readfirstlane((int)((unsigned long long)(size_t)g.Bt >> 32)) << 32) | (unsigned)__builtin_amdgcn_readfirstlane((int)(unsigned)(size_t)g.Bt);
    const __amdgpu_buffer_rsrc_t rsA = __builtin_amdgcn_make_buffer_rsrc((void*)uA, 0, 0x80000000u, 0x00020000);
    const __amdgpu_buffer_rsrc_t rsB = __builtin_amdgcn_make_buffer_rsrc((void*)uB, 0, 0x80000000u, 0x00020000);
    const unsigned ldsw = (unsigned)wid * 1024u;
    const int aoff = lds_byte(wr * 64 + fr, fq * 8), boff = lds_byte(wc * 32 + fr, fq * 8);
#define PG8_SA(b, h) (((b) * 2 + (h)) * HTB)
#define PG8_SB(b, h) ((4 + (b) * 2 + (h)) * HTB)
#define PG8_GLDS(ldsp, v32, gp) asm volatile("s_mov_b32 m0, %0\n\ts_nop 0\n\tglobal_load_lds_dwordx4 %1, %2" :: "s"(__builtin_amdgcn_readfirstlane((int)(size_t)(ldsp))), "v"(v32), "s"(gp) : "memory", "m0")
#define PG8_STAGE(bufoff, goff, voff) do { _Pragma("unroll") for (int _i = 0; _i < 2; ++_i) { \
        if constexpr (BUF == 1 || BUF == 3) __builtin_amdgcn_raw_ptr_buffer_load_lds(rsB, (PG8_LAS void*)(lds + (bufoff) + ldsw + _i * 8192), 16, (voff)[_i], (goff), 0, 0); \
        else if constexpr (BUF == 2) PG8_GLDS(lds + (bufoff) + ldsw + _i * 8192, (voff)[_i] + (unsigned)__builtin_amdgcn_readfirstlane((int)(goff)), (const char*)uB); \
        else __builtin_amdgcn_global_load_lds((const unsigned*)((const char*)g.Bt + (size_t)((goff) + (voff)[_i])), (PG8_LAS unsigned*)(lds + (bufoff) + ldsw + _i * 8192), 16, 0, 0); } } while (0)
#define PG8_STA(bufoff, koff, h, nx) do { _Pragma("unroll") for (int _i = 0; _i < 2; ++_i) { \
        const unsigned _v = GATHER ? ((nx) ? gAn[h][_i] : gAc[h][_i]) : voffA[_i]; const unsigned _s = GATHER ? (koff) : (koff) + (unsigned)(h) * hstep; \
        if constexpr (BUF == 1) __builtin_amdgcn_raw_ptr_buffer_load_lds(rsA, (PG8_LAS void*)(lds + (bufoff) + ldsw + _i * 8192), 16, _v, _s, 0, 0); \
        else if constexpr (BUF == 2 || BUF == 3) PG8_GLDS(lds + (bufoff) + ldsw + _i * 8192, _v + (unsigned)__builtin_amdgcn_readfirstlane((int)_s), (const char*)uA); \
        else __builtin_amdgcn_global_load_lds((const unsigned*)((const char*)g.A + (size_t)(_s + _v)), (PG8_LAS unsigned*)(lds + (bufoff) + ldsw + _i * 8192), 16, 0, 0); } } while (0)
#define PG8_LDA(dst, b, h) do { _Pragma("unroll") for (int m = 0; m < 4; ++m) _Pragma("unroll") for (int k = 0; k < 2; ++k) dst[m][k] = *(const PG8_LAS bf16x8*)(lds + PG8_SA(b, h) + aoff + m * 2048 + k * 1024); } while (0)
#define PG8_LDB(dst, b, h) do { _Pragma("unroll") for (int n = 0; n < 2; ++n) _Pragma("unroll") for (int k = 0; k < 2; ++k) dst[n][k] = *(const PG8_LAS bf16x8*)(lds + PG8_SB(b, h) + boff + n * 2048 + k * 1024); } while (0)
#define PG8_CAT(f) __builtin_shufflevector(__builtin_bit_cast(i32x4, (f)[0]), __builtin_bit_cast(i32x4, (f)[1]), 0, 1, 2, 3, 4, 5, 6, 7)
#define PG8_MMA(ai, bj, At, Bt) do { __builtin_amdgcn_s_setprio(1); \
        if constexpr (FP8) { _Pragma("unroll") for (int m = 0; m < 4; ++m) _Pragma("unroll") for (int n = 0; n < 2; ++n) \
            acc[ai][bj][m][n] = __builtin_amdgcn_mfma_scale_f32_16x16x128_f8f6f4(PG8_CAT(Bt[n]), PG8_CAT(At[m]), acc[ai][bj][m][n], 0, 0, 0, 0, 0, 0); } \
        else { _Pragma("unroll") for (int m = 0; m < 4; ++m) _Pragma("unroll") for (int n = 0; n < 2; ++n) _Pragma("unroll") for (int k = 0; k < 2; ++k) \
            acc[ai][bj][m][n] = __builtin_amdgcn_mfma_f32_16x16x32_bf16(Bt[n][k], At[m][k], acc[ai][bj][m][n], 0, 0, 0); } \
        __builtin_amdgcn_s_setprio(0); } while (0)
#define PG8_WAIT_V(n) asm volatile("s_waitcnt vmcnt(" #n ")" ::: "memory")
#define PG8_WAIT_L(n) asm volatile("s_waitcnt lgkmcnt(" #n ")" ::: "memory")
#define PG8_BAR __builtin_amdgcn_s_barrier()
#define PG8_SCHED __builtin_amdgcn_sched_barrier(0)
    Unit cur, nxt; int ui = 0;
    if (!S.next(0, cur)) return;
    f32x4 acc[2][2][4][2];
#pragma unroll
    for (int a = 0; a < 2; ++a)
#pragma unroll
        for (int b = 0; b < 2; ++b)
#pragma unroll
            for (int m = 0; m < 4; ++m)
#pragma unroll
                for (int n = 0; n < 2; ++n) { acc[a][b][m][n] = (f32x4){0.f, 0.f, 0.f, 0.f}; if constexpr (FP8) asm volatile("" : "+v"(acc[a][b][m][n])); }
    bf16x8 At[4][2], B0[2][2], B1[2][2];
    unsigned cA = GATHER ? 0u : (unsigned)cur.pm * tstep, cB = (unsigned)cur.pn * tstep;
    if constexpr (GATHER) { PG8_GLOAD(gAc, cur.pm); }
    S.a_ready(cur);
    if constexpr (SP2) {
        PG8_STAGE(PG8_SB(0, 0), cB, voffB); PG8_STAGE(PG8_SB(0, 1), cB + hstep, voffB); PG8_STA(PG8_SA(0, 0), cA, 0, false); PG8_STA(PG8_SA(0, 1), cA, 1, false);
        if (wr == 1) PG8_BAR;
        PG8_WAIT_V(2); PG8_BAR;
        PG8_STAGE(PG8_SB(1, 0), cB + kstep, voffB); PG8_STA(PG8_SA(1, 0), cA + kstep, 0, false); PG8_STAGE(PG8_SB(1, 1), cB + hstep + kstep, voffB);
        PG8_WAIT_V(6); PG8_BAR;
    } else {
        PG8_STAGE(PG8_SB(0, 0), cB, voffB); PG8_STA(PG8_SA(0, 0), cA, 0, false); PG8_STAGE(PG8_SB(0, 1), cB + hstep, voffB); PG8_STA(PG8_SA(0, 1), cA, 1, false);
        if (wr == 1) PG8_BAR;
        PG8_WAIT_V(4); PG8_BAR;
        PG8_STAGE(PG8_SB(1, 0), cB + kstep, voffB); PG8_STA(PG8_SA(1, 0), cA + kstep, 0, false); PG8_STAGE(PG8_SB(1, 1), cB + hstep + kstep, voffB);
        PG8_WAIT_V(6); PG8_BAR;
    }
    for (;;) {
        const bool has_next = S.next(ui + 1, nxt);
        const unsigned nA = GATHER ? cA : (has_next ? (unsigned)nxt.pm * tstep : cA), nB = has_next ? (unsigned)nxt.pn * tstep : cB;
        if constexpr (GATHER) { if (has_next) { PG8_GLOAD(gAn, nxt.pm); } else {
#pragma unroll
            for (int _h = 0; _h < 2; ++_h)
#pragma unroll
                for (int _i = 0; _i < 2; ++_i) gAn[_h][_i] = gAc[_h][_i]; } }
#pragma unroll 1
        for (int t = 0; t < nt; t += 2) {
            const bool last = (t == nt - 2);
            const unsigned a1 = cA + (unsigned)(t + 1) * kstep;
            const unsigned a2 = last ? nA : cA + (unsigned)(t + 2) * kstep, b2 = last ? nB : cB + (unsigned)(t + 2) * kstep;
            const unsigned a3 = a2 + kstep, b3 = b2 + kstep;
            if (last && has_next) S.a_ready(nxt);
            if constexpr (SP2) {
            PG8_LDB(B0, 0, 0); PG8_LDB(B1, 0, 1); PG8_SCHED; PG8_LDA(At, 0, 0); PG8_STA(PG8_SA(1, 1), a1, 1, false);
            PG8_WAIT_V(8); PG8_WAIT_L(0); PG8_BAR; PG8_MMA(0, 0, At, B0); PG8_MMA(0, 1, At, B1); PG8_BAR; PG8_SCHED;
            PG8_LDA(At, 0, 1); PG8_STAGE(PG8_SB(0, 0), b2, voffB); PG8_STAGE(PG8_SB(0, 1), b2 + hstep, voffB); PG8_STA(PG8_SA(0, 0), a2, 0, last);
            PG8_WAIT_V(8); PG8_WAIT_L(0); PG8_BAR; PG8_MMA(1, 0, At, B0); PG8_MMA(1, 1, At, B1); PG8_BAR; PG8_SCHED;
            PG8_LDB(B0, 1, 0); PG8_LDB(B1, 1, 1); PG8_SCHED; PG8_LDA(At, 1, 0); PG8_STA(PG8_SA(0, 1), a2, 1, last);
            PG8_WAIT_V(8); PG8_WAIT_L(0); PG8_BAR; PG8_MMA(0, 0, At, B0); PG8_MMA(0, 1, At, B1); PG8_BAR; PG8_SCHED;
            PG8_LDA(At, 1, 1); PG8_STAGE(PG8_SB(1, 0), b3, voffB); PG8_STAGE(PG8_SB(1, 1), b3 + hstep, voffB); PG8_STA(PG8_SA(1, 0), a3, 0, last);
            PG8_WAIT_V(8); PG8_WAIT_L(0); PG8_BAR; PG8_MMA(1, 0, At, B0); PG8_MMA(1, 1, At, B1); PG8_BAR; PG8_SCHED;
            } else {
            PG8_LDB(B0, 0, 0); PG8_SCHED; PG8_LDA(At, 0, 0); PG8_STA(PG8_SA(1, 1), a1, 1, false);
            PG8_WAIT_L(8); PG8_BAR; PG8_WAIT_L(0); PG8_MMA(0, 0, At, B0); PG8_BAR; PG8_SCHED;
            PG8_LDB(B1, 0, 1); PG8_STAGE(PG8_SB(0, 0), b2, voffB);
            PG8_BAR; PG8_WAIT_L(0); PG8_MMA(0, 1, At, B1); PG8_BAR;
            PG8_LDA(At, 0, 1); PG8_STA(PG8_SA(0, 0), a2, 0, last);
            PG8_BAR; PG8_WAIT_L(0); PG8_MMA(1, 0, At, B0); PG8_BAR; PG8_SCHED;
            PG8_STAGE(PG8_SB(0, 1), b2 + hstep, voffB);
            PG8_WAIT_V(6); PG8_BAR; PG8_MMA(1, 1, At, B1); PG8_BAR;
            PG8_LDB(B0, 1, 0); PG8_SCHED; PG8_LDA(At, 1, 0); PG8_STA(PG8_SA(0, 1), a2, 1, last);
            PG8_WAIT_L(8); PG8_BAR; PG8_WAIT_L(0); PG8_MMA(0, 0, At, B0); PG8_BAR; PG8_SCHED;
            PG8_LDB(B1, 1, 1); PG8_STAGE(PG8_SB(1, 0), b3, voffB);
            PG8_BAR; PG8_WAIT_L(0); PG8_MMA(0, 1, At, B1); PG8_BAR;
            PG8_LDA(At, 1, 1); PG8_STA(PG8_SA(1, 0), a3, 0, last);
            PG8_BAR; PG8_WAIT_L(0); PG8_MMA(1, 0, At, B0); PG8_BAR; PG8_SCHED;
            PG8_STAGE(PG8_SB(1, 1), b3 + hstep, voffB);
            PG8_WAIT_V(6); PG8_BAR; PG8_MMA(1, 1, At, B1); PG8_BAR;
            }
        }
        if constexpr (ALIGN_EPI) { if (wr == 0) PG8_BAR; }
        if constexpr (!Epi::AFTER_DRAIN) { const int _l = my_tid(wv) & 63; E(acc, cur, wr, wc, _l & 15, _l >> 4); S.done(cur); }
        if (!has_next) break;
#pragma unroll
        for (int a = 0; a < 2; ++a)
#pragma unroll
            for (int b = 0; b < 2; ++b)
#pragma unroll
                for (int m = 0; m < 4; ++m)
#pragma unroll
                    for (int n = 0; n < 2; ++n) { acc[a][b][m][n] = (f32x4){0.f, 0.f, 0.f, 0.f}; if constexpr (FP8) asm volatile("" : "+v"(acc[a][b][m][n])); }
        cur = nxt; cA = nA; cB = nB; ++ui;
        if constexpr (GATHER) {
#pragma unroll
            for (int _h = 0; _h < 2; ++_h)
#pragma unroll
                for (int _i = 0; _i < 2; ++_i) gAc[_h][_i] = gAn[_h][_i]; }
        if constexpr (ALIGN_EPI) { if (wr == 1) PG8_BAR; }
    }
    PG8_WAIT_V(0);
    if constexpr (!ALIGN_EPI) { if (wr == 0) PG8_BAR; }
    PG8_BAR;
#undef PG8_SA
#undef PG8_SB
#undef PG8_STAGE
#undef PG8_STA
#undef PG8_GLDS
#undef PG8_GLOAD
#undef PG8_LDA
#undef PG8_LDB
#undef PG8_MMA
#undef PG8_CAT
#undef PG8_WAIT_V
#undef PG8_WAIT_L
#undef PG8_BAR
#undef PG8_SCHED
}
}

#define LDS_WAIT() asm volatile("s_waitcnt lgkmcnt(0)" ::: "memory")
#define LBAR() do { asm volatile("s_waitcnt lgkmcnt(0)" ::: "memory"); __builtin_amdgcn_s_barrier(); asm volatile("" ::: "memory"); } while (0)

__device__ __forceinline__ void cvt_item(const float* W, int K, int N, bf16_t* WT, int mode, int item, int lane) {
    const int nblk = N / 64, kb = item / nblk, nb = item % nblk, k0 = 64 * kb, n0 = 64 * nb;
    const int rbase = mode == 0 ? n0 : ((n0 >> 7) * 256 + (n0 & 127) + (mode == 2 ? 128 : 0));
    const int r = lane >> 4, c4 = lane & 15;
    const float* src = W + (size_t)(k0 + 16 * r) * N + n0 + 4 * c4;
    f32x4 v[16];
#pragma unroll
    for (int i = 0; i < 16; ++i) v[i] = *(const f32x4*)(src + (size_t)i * N);
    bf16_t* dst = WT + (size_t)(rbase + 4 * c4) * K + k0 + 16 * r;
#pragma unroll
    for (int q = 0; q < 4; ++q)
#pragma unroll
        for (int hh = 0; hh < 2; ++hh) { u32x4 o;
            o.x = pk2(v[8 * hh + 0][q], v[8 * hh + 1][q]); o.y = pk2(v[8 * hh + 2][q], v[8 * hh + 3][q]); o.z = pk2(v[8 * hh + 4][q], v[8 * hh + 5][q]); o.w = pk2(v[8 * hh + 6][q], v[8 * hh + 7][q]);
            *(u32x4*)(dst + (size_t)q * K + 8 * hh) = o; }
}

__device__ __forceinline__ void phase0(const Params& p, LAS unsigned char* lds, int bid, int G, int wv) {
    const int tid = my_tid(wv), lane = tid & 63, wave = tid >> 6;
    unsigned char* ws = p.ws;
    if (bid < 192) {
        LAS float* sc = (LAS float*)lds;
        LAS float* part = sc + 9 * 1024;
        const float* c = p.in[1]; const float* cctx = p.in[3]; const float* ada_w = p.in[4]; const float* ada_b = p.in[5];
        float* MOD = (float*)(ws + WS_MOD);
        for (int i = tid; i < 9 * 1024; i += NTHR) { const int r = i >> 10, k = i & 1023; const float v = r < 8 ? c[r * 1024 + k] : cctx[k]; sc[i] = v / (1.f + expf(-v)); }
        __syncthreads();
        for (int it = bid; it < 192; it += G) {
            const int col = tid & 31, kg = tid >> 5;
            float acc[9];
#pragma unroll
            for (int r = 0; r < 9; ++r) acc[r] = 0.f;
            const float* w = ada_w + (size_t)(kg * 64) * 6144 + it * 32 + col;
#pragma unroll 16
            for (int k = 0; k < 64; ++k) { const float wv = w[(size_t)k * 6144];
#pragma unroll
                for (int r = 0; r < 9; ++r) acc[r] += sc[r * 1024 + kg * 64 + k] * wv; }
#pragma unroll
            for (int r = 0; r < 9; ++r) part[(kg * 9 + r) * 32 + col] = acc[r];
            __syncthreads();
            for (int o = tid; o < 288; o += NTHR) { const int r = o >> 5, cc = o & 31; float s_ = ada_b[it * 32 + cc];
#pragma unroll
                for (int q = 0; q < 16; ++q) s_ += part[(q * 9 + r) * 32 + cc];
                MOD[r * 6144 + it * 32 + cc] = s_; }
            __syncthreads();
        }
    }
    {
        const int gw = bid * NWAVES + wave, NGW = G * NWAVES;
        constexpr int I_IN = 16 * (DIN / 64), I_OUT = 16 * 16;
        for (int it = gw; it < I_IN + I_OUT; it += NGW) {
            if (it < I_IN) cvt_item(p.in[8], D, DIN, (bf16_t*)(ws + WS_WINT), 0, it, lane);
            else cvt_item(p.in[21], D, D, (bf16_t*)(ws + WS_WOUTT), 0, it - I_IN, lane);
        }
    }
}
constexpr size_t OUT_W2T = (MOE_FP8 ? 32 : 64) * MiB;
__device__ __forceinline__ void xcvt_load(const Params& p, int g, int lane, f32x4 (&v)[8]) {
    const int which = g >> 13, r = g & 8191, e = r >> 9, kb = (r >> 4) & 31, nb = r & 15;
    const float* W = which == 0 ? p.in[23] : (which == 1 ? p.in[24] : p.in[25]);
    const __amdgpu_buffer_rsrc_t rs = __builtin_amdgcn_make_buffer_rsrc((void*)W, 0, 64 << 20, 0x00020000);
    const unsigned vo = (unsigned)(((lane >> 4) * 8 * 1024 + (lane & 15) * 4) * 4);
    const unsigned so = (unsigned)(((e * 1024 + kb * 32) * 1024 + nb * 64) * 4);
#pragma unroll
    for (int i = 0; i < 8; ++i) v[i] = __builtin_bit_cast(f32x4, __builtin_amdgcn_raw_buffer_load_b128(rs, vo, so + (unsigned)i * 4096u, 0));
}
__device__ __forceinline__ void xcvt_store(const Params& p, int g, int lane, const f32x4 (&v)[8]) {
    const int which = g >> 13, r = g & 8191, e = r >> 9, kb = (r >> 4) & 31, nb = r & 15, n0 = nb * 64;
    const int rbase = which == 2 ? n0 : ((n0 >> 7) * 256 + (n0 & 127) + (which == 1 ? 128 : 0));
#if MOE_FP8
    const unsigned so = which == 2 ? (unsigned)OUT_W2T + (unsigned)((e * 1024 + rbase) * 1024 + kb * 32) : (unsigned)((e * 2048 + rbase) * 1024 + kb * 32);
    const __amdgpu_buffer_rsrc_t rs = __builtin_amdgcn_make_buffer_rsrc((void*)p.out, 0, 48 << 20, 0x00020000);
    const unsigned vo = (unsigned)((lane & 15) * 4 * 1024 + (lane >> 4) * 8);
#pragma unroll
    for (int q = 0; q < 4; ++q) { u32x2 o;
        o.x = pk4_fp8_raw(v[0][q] * W8_SCALE, v[1][q] * W8_SCALE, v[2][q] * W8_SCALE, v[3][q] * W8_SCALE); o.y = pk4_fp8_raw(v[4][q] * W8_SCALE, v[5][q] * W8_SCALE, v[6][q] * W8_SCALE, v[7][q] * W8_SCALE);
        __builtin_amdgcn_raw_buffer_store_b64(o, rs, vo, so + (unsigned)q * 1024u, 0); }
#else
    const unsigned so = which == 2 ? (unsigned)OUT_W2T + (unsigned)(((e * 1024 + rbase) * 1024 + kb * 32) * 2) : (unsigned)(((e * 2048 + rbase) * 1024 + kb * 32) * 2);
    const __amdgpu_buffer_rsrc_t rs = __builtin_amdgcn_make_buffer_rsrc((void*)p.out, 0, 96 << 20, 0x00020000);
    const unsigned vo = (unsigned)(((lane & 15) * 4 * 1024 + (lane >> 4) * 8) * 2);
#pragma unroll
    for (int q = 0; q < 4; ++q) { u32x4 o;
        o.x = pk2(v[0][q], v[1][q]); o.y = pk2(v[2][q], v[3][q]); o.z = pk2(v[4][q], v[5][q]); o.w = pk2(v[6][q], v[7][q]);
        __builtin_amdgcn_raw_buffer_store_b128(o, rs, vo, so + (unsigned)q * 2048u, 0); }
#endif
}

__device__ __forceinline__ void phase1(const Params& p, int bid, int G, int wv) {
    const int tid = my_tid(wv), lane = tid & 63, wave = tid >> 6;
    const int gw = bid * NWAVES + wave, NGW = G * NWAVES;
    const float* MOD = (const float*)(p.ws + WS_MOD); const float* n1g = p.in[6];
    bf16_t* XN = (bf16_t*)(p.ws + WS_XN);
    f32x4 g[4];
#pragma unroll
    for (int j = 0; j < 4; ++j) g[j] = *(const f32x4*)(n1g + 4 * (lane + 64 * j));
    for (int m0 = gw; m0 < MALL; m0 += 2 * NGW) {
        f32x4 v[2][4]; float ss[2]; int mrow[2];
#pragma unroll
        for (int tk = 0; tk < 2; ++tk) { const int m = m0 + tk * NGW < MALL ? m0 + tk * NGW : m0;
            const float* src = m < MX ? p.in[0] + (size_t)m * D : p.in[2] + (size_t)(m - MX) * D; mrow[tk] = m;
            ss[tk] = 0.f;
#pragma unroll
            for (int j = 0; j < 4; ++j) { v[tk][j] = ((const f32x4*)src)[lane + 64 * j]; ss[tk] += (v[tk][j].x * v[tk][j].x + v[tk][j].y * v[tk][j].y) + (v[tk][j].z * v[tk][j].z + v[tk][j].w * v[tk][j].w); } }
#pragma unroll
        for (int tk = 0; tk < 2; ++tk) { const int m = mrow[tk], mr = m < MX ? (m >> 12) : 8;
            const float* sh = MOD + (size_t)mr * 6144; const float* scp = sh + 1024;
            const float rstd = rsqrtf(wave_sum(ss[tk]) * (1.f / D) + 1e-6f);
#pragma unroll
            for (int j = 0; j < 4; ++j) { const int col = 4 * (lane + 64 * j);
                const f32x4 s_ = *(const f32x4*)(scp + col), h = *(const f32x4*)(sh + col);
                const f32x4 y = v[tk][j] * rstd * g[j] * (s_ + 1.f) + h;
                u32x2 o; o.x = pk2(y.x, y.y); o.y = pk2(y.z, y.w);
                *(u32x2*)(XN + (size_t)m * D + col) = o; } }
    }
}

struct Px5 { u32x4 s, n0, n1, n2, n3; };
__device__ __forceinline__ Px5 px_load(const bf16_t* PX, int row, const int (&nbr)[4], int cb) {
    const __amdgpu_buffer_rsrc_t rs = __builtin_amdgcn_make_buffer_rsrc((void*)PX, 0, MALL * DIN * 2, 0x00020000);
    const unsigned cbb = (unsigned)cb * 2u, OOB = 0xFFFFF000u;
    Px5 q;
    q.s = __builtin_bit_cast(u32x4, __builtin_amdgcn_raw_buffer_load_b128(rs, (unsigned)row * (DIN * 2) + cbb, 0, 0));
    q.n0 = __builtin_bit_cast(u32x4, __builtin_amdgcn_raw_buffer_load_b128(rs, nbr[0] >= 0 ? (unsigned)nbr[0] * (DIN * 2) + cbb : OOB, 0, 0));
    q.n1 = __builtin_bit_cast(u32x4, __builtin_amdgcn_raw_buffer_load_b128(rs, nbr[1] >= 0 ? (unsigned)nbr[1] * (DIN * 2) + cbb : OOB, 0, 0));
    q.n2 = __builtin_bit_cast(u32x4, __builtin_amdgcn_raw_buffer_load_b128(rs, nbr[2] >= 0 ? (unsigned)nbr[2] * (DIN * 2) + cbb : OOB, 0, 0));
    q.n3 = __builtin_bit_cast(u32x4, __builtin_amdgcn_raw_buffer_load_b128(rs, nbr[3] >= 0 ? (unsigned)nbr[3] * (DIN * 2) + cbb : OOB, 0, 0));
    return q; }
__device__ __forceinline__ void px_lerp(const Px5& q, bool isctx, int cb, const float* mu, float (&out)[8]) {
    u32x4 sh;
    if (isctx) { sh.x = (q.n0.x & 0xffffu) | (q.n1.x & 0xffff0000u); sh.y = (q.n0.y & 0xffffu) | (q.n1.y & 0xffff0000u); sh.z = (q.n0.z & 0xffffu) | (q.n1.z & 0xffff0000u); sh.w = (q.n0.w & 0xffffu) | (q.n1.w & 0xffff0000u); }
    else { sh.x = (q.n0.x & 0xffffu) | (q.n1.x & 0xffff0000u); sh.y = (q.n2.y & 0xffffu) | (q.n3.y & 0xffff0000u); sh.z = (q.n0.z & 0xffffu) | (q.n1.z & 0xffff0000u); sh.w = (q.n2.w & 0xffffu) | (q.n3.w & 0xffff0000u); }
    float s[8], sv[8];
    unpack8(q.s, s); unpack8(sh, sv);
    const f32x4 m0 = *(const f32x4*)(mu + cb), m1 = *(const f32x4*)(mu + cb + 4);
    const float mv[8] = {m0.x, m0.y, m0.z, m0.w, m1.x, m1.y, m1.z, m1.w};
#pragma unroll
    for (int e = 0; e < 8; ++e) out[e] = s[e] + mv[e] * (sv[e] - s[e]);
}
__device__ __forceinline__ void neighbours(int t, bool isctx, int rowbase, int (&nbr)[4]) {
    if (isctx) { nbr[0] = t > 0 ? rowbase + t - 1 : -1; nbr[1] = t < CTXL - 1 ? rowbase + t + 1 : -1; nbr[2] = -1; nbr[3] = -1; }
    else { const int cg_ = t & 63, rg = t >> 6;
        nbr[0] = cg_ > 0 ? rowbase + t - 1 : -1; nbr[1] = cg_ < 63 ? rowbase + t + 1 : -1; nbr[2] = rg > 0 ? rowbase + t - 64 : -1; nbr[3] = rg < 63 ? rowbase + t + 64 : -1; }
}

typedef short s16x4 __attribute__((ext_vector_type(4)));
constexpr int RS = 128;
constexpr int IMG = 64 * RS;
__device__ __forceinline__ int ioff(int row, int col) { return row * RS + ((col * 2) ^ (((row & 2) | ((row >> 1) & 4)) << 4)); }
constexpr int I_AT = 0, I_BT = IMG, I_KT = 2 * IMG, I_RT = 3 * IMG, I_BH = 4 * IMG, I_KH = 5 * IMG, I_VV = 6 * IMG;
constexpr int I_LBT = 7 * IMG, I_LAK = 8 * IMG, I_PRB = 9 * IMG, I_PRK = 10 * IMG, I_TM = 11 * IMG, I_Q = 12 * IMG;
constexpr int I_E = 13 * IMG;
constexpr int I_LT = 13 * IMG + 4608;
constexpr int I_WUP = I_LT + 17408, I_AUP = I_WUP + IMG;
constexpr int I_PAR = I_AUP + IMG;
constexpr int I_VV2 = I_PAR + 1280;
constexpr int X_END = I_VV2 + IMG;
constexpr int I_W1 = I_LBT, I_W2 = I_LAK;
constexpr int I_XW = I_Q, I_XA = I_TM;
constexpr int I_DW = I_AT, I_DA = I_LT;
constexpr int I_G = I_PRB, I_GT = I_E;
static_assert(I_DW + 17408 <= I_RT && I_PRK == I_PRB + IMG && X_END + 64 <= LDS_BYTES && X_END == LDS_MISC, "scan LDS map");

__device__ __forceinline__ bf16x8 frag_rm(const LAS unsigned char* img, int row0, int k0, int lane) {
    return *(const LAS bf16x8*)(img + ioff(row0 + (lane & 15), k0 + 8 * (lane >> 4))); }
__device__ __forceinline__ bf16x8 frag_tr(const LAS unsigned char* img, int k0, int col0, int lane) {
    LAS unsigned char* a = (LAS unsigned char*)img + ioff(k0 + 8 * (lane >> 4) + ((lane & 15) >> 2), col0 + 4 * (lane & 3));
    const s16x4 lo = __builtin_amdgcn_ds_read_tr16_b64_v4i16((LAS s16x4*)a);
    const s16x4 hi = __builtin_amdgcn_ds_read_tr16_b64_v4i16((LAS s16x4*)(a + 4 * RS));
    return __builtin_shufflevector(lo, hi, 0, 1, 2, 3, 4, 5, 6, 7); }
#define MFMA16(a, b, c) __builtin_amdgcn_mfma_f32_16x16x32_bf16((a), (b), (c), 0, 0, 0)
__device__ __forceinline__ void st_img(LAS unsigned char* img, int n0, int m0, int lane, const f32x4 v) {
    u32x2 w; w.x = pk2(v[0], v[1]); w.y = pk2(v[2], v[3]);
    *(LAS u32x2*)(img + ioff(n0 + (lane & 15), m0 + 4 * (lane >> 4))) = w; }
__device__ __forceinline__ f32x4 up4(const u32x2 w) { return (f32x4){bflo(w.x), bfhi(w.x), bflo(w.y), bfhi(w.y)}; }

__device__ __forceinline__ void phase_scanX(const Params& p, LAS unsigned char* lds, int bid, int G, int wv) {
    const int tid_ = my_tid(wv), lane_ = tid_ & 63, wave = __builtin_amdgcn_readfirstlane(tid_ >> 6);
    const bf16_t* PX = (const bf16_t*)(p.ws + WS_PX);
    const float* mu = p.in[9];
    const f32x4 fz = (f32x4){0.f, 0.f, 0.f, 0.f};
    for (int it_ = bid; it_ < NB * NH * 2 * 2; it_ += G) {
        const int item = (G == 256) ? ((it_ & 7) * 32 + (it_ >> 3)) : it_;
        const int bhd = item >> 1, dir = bhd & 1, h = (bhd >> 1) & 7, b = bhd >> 4;
        LBAR();
        { const int tid = opq(tid_), j = tid >> 3, k0 = (tid & 7) * 8;
          const float* wu = p.in[11] + (size_t)dir * 64 * DR + (size_t)j * DR + h * 64 + k0; const float* au = p.in[13] + (size_t)dir * 64 * DR + (size_t)j * DR + h * 64 + k0;
          const f32x4 w0 = *(const f32x4*)wu, w1 = *(const f32x4*)(wu + 4), a0 = *(const f32x4*)au, a1 = *(const f32x4*)(au + 4);
          const float wf[8] = {w0.x, w0.y, w0.z, w0.w, w1.x, w1.y, w1.z, w1.w}, af[8] = {a0.x, a0.y, a0.z, a0.w, a1.x, a1.y, a1.z, a1.w};
          *(LAS u32x4*)(lds + I_WUP + ioff(j, k0)) = pack8(wf); *(LAS u32x4*)(lds + I_AUP + ioff(j, k0)) = pack8(af); }
        { const int k0_ = (opq(tid_) & 7) * 8, hc_ = h * 64 + k0_; LAS float* PARw = (LAS float*)(lds + I_PAR) + k0_;
#pragma unroll
          for (int e = 0; e < 8; ++e) { PARw[e] = p.in[10][dir * DR + hc_ + e]; PARw[64 + e] = p.in[12][dir * DR + hc_ + e]; PARw[128 + e] = p.in[14][hc_ + e]; PARw[192 + e] = p.in[15][hc_ + e]; PARw[256 + e] = p.in[16][hc_ + e]; } }
#define XCI(cc_) ((item & 1) * 34 + 33 - (cc_))
#define X_PXLOAD(ci_) do { const int tid__ = opq(tid_), j__ = tid__ >> 3, k0__ = (tid__ & 7) * 8; const int ci__ = (ci_); const bool ctx__ = ci__ < 4; const int c__ = ctx__ ? ci__ : ci__ - 4; \
            const int L__ = ctx__ ? CTXL : T, rb__ = ctx__ ? MX + b * CTXL : b * T, pos__ = 64 * c__ + j__, t__ = dir ? (L__ - 1 - pos__) : pos__; \
            int nbr__[4]; neighbours(t__, ctx__, rb__, nbr__); \
            qv = px_load(PX, rb__ + t__, nbr__, 1024 + h * 64 + k0__); qw = px_load(PX, rb__ + t__, nbr__, 1536 + k0__); qa = px_load(PX, rb__ + t__, nbr__, 1600 + k0__); \
            qr = px_load(PX, rb__ + t__, nbr__, h * 64 + k0__); qk = px_load(PX, rb__ + t__, nbr__, 512 + h * 64 + k0__); } while (0)
#define X_LERP(ci_, par_, rd_, kd_) do { const int tid__ = opq(tid_), j__ = tid__ >> 3, k0__ = (tid__ & 7) * 8; const bool ctx__ = (ci_) < 4; \
            { float v__[8]; px_lerp(qv, ctx__, 1024 + h * 64 + k0__, mu, v__); *(LAS u32x4*)(lds + ((par_) ? I_VV2 : I_VV) + ioff(j__, k0__)) = pack8(v__); } \
            { float xw__[8]; px_lerp(qw, ctx__, 1536 + k0__, mu, xw__); \
              _Pragma("unroll") for (int e = 0; e < 8; ++e) xw__[e] = ftanh(xw__[e]); \
              *(LAS u32x4*)(lds + I_XW + ioff(j__, k0__)) = pack8(xw__); } \
            { float xa__[8]; px_lerp(qa, ctx__, 1600 + k0__, mu, xa__); *(LAS u32x4*)(lds + I_XA + ioff(j__, k0__)) = pack8(xa__); } \
            px_lerp(qr, ctx__, h * 64 + k0__, mu, rd_); px_lerp(qk, ctx__, 512 + h * 64 + k0__, mu, kd_); } while (0)
#define X_LORA() do { const int lane = opq(lane_); const int pr = wave >> 2, nt = wave & 3; \
            const LAS unsigned char* Ximg = lds + (pr ? I_XA : I_XW); const LAS unsigned char* Wimg = lds + (pr ? I_AUP : I_WUP); \
            LAS float* Dout = (LAS float*)(lds + (pr ? I_DA : I_DW)); \
            const bf16x8 b0 = frag_rm(Ximg, 16 * nt, 0, lane), b1 = frag_rm(Ximg, 16 * nt, 32, lane); \
            bf16x8 wa[4][2]; \
            _Pragma("unroll") for (int mt = 0; mt < 4; ++mt) { wa[mt][0] = frag_tr(Wimg, 0, 16 * mt, lane); wa[mt][1] = frag_tr(Wimg, 32, 16 * mt, lane); } \
            _Pragma("unroll") for (int mt = 0; mt < 4; ++mt) { const f32x4 acc = MFMA16(wa[mt][1], b1, MFMA16(wa[mt][0], b0, fz)); \
                *(LAS f32x4*)(Dout + (16 * nt + (lane & 15)) * 68 + 16 * mt + 4 * (lane >> 4)) = acc; } } while (0)
        float r[8], k[8];
#if XSCOPE
        { Px5 qv, qw, qa, qr, qk; X_PXLOAD(XCI(0));
          X_LERP(XCI(0), 0, r, k); }
#else
        Px5 qv, qw, qa, qr, qk;
        X_PXLOAD(XCI(0));
        X_LERP(XCI(0), 0, r, k);
#endif
        LBAR();
        X_LORA();
        for (int cc = 0; cc < 34; ++cc) {
            const int tid = opq(tid_), j = tid >> 3, sub = tid & 7, k0 = sub * 8;
#if XSCOPE
            Px5 qv, qw, qa, qr, qk;
#endif
            const int ci = XCI(cc);
            const bool isctx = ci < 4; const int c = isctx ? ci : ci - 4;
            const int u = bhd * 68 + ci;
            const int L = isctx ? CTXL : T, rowbase = isctx ? MX + b * CTXL : b * T;
            const int pos = 64 * c + j, t = dir ? (L - 1 - pos) : pos;
            const LAS unsigned char* vvimg = lds + ((cc & 1) ? I_VV2 : I_VV);
            LBAR();
            if (cc + 1 < 34) X_PXLOAD(XCI(cc + 1));
            float kkn[8], ab[8], kd[8];
            { const LAS float* DW = (const LAS float*)(lds + I_DW) + j * 68 + k0; const LAS float* DA = (const LAS float*)(lds + I_DA) + j * 68 + k0;
              const f32x4 d0 = *(const LAS f32x4*)DW, d1 = *(const LAS f32x4*)(DW + 4), e0 = *(const LAS f32x4*)DA, e1 = *(const LAS f32x4*)(DA + 4);
              const float dw[8] = {d0.x, d0.y, d0.z, d0.w, d1.x, d1.y, d1.z, d1.w}, da[8] = {e0.x, e0.y, e0.z, e0.w, e1.x, e1.y, e1.z, e1.w};
              const LAS float* PAR = (const LAS float*)(lds + I_PAR) + k0;
              const LAS float* w0p = PAR; const LAS float* a0p = PAR + 64; const LAS float* kkp = PAR + 128; const LAS float* kap = PAR + 192; const LAS float* rkp = PAR + 256;
              float ss = 0.f, bd = 0.f, lw[8];
#pragma unroll
              for (int e = 0; e < 8; ++e) {
                  kkn[e] = k[e] * kkp[e]; ss += kkn[e] * kkn[e];
                  const float z = w0p[e] + dw[e];
                  lw[e] = -0.60653066f * fsigmoid(z);
                  const float as = fsigmoid(a0p[e] + da[e]);
                  kd[e] = k[e] * (1.f + (as - 1.f) * kap[e]);
                  bd += r[e] * kd[e] * rkp[e];
                  ab[e] = as; }
              ss = red8(ss); bd = red8(bd);
              const float inv = __builtin_amdgcn_rcpf(fmaxf(__builtin_amdgcn_sqrtf(ss), 1e-12f));
#pragma unroll
              for (int e = 0; e < 8; ++e) { kkn[e] *= inv; ab[e] *= kkn[e]; }
              LAS float* Gs = (LAS float*)(lds + I_G) + j * 64 + k0;
              *(LAS f32x4*)Gs = (f32x4){lw[0], lw[1], lw[2], lw[3]}; *(LAS f32x4*)(Gs + 4) = (f32x4){lw[4], lw[5], lw[6], lw[7]};
              if (!isctx && sub == 0) *(float*)(p.ws + (size_t)(unsigned)(WS_BDOT + ((dir * MX + rowbase + t) * NH + h) * 4)) = bd; }
            LBAR();
            { const int kap = tid & 63, jq = tid >> 6; LAS float* Gs = (LAS float*)(lds + I_G); LAS float* GT = (LAS float*)(lds + I_GT);
              float pf[8], run = 0.f;
#pragma unroll
              for (int e = 0; e < 8; ++e) { run += Gs[(8 * jq + e) * 64 + kap]; pf[e] = run; }
              GT[jq * 64 + kap] = run;
              LBAR();
              float off = 0.f;
#pragma unroll
              for (int q = 0; q < 7; ++q) off += (q < jq) ? GT[q * 64 + kap] : 0.f;
#pragma unroll
              for (int e = 0; e < 8; ++e) Gs[(8 * jq + e) * 64 + kap] = pf[e] + off; }
            LBAR();
            { const LAS float* Gs = (const LAS float*)(lds + I_G);
              const f32x4 g0 = *(const LAS f32x4*)(Gs + j * 64 + k0), g1 = *(const LAS f32x4*)(Gs + j * 64 + k0 + 4);
              const f32x4 c0 = *(const LAS f32x4*)(Gs + 63 * 64 + k0), c1 = *(const LAS f32x4*)(Gs + 63 * 64 + k0 + 4);
              f32x4 m0 = fz, m1 = fz; if (j > 0) { m0 = *(const LAS f32x4*)(Gs + (j - 1) * 64 + k0); m1 = *(const LAS f32x4*)(Gs + (j - 1) * 64 + k0 + 4); }
              const float g[8] = {g0.x, g0.y, g0.z, g0.w, g1.x, g1.y, g1.z, g1.w}, gm[8] = {m0.x, m0.y, m0.z, m0.w, m1.x, m1.y, m1.z, m1.w}, gc[8] = {c0.x, c0.y, c0.z, c0.w, c1.x, c1.y, c1.z, c1.w};
              float at[8], bt[8], kt[8], rt[8], bh[8], kh[8];
#pragma unroll
              for (int e = 0; e < 8; ++e) { const float eg = __expf(g[e]), em = __expf(gm[e]), ei = __expf(-g[e]), eh = __expf(gc[e] - g[e]);
                  at[e] = -kkn[e] * em; bt[e] = ab[e] * ei; kt[e] = kd[e] * ei; rt[e] = r[e] * eg; bh[e] = ab[e] * eh; kh[e] = kd[e] * eh; }
              const int o = ioff(j, k0);
              *(LAS u32x4*)(lds + I_AT + o) = pack8(at); *(LAS u32x4*)(lds + I_BT + o) = pack8(bt); *(LAS u32x4*)(lds + I_KT + o) = pack8(kt);
              *(LAS u32x4*)(lds + I_RT + o) = pack8(rt); *(LAS u32x4*)(lds + I_BH + o) = pack8(bh); *(LAS u32x4*)(lds + I_KH + o) = pack8(kh);
              if (j == 0) { float* GAM = (float*)(p.ws + (size_t)(unsigned)(WS_GAM + (u * 64 + k0) * 4));
#pragma unroll
                  for (int e = 0; e < 8; ++e) GAM[e] = __expf(gc[e]); } }
            LBAR();
            const int cvitem = __builtin_amdgcn_readfirstlane(opq((CVPOS != 0 && cc < 32 && wave >= 5) ? item * 96 + cc * 3 + (wave - 5) : -1));
            f32x4 cv[8];
#if CVPOS == 1
            if (cvitem >= 0) xcvt_load(p, cvitem, opq(lane_), cv);
#endif
            { const int lane = opq(lane_); const int nt = wave >> 1, mb = (wave & 1) * 2;
              const bf16x8 bB0 = frag_rm(lds + I_BT, 16 * nt, 0, lane), bB1 = frag_rm(lds + I_BT, 16 * nt, 32, lane);
              const int n = 16 * nt + (lane & 15);
#pragma unroll
              for (int mi = 0; mi < 2; ++mi) { const int mt = mb + mi, m0 = 16 * mt + 4 * (lane >> 4);
                  const bf16x8 aA0 = frag_rm(lds + I_AT, 16 * mt, 0, lane), aA1 = frag_rm(lds + I_AT, 16 * mt, 32, lane);
                  f32x4 lt = MFMA16(aA1, bB1, MFMA16(aA0, bB0, fz));
#pragma unroll
                  for (int q = 0; q < 4; ++q) lt[q] = (m0 + q > n) ? lt[q] : 0.f;
                  *(LAS f32x4*)((LAS float*)(lds + I_LT) + n * 68 + m0) = lt;
                  st_img(lds + I_LBT, 16 * nt, 16 * mt, lane, lt); } }
            LBAR();
            if (wave == 0) {
                const int lane = opq(lane_); const int a16 = lane >> 4, il = lane & 15;
                const LAS float* LT = (const LAS float*)(lds + I_LT);
                typedef float f32x2v __attribute__((ext_vector_type(2)));
                f32x2v tp[8];
#pragma unroll
                for (int i = 0; i < 8; ++i) tp[i] = (f32x2v){0.f, 0.f};
                f32x4 Lc[4], Ln[4];
#pragma unroll
                for (int q4 = 0; q4 < 4; ++q4) { Lc[q4] = fz; Ln[q4] = fz; }
                Lc[3] = *(const LAS f32x4*)(LT + (16 * a16 + 14) * 68 + 16 * a16 + 12);
                tp[7].y = (il == 15) ? 1.f : 0.f;
#pragma unroll
                for (int jl = 14; jl >= 0; --jl) {
                    if (jl > 0) { const LAS float* Lrow = LT + (16 * a16 + jl - 1) * 68 + 16 * a16;
#pragma unroll
                        for (int q4 = 0; q4 < 4; ++q4) if (4 * q4 + 3 > jl - 1) Ln[q4] = *(const LAS f32x4*)(Lrow + 4 * q4); }
                    f32x2v s01 = (f32x2v){(il == jl) ? 1.f : 0.f, 0.f}, s23 = (f32x2v){0.f, 0.f};
#pragma unroll
                    for (int q4 = 0; q4 < 4; ++q4) if (4 * q4 + 3 > jl) { const f32x4 Lv = Lc[q4];
                        s01 += tp[2 * q4] * (f32x2v){Lv.x, Lv.y}; s23 += tp[2 * q4 + 1] * (f32x2v){Lv.z, Lv.w}; }
                    float tv_ = (s01.x + s01.y) + (s23.x + s23.y);
                    asm volatile("" : "+v"(tv_) :: "memory");
                    if (jl & 1) tp[jl >> 1].y = tv_; else tp[jl >> 1].x = tv_;
#pragma unroll
                    for (int q4 = 0; q4 < 4; ++q4) Lc[q4] = Ln[q4];
                }
                LAS unsigned char* tmi = lds + I_TM;
                const u32x4 z4 = (u32x4){0u, 0u, 0u, 0u};
#pragma unroll
                for (int c8 = 0; c8 < 2; ++c8) { const float tv[8] = {tp[4 * c8].x, tp[4 * c8].y, tp[4 * c8 + 1].x, tp[4 * c8 + 1].y, tp[4 * c8 + 2].x, tp[4 * c8 + 2].y, tp[4 * c8 + 3].x, tp[4 * c8 + 3].y};
                    *(LAS u32x4*)(tmi + ioff(lane, 16 * a16 + 8 * c8)) = pack8(tv); }
                if ((a16 & 1) == 0) {
#pragma unroll
                    for (int c8 = 0; c8 < 2; ++c8) *(LAS u32x4*)(tmi + ioff(lane, 16 * (a16 + 1) + 8 * c8)) = z4; }
                if (a16 < 2) {
#pragma unroll
                    for (int c8 = 0; c8 < 4; ++c8) *(LAS u32x4*)(tmi + ioff(lane, 32 + 8 * c8)) = z4; }
                asm volatile("s_waitcnt lgkmcnt(0)" ::: "memory");
                const bf16x8 zf = (bf16x8){0, 0, 0, 0, 0, 0, 0, 0};
                const bool khi = (lane & 32) != 0;
#pragma unroll
                for (int pq = 0; pq < 2; ++pq) {
                    bf16x8 fa = frag_tr(lds + I_TM, 32 * pq, 32 * pq, lane), fb = frag_tr(lds + I_LBT, 32 * pq, 32 * pq + 16, lane);
                    fa = khi ? zf : fa; fb = khi ? zf : fb;
                    st_img(lds + I_E, 16 * pq, 0, lane, MFMA16(fa, fb, fz)); }
                asm volatile("s_waitcnt lgkmcnt(0)" ::: "memory");
#pragma unroll
                for (int pq = 0; pq < 2; ++pq) {
                    bf16x8 fa = frag_tr(lds + I_E, 16 * pq, 0, lane), fb = frag_rm(lds + I_TM, 32 * pq + 16, 32 * pq + 16, lane);
                    fa = khi ? zf : fa; fb = khi ? zf : fb;
                    st_img(lds + I_TM, 32 * pq + 16, 32 * pq, lane, MFMA16(fa, fb, fz)); }
                asm volatile("s_waitcnt lgkmcnt(0)" ::: "memory");
                { f32x4 ea[4];
#pragma unroll
                  for (int tq = 0; tq < 4; ++tq) { const int nt2 = tq >> 1, mt2 = tq & 1;
                      ea[tq] = MFMA16(frag_tr(lds + I_TM, 0, 16 * mt2, lane), frag_tr(lds + I_LBT, 0, 32 + 16 * nt2, lane), fz); }
#pragma unroll
                  for (int tq = 0; tq < 4; ++tq) st_img(lds + I_E, 16 * (tq >> 1), 16 * (tq & 1), lane, ea[tq]); }
                asm volatile("s_waitcnt lgkmcnt(0)" ::: "memory");
                { f32x4 ta[4];
#pragma unroll
                  for (int tq = 0; tq < 4; ++tq) { const int nt2 = tq >> 1, mt2 = tq & 1;
                      ta[tq] = MFMA16(frag_tr(lds + I_E, 0, 16 * mt2, lane), frag_rm(lds + I_TM, 32 + 16 * nt2, 32, lane), fz); }
#pragma unroll
                  for (int tq = 0; tq < 4; ++tq) st_img(lds + I_TM, 32 + 16 * (tq >> 1), 16 * (tq & 1), lane, ta[tq]); }
            } else if (wave < 5) {
                const int lane = opq(lane_); const int nt = wave - 1, n = 16 * nt + (lane & 15);
                const bf16x8 bA0 = frag_rm(lds + I_AT, 16 * nt, 0, lane), bA1 = frag_rm(lds + I_AT, 16 * nt, 32, lane);
                const bf16x8 bR0 = frag_rm(lds + I_RT, 16 * nt, 0, lane), bR1 = frag_rm(lds + I_RT, 16 * nt, 32, lane);
                bf16x8 fk[4][2], fb[4][2];
#pragma unroll
                for (int mt = 0; mt < 4; ++mt) { fk[mt][0] = frag_rm(lds + I_KT, 16 * mt, 0, lane); fk[mt][1] = frag_rm(lds + I_KT, 16 * mt, 32, lane);
                                                 fb[mt][0] = frag_rm(lds + I_BT, 16 * mt, 0, lane); fb[mt][1] = frag_rm(lds + I_BT, 16 * mt, 32, lane); }
                f32x4 laks[4], prbs[4];
#pragma unroll
                for (int mt = 0; mt < 4; ++mt) { const int m0 = 16 * mt + 4 * (lane >> 4);
                    f32x4 lak = MFMA16(fk[mt][1], bA1, MFMA16(fk[mt][0], bA0, fz)), prb = MFMA16(fb[mt][1], bR1, MFMA16(fb[mt][0], bR0, fz));
#pragma unroll
                    for (int q = 0; q < 4; ++q) { lak[q] = (m0 + q < n) ? lak[q] : 0.f; prb[q] = (m0 + q <= n) ? prb[q] : 0.f; }
                    laks[mt] = lak; prbs[mt] = prb; }
#pragma unroll
                for (int mt = 0; mt < 4; ++mt) { st_img(lds + I_LAK, 16 * nt, 16 * mt, lane, laks[mt]); st_img(lds + I_PRB, 16 * nt, 16 * mt, lane, prbs[mt]); }
                bf16x8 fv[4][2];
#pragma unroll
                for (int mt = 0; mt < 4; ++mt) { fv[mt][0] = frag_tr(vvimg, 0, 16 * mt, lane); fv[mt][1] = frag_tr(vvimg, 32, 16 * mt, lane); }
                asm volatile("s_waitcnt lgkmcnt(0)" ::: "memory");
                const bf16x8 bL0 = frag_rm(lds + I_LAK, 16 * nt, 0, lane), bL1 = frag_rm(lds + I_LAK, 16 * nt, 32, lane);
                f32x4 qs[4];
#pragma unroll
                for (int mt = 0; mt < 4; ++mt) qs[mt] = MFMA16(fv[mt][1], bL1, MFMA16(fv[mt][0], bL0, fz));
#pragma unroll
                for (int mt = 0; mt < 4; ++mt) st_img(lds + I_Q, 16 * nt, 16 * mt, lane, qs[mt]);
            } else {
                const int lane = opq(lane_);
#if CVPOS == 3
                if (cvitem >= 0) xcvt_load(p, cvitem, lane, cv);
#endif
#pragma unroll
                for (int bt = 0; bt < 2; ++bt) { bf16x8 fa[3][2], fr[3][2]; f32x4 accs[3];
#pragma unroll
                    for (int k3 = 0; k3 < 3; ++k3) { const int tq = (wave - 5) + 3 * (3 * bt + k3); const int tqc = tq < 16 ? tq : 15, nt = tqc >> 2, mt = tqc & 3;
                        fa[k3][0] = frag_rm(lds + I_KT, 16 * mt, 0, lane); fa[k3][1] = frag_rm(lds + I_KT, 16 * mt, 32, lane);
                        fr[k3][0] = frag_rm(lds + I_RT, 16 * nt, 0, lane); fr[k3][1] = frag_rm(lds + I_RT, 16 * nt, 32, lane); }
#pragma unroll
                    for (int k3 = 0; k3 < 3; ++k3) { const int tq = (wave - 5) + 3 * (3 * bt + k3); const int tqc = tq < 16 ? tq : 15, nt = tqc >> 2, mt = tqc & 3, n = 16 * nt + (lane & 15), m0 = 16 * mt + 4 * (lane >> 4);
                        f32x4 acc = MFMA16(fa[k3][1], fr[k3][1], MFMA16(fa[k3][0], fr[k3][0], fz));
#pragma unroll
                        for (int q = 0; q < 4; ++q) acc[q] = (m0 + q <= n) ? acc[q] : 0.f;
                        accs[k3] = acc; }
#pragma unroll
                    for (int k3 = 0; k3 < 3; ++k3) { const int tq = (wave - 5) + 3 * (3 * bt + k3); const int tqc = tq < 16 ? tq : 15, nt = tqc >> 2, mt = tqc & 3;
                        st_img(lds + I_PRK, 16 * nt, 16 * mt, lane, accs[k3]); } }
#if CVPOS == 2
                if (cvitem >= 0) xcvt_load(p, cvitem, lane, cv);
#endif
                if (cvitem >= 0) xcvt_store(p, cvitem, lane, cv);
            }
            LBAR();
            { const int lane = opq(lane_); const int pr = wave >> 2, nt = wave & 3; const LAS unsigned char* Aimg = lds + (pr ? I_Q : I_AT); LAS unsigned char* Oimg = lds + (pr ? I_W2 : I_W1);
              const bf16x8 bT0 = frag_rm(lds + I_TM, 16 * nt, 0, lane), bT1 = frag_rm(lds + I_TM, 16 * nt, 32, lane);
#pragma unroll
              for (int mt = 0; mt < 4; ++mt) { f32x4 acc = MFMA16(frag_tr(Aimg, 0, 16 * mt, lane), bT0, fz); acc = MFMA16(frag_tr(Aimg, 32, 16 * mt, lane), bT1, acc);
                  st_img(Oimg, 16 * nt, 16 * mt, lane, acc); } }
            LBAR();
            float rn[8], kn[8];
            if (cc + 1 < 34) { X_LERP(XCI(cc + 1), (cc + 1) & 1, rn, kn); LBAR(); X_LORA(); }
            { const int lane = opq(lane_); const int nt = wave >> 1, mb = (wave & 1) * 2;
              const int n = 16 * nt + (lane & 15);
              const bf16x8 bBh0 = frag_tr(lds + I_BH, 0, 16 * nt, lane), bBh1 = frag_tr(lds + I_BH, 32, 16 * nt, lane);
              const bf16x8 bW20 = frag_tr(lds + I_W2, 0, 16 * nt, lane), bW21 = frag_tr(lds + I_W2, 32, 16 * nt, lane);
              const bf16x8 bVv0 = frag_tr(vvimg, 0, 16 * nt, lane), bVv1 = frag_tr(vvimg, 32, 16 * nt, lane);
              const bf16x8 bPb0 = frag_rm(lds + I_PRB, 16 * nt, 0, lane), bPb1 = frag_rm(lds + I_PRB, 16 * nt, 32, lane);
              const bf16x8 bPk0 = frag_rm(lds + I_PRK, 16 * nt, 0, lane), bPk1 = frag_rm(lds + I_PRK, 16 * nt, 32, lane);
              const unsigned MLRo = (unsigned)WS_MLR + (unsigned)u * 8192u, NTo = (unsigned)WS_NT + (unsigned)u * 8192u, RBo = (unsigned)WS_RB + (unsigned)(bhd * 64 + c) * 8192u;
              const int posn = 64 * c + n, tn = dir ? (T - 1 - posn) : posn;
              const unsigned Yo = (unsigned)(dir ? WS_YB : WS_YF) + (unsigned)(((b * T + tn) * DR + h * 64) * 2);
#pragma unroll
              for (int mi = 0; mi < 2; ++mi) { const int mt = mb + mi, m0 = 16 * mt + 4 * (lane >> 4);
                  const bf16x8 aW10 = frag_tr(lds + I_W1, 0, 16 * mt, lane), aW11 = frag_tr(lds + I_W1, 32, 16 * mt, lane);
                  const bf16x8 aBh0 = frag_tr(lds + I_BH, 0, 16 * mt, lane), aBh1 = frag_tr(lds + I_BH, 32, 16 * mt, lane);
                  const bf16x8 aKh0 = frag_tr(lds + I_KH, 0, 16 * mt, lane), aKh1 = frag_tr(lds + I_KH, 32, 16 * mt, lane);
                  const f32x4 mlr = MFMA16(aW11, bBh1, MFMA16(aW10, bBh0, fz));
                  const f32x4 ntv = MFMA16(aKh1, bVv1, MFMA16(aKh0, bVv0, MFMA16(aBh1, bW21, MFMA16(aBh0, bW20, fz))));
                  const int fo = ((nt * 2 + (mt >> 1)) * 64 + (lane & 15) + 16 * (2 * (mt & 1) + (lane >> 5))) * 8 + 4 * ((lane >> 4) & 1);
                  { u32x2 w; w.x = pk2(mlr[0], mlr[1]); w.y = pk2(mlr[2], mlr[3]); *(u32x2*)(p.ws + (size_t)(MLRo + 2u * (unsigned)fo)) = w; }
                  { u32x2 w; w.x = pk2(ntv[0], ntv[1]); w.y = pk2(ntv[2], ntv[3]); *(u32x2*)(p.ws + (size_t)(NTo + 8u * (unsigned)((nt * 4 + mt) * 64 + lane))) = w; }
                  if (!isctx) {
                      const bf16x8 aW20 = frag_tr(lds + I_W2, 0, 16 * mt, lane), aW21 = frag_tr(lds + I_W2, 32, 16 * mt, lane);
                      const bf16x8 aVv0 = frag_tr(vvimg, 0, 16 * mt, lane), aVv1 = frag_tr(vvimg, 32, 16 * mt, lane);
                      f32x4 rb = MFMA16(aW11, bPb1, MFMA16(aW10, bPb0, fz));
                      const f32x4 y0 = MFMA16(aVv1, bPk1, MFMA16(aVv0, bPk0, MFMA16(aW21, bPb1, MFMA16(aW20, bPb0, fz))));
                      rb += up4(*(const LAS u32x2*)(lds + I_RT + ioff(n, m0)));
                      { u32x2 w; w.x = pk2(rb[0], rb[1]); w.y = pk2(rb[2], rb[3]); *(u32x2*)(p.ws + (size_t)(RBo + 2u * (unsigned)fo)) = w; }
                      { u32x2 w; w.x = pk2(y0[0], y0[1]); w.y = pk2(y0[2], y0[3]); *(u32x2*)(p.ws + (size_t)(Yo + 2u * (unsigned)m0)) = w; }
                  } } }
#if XSCOPE
#pragma unroll
            for (int e = 0; e < 8; ++e) { r[e] = rn[e]; k[e] = kn[e]; }
#else
            if (cc + 1 < 34) {
#pragma unroll
                for (int e = 0; e < 8; ++e) { r[e] = rn[e]; k[e] = kn[e]; } }
#endif
        }
    }
}
#undef X_PXLOAD
#undef XCI
#undef X_LERP
#undef X_LORA

struct SSet { bf16x8 A0, A1, R0, R1; u32x2 N0, Y0; f32x4 G; size_t yoff; };
__device__ __forceinline__ void phase_scanS(const Params& p, LAS unsigned char* lds, int bid, int G, int wv) {
    const int tid = my_tid(wv), lane = tid & 63, wave = __builtin_amdgcn_readfirstlane(tid >> 6);
    LAS unsigned char* HH = lds; LAS unsigned char* HL = lds + IMG;
    const int mtk = wave >> 1, ntl = wave & 1;
    const f32x4 fz = (f32x4){0.f, 0.f, 0.f, 0.f};
    for (int it = bid; it < NB * NH * 2 * 2; it += G) {
        const int item = it & 127, half = it >> 7, ntg = 2 * half + ntl;
        const int dir = item & 1, h = (item >> 1) & 7, b = item >> 4;
        f32x4 Hm0 = fz;
        LBAR();
        st_img(HH, 16 * ntl, 16 * mtk, lane, fz); st_img(HL, 16 * ntl, 16 * mtk, lane, fz);
        LBAR();
        const bf16_t* MLRg = (const bf16_t*)(p.ws + WS_MLR) + (size_t)item * 68 * 4096; const bf16_t* NTg = (const bf16_t*)(p.ws + WS_NT) + (size_t)item * 68 * 4096;
        const float* GAMg = (const float*)(p.ws + WS_GAM) + (size_t)item * 68 * 64; const bf16_t* RBg = (const bf16_t*)(p.ws + WS_RB) + (size_t)item * 64 * 4096;
        bf16_t* Yg = (bf16_t*)(p.ws + (dir ? WS_YB : WS_YF)) + (size_t)b * T * DR + h * 64;
        const int arow = (mtk * 2 * 64 + lane) * 8;
#define S_LOAD(S_, ci_) do { const int ci__ = (ci_) < 68 ? (ci_) : 67; const int c__ = ci__ >= 4 ? ci__ - 4 : 0; \
            const bf16_t* M__ = MLRg + (size_t)ci__ * 4096; S_.A0 = *(const bf16x8*)(M__ + arow); S_.A1 = *(const bf16x8*)(M__ + arow + 512); \
            S_.N0 = *(const u32x2*)(NTg + (size_t)ci__ * 4096 + lane * 4 + (ntg * 4 + mtk) * 256); \
            S_.G = *(const f32x4*)(GAMg + ci__ * 64 + 16 * mtk + 4 * (lane >> 4)); \
            const bf16_t* R__ = RBg + (size_t)c__ * 4096; S_.R0 = *(const bf16x8*)(R__ + arow); S_.R1 = *(const bf16x8*)(R__ + arow + 512); \
            const int pos__ = 64 * c__ + 16 * mtk + (lane & 15), t__ = dir ? (T - 1 - pos__) : pos__; \
            S_.yoff = (size_t)t__ * DR + 4 * (lane >> 4) + 16 * ntg; S_.Y0 = *(const u32x2*)(Yg + S_.yoff); } while (0)
#define S_STEP(S_, ci_) do { if ((ci_) < 68) { \
            const bf16x8 h00 = frag_rm(HH, 16 * ntl, 0, lane), h01 = frag_rm(HH, 16 * ntl, 32, lane); \
            const bf16x8 l00 = frag_rm(HL, 16 * ntl, 0, lane), l01 = frag_rm(HL, 16 * ntl, 32, lane); \
            f32x4 a0 = Hm0 * S_.G + up4(S_.N0); \
            a0 = MFMA16(S_.A0, h00, a0); a0 = MFMA16(S_.A1, h01, a0); a0 = MFMA16(S_.A0, l00, a0); a0 = MFMA16(S_.A1, l01, a0); \
            if ((ci_) >= 4) { \
                f32x4 y0 = up4(S_.Y0); \
                y0 = MFMA16(h00, S_.R0, y0); y0 = MFMA16(h01, S_.R1, y0); y0 = MFMA16(l00, S_.R0, y0); y0 = MFMA16(l01, S_.R1, y0); \
                { u32x2 w; w.x = pk2(y0[0], y0[1]); w.y = pk2(y0[2], y0[3]); *(u32x2*)(Yg + S_.yoff) = w; } } \
            LBAR(); \
            Hm0 = a0; \
            { f32x4 hi, lo; \
              _Pragma("unroll") for (int q = 0; q < 4; ++q) { hi[q] = __uint_as_float(f2bf(a0[q]) << 16); lo[q] = a0[q] - hi[q]; } \
              st_img(HH, 16 * ntl, 16 * mtk, lane, hi); st_img(HL, 16 * ntl, 16 * mtk, lane, lo); } \
            LBAR(); } } while (0)
        SSet s0, s1, s2, s3;
        S_LOAD(s0, 0); S_LOAD(s1, 1); S_LOAD(s2, 2);
        for (int ci = 0; ci < 68; ci += 4) {
            S_LOAD(s3, ci + 3); S_STEP(s0, ci);
            S_LOAD(s0, ci + 4); S_STEP(s1, ci + 1);
            S_LOAD(s1, ci + 5); S_STEP(s2, ci + 2);
            S_LOAD(s2, ci + 6); S_STEP(s3, ci + 3);
        }
#undef S_LOAD
#undef S_STEP
    }
}

__device__ __forceinline__ void phase_out(const Params& p, LAS unsigned char* lds, int bid, int G, int wv) {
    const int tid_ = my_tid(wv), lane_ = tid_ & 63, wave = __builtin_amdgcn_readfirstlane(tid_ >> 6);
    const bf16_t* PX = (const bf16_t*)(p.ws + WS_PX); const bf16_t* YF = (const bf16_t*)(p.ws + WS_YF); const bf16_t* YB = (const bf16_t*)(p.ws + WS_YB);
    const float* BDOT = (const float*)(p.ws + WS_BDOT);
    bf16_t* AX = (bf16_t*)(p.ws + WS_AX);
    const float* mu = p.in[9];
    constexpr int SGS = 272;
    LAS unsigned char* SG = lds;
    LAS unsigned char* GW = lds + 64 * SGS + wave * IMG;
    const f32x4 fz = (f32x4){0.f, 0.f, 0.f, 0.f};
    bf16x8 gf[4][4];
    { const float* gu = p.in[17] + wave * 64 + (lane_ & 15);
#pragma unroll
      for (int ct = 0; ct < 4; ++ct)
#pragma unroll
          for (int ks = 0; ks < 4; ++ks) { float f[8];
#pragma unroll
              for (int e = 0; e < 8; ++e) f[e] = gu[(size_t)(32 * ks + 8 * (lane_ >> 4) + e) * DR + 16 * ct];
              gf[ct][ks] = __builtin_bit_cast(bf16x8, pack8(f)); } }
    const int tokl = lane_ >> 3, cs = lane_ & 7, cb = wave * 64 + cs * 8;
    float gng[8], gnb[8];
    { const f32x4 g0 = *(const f32x4*)(p.in[18] + cb), g1 = *(const f32x4*)(p.in[18] + cb + 4), b0 = *(const f32x4*)(p.in[19] + cb), b1 = *(const f32x4*)(p.in[19] + cb + 4);
      gng[0] = g0.x; gng[1] = g0.y; gng[2] = g0.z; gng[3] = g0.w; gng[4] = g1.x; gng[5] = g1.y; gng[6] = g1.z; gng[7] = g1.w;
      gnb[0] = b0.x; gnb[1] = b0.y; gnb[2] = b0.z; gnb[3] = b0.w; gnb[4] = b1.x; gnb[5] = b1.y; gnb[6] = b1.z; gnb[7] = b1.w; }
    for (int bq = bid; bq < MX / 64; bq += G) {
        const int bt = (G == 256) ? ((bq & 7) * 64 + ((bq & 255) >> 3) * 2 + (bq >> 8)) : bq;
        const int tok0 = bt * 64, b = tok0 >> 12, rowbase = b * T;
        LBAR();
        { const int tid = opq(tid_), tl = tid >> 3, sub = tid & 7; const int tok = tok0 + tl, t = tok & (T - 1);
          int nbr[4]; neighbours(t, false, rowbase, nbr);
          const Px5 q0 = px_load(PX, tok, nbr, 1664 + sub * 16), q1 = px_load(PX, tok, nbr, 1664 + sub * 16 + 8);
          float x0[8], x1[8]; px_lerp(q0, false, 1664 + sub * 16, mu, x0); px_lerp(q1, false, 1664 + sub * 16 + 8, mu, x1);
#pragma unroll
          for (int e = 0; e < 8; ++e) { x0[e] = fsigmoid(x0[e]); x1[e] = fsigmoid(x1[e]); }
          *(LAS u32x4*)(SG + tl * SGS + sub * 32) = pack8(x0); *(LAS u32x4*)(SG + tl * SGS + sub * 32 + 16) = pack8(x1); }
        LBAR();
        { const int lane = opq(lane_);
#pragma unroll
          for (int tt = 0; tt < 4; ++tt) { bf16x8 bs[4];
#pragma unroll
              for (int ks = 0; ks < 4; ++ks) bs[ks] = *(const LAS bf16x8*)(SG + (16 * tt + (lane & 15)) * SGS + (32 * ks + 8 * (lane >> 4)) * 2);
#pragma unroll
              for (int ct = 0; ct < 4; ++ct) { f32x4 acc = fz;
#pragma unroll
                  for (int ks = 0; ks < 4; ++ks) acc = MFMA16(gf[ct][ks], bs[ks], acc);
                  st_img(GW, 16 * tt, 16 * ct, lane, acc); } } }
        asm volatile("s_waitcnt lgkmcnt(0)" ::: "memory");
#pragma unroll 2
        for (int ps = 0; ps < 8; ++ps) {
            const int lane = opq(lane_); const int tl = 8 * ps + (lane >> 3), tok = tok0 + tl, t = tok & (T - 1);
            int nbr[4]; neighbours(t, false, rowbase, nbr);
            const Px5 qv = px_load(PX, tok, nbr, 1024 + cb);
            float yf[8], yb[8], y[8], g[8], v[8];
            unpack8(*(const u32x4*)(YF + (size_t)tok * DR + cb), yf); unpack8(*(const u32x4*)(YB + (size_t)tok * DR + cb), yb);
            const float bd = BDOT[(size_t)tok * NH + wave] + BDOT[((size_t)MX + tok) * NH + wave];
            unpack8(*(const LAS u32x4*)(GW + ioff(tl, 8 * (lane & 7))), g);
            px_lerp(qv, false, 1024 + cb, mu, v);
            float s1 = 0.f;
#pragma unroll
            for (int e = 0; e < 8; ++e) { y[e] = yf[e] + yb[e]; s1 += y[e]; }
            const float mean = red8(s1) * (1.f / 64.f);
            float s2 = 0.f;
#pragma unroll
            for (int e = 0; e < 8; ++e) { y[e] -= mean; s2 += y[e] * y[e]; }
            const float rstd = rsqrtf(red8(s2) * (1.f / 64.f) + 64e-5f);
            float ax[8];
#pragma unroll
            for (int e = 0; e < 8; ++e) ax[e] = (y[e] * rstd * gng[e] + gnb[e] + bd * v[e]) * g[e];
            *(u32x4*)(AX + (size_t)tok * D + cb) = pack8(ax);
        }
        { const float* cwp = p.in[20] + cb;
          const f32x4 w00 = *(const f32x4*)(cwp), w01 = *(const f32x4*)(cwp + 4), w10 = *(const f32x4*)(cwp + DR), w11 = *(const f32x4*)(cwp + DR + 4), w20 = *(const f32x4*)(cwp + 2 * DR), w21 = *(const f32x4*)(cwp + 2 * DR + 4);
          const float cw0[8] = {w00.x, w00.y, w00.z, w00.w, w01.x, w01.y, w01.z, w01.w}, cw1[8] = {w10.x, w10.y, w10.z, w10.w, w11.x, w11.y, w11.z, w11.w}, cw2[8] = {w20.x, w20.y, w20.z, w20.w, w21.x, w21.y, w21.z, w21.w};
#pragma unroll 2
          for (int ps = 0; ps < 8; ++ps) {
              const int lane = opq(lane_); const int tok = tok0 + 8 * ps + (lane >> 3), t = tok & (T - 1);
              float bg[8], c0[8], u0[8], cm[8], um[8], cp[8], up[8];
              const u32x4 z = (u32x4){0u, 0u, 0u, 0u};
              const bf16_t* pr = PX + (size_t)tok * DIN + RWC + cb;
              unpack8(*(const u32x4*)pr, bg); unpack8(*(const u32x4*)(pr + 512), c0); unpack8(*(const u32x4*)(pr + 1024), u0);
              unpack8(t > 0 ? *(const u32x4*)(pr - DIN + 512) : z, cm); unpack8(t > 0 ? *(const u32x4*)(pr - DIN + 1024) : z, um);
              unpack8(t < T - 1 ? *(const u32x4*)(pr + DIN + 512) : z, cp); unpack8(t < T - 1 ? *(const u32x4*)(pr + DIN + 1024) : z, up);
              float bx[8];
#pragma unroll
              for (int e = 0; e < 8; ++e) bx[e] = bg[e] * (cw0[e] * (cm[e] * um[e]) + cw1[e] * (c0[e] * u0[e]) + cw2[e] * (cp[e] * up[e]));
              *(u32x4*)(AX + (size_t)tok * D + DR + cb) = pack8(bx);
          } }
    }
}

__device__ __forceinline__ void phase_hx(const Params& p, LAS unsigned char* lds, int bid, int G, int wv) {
    const int tid = my_tid(wv), lane = tid & 63, wave = tid >> 6;
    const bf16_t* X1 = (const bf16_t*)(p.ws + WS_X1); const float* MOD = (const float*)(p.ws + WS_MOD); const float* n2g = p.in[7];
    unsigned char* HX = p.ws + WS_HX; float* AFF = (float*)(p.ws + WS_AFF);
    LAS float* RW = (LAS float*)lds;
    { const float* rw = p.in[22]; for (int i = tid; i < 1024 * 16; i += NTHR) RW[(i & 15) * 1024 + (i >> 4)] = rw[i]; }
    __syncthreads();
    const int gw = bid * NWAVES + wave, NGW = G * NWAVES;
    const bool u5 = (lane & 32) != 0, u4 = (lane & 16) != 0, u3 = (lane & 8) != 0, u2 = (lane & 4) != 0;
    const int emine = (u5 ? 8 : 0) + (u4 ? 4 : 0) + (u3 ? 2 : 0) + (u2 ? 1 : 0);
    for (int blk = gw; blk < MX / 16; blk += NGW) {
        const int tokb = blk * 16, b = tokb >> 12;
        const float* sh = MOD + (size_t)b * 6144 + 3072; const float* scp = sh + 1024;
        f32x4 ga[4], hb[4];
#pragma unroll
        for (int j = 0; j < 4; ++j) { const int col = 4 * (lane + 64 * j); ga[j] = *(const f32x4*)(n2g + col) * (*(const f32x4*)(scp + col) + 1.f); hb[j] = *(const f32x4*)(sh + col); }
        u32x2 xq[2][4];
#pragma unroll
        for (int tk = 0; tk < 2; ++tk)
#pragma unroll
            for (int j = 0; j < 4; ++j) xq[tk][j] = ((const u32x2*)(X1 + (size_t)(tokb + tk) * D))[lane + 64 * j];
        for (int it = 0; it < 8; ++it) {
            f32x4 yv[2][4]; float lg[2][16];
            u32x2 xn[2][4];
            { const int itn = it < 7 ? it + 1 : it;
#pragma unroll
              for (int tk = 0; tk < 2; ++tk)
#pragma unroll
                for (int j = 0; j < 4; ++j) xn[tk][j] = ((const u32x2*)(X1 + (size_t)(tokb + 2 * itn + tk) * D))[lane + 64 * j]; }
#pragma unroll
            for (int tk = 0; tk < 2; ++tk) { const int tok = tokb + 2 * it + tk;
                f32x4 v[4]; float ss = 0.f;
#pragma unroll
                for (int j = 0; j < 4; ++j) { v[j] = up4(xq[tk][j]); ss += (v[j].x * v[j].x + v[j].y * v[j].y) + (v[j].z * v[j].z + v[j].w * v[j].w); }
                const float rstd = rsqrtf(wave_sum(ss) * (1.f / D) + 1e-6f);
#pragma unroll
                for (int j = 0; j < 4; ++j) { const f32x4 y = v[j] * rstd * ga[j] + hb[j]; yv[tk][j] = y;
#if MOE_FP8
                    *(unsigned*)(HX + (size_t)tok * D + 4 * (lane + 64 * j)) = pk4_fp8_raw(y.x, y.y, y.z, y.w); } }
#else
                    u32x2 o; o.x = pk2(y.x, y.y); o.y = pk2(y.z, y.w);
                    *(u32x2*)((bf16_t*)HX + (size_t)tok * D + 4 * (lane + 64 * j)) = o; } }
#endif
#pragma unroll
            for (int e = 0; e < 16; ++e) { f32x2 p0 = (f32x2){0.f, 0.f}, p1 = (f32x2){0.f, 0.f};
#pragma unroll
                for (int j = 0; j < 4; ++j) { const f32x4 w = *(const LAS f32x4*)(RW + e * 1024 + 4 * (lane + 64 * j)); const f32x4 y0 = yv[0][j], y1 = yv[1][j];
                    const f32x2 wl = (f32x2){w.x, w.y}, wh = (f32x2){w.z, w.w};
                    p0 += (f32x2){y0.x, y0.y} * wl; p0 += (f32x2){y0.z, y0.w} * wh; p1 += (f32x2){y1.x, y1.y} * wl; p1 += (f32x2){y1.z, y1.w} * wh; }
                float a0 = p0.x + p0.y, a1 = p1.x + p1.y;
                asm volatile("" : "+v"(a0), "+v"(a1) :: "memory");
                lg[0][e] = a0; lg[1][e] = a1; }
#pragma unroll
            for (int tk = 0; tk < 2; ++tk) { const int tok = tokb + 2 * it + tk, t = tok & (T - 1);
                float r8[8], r4[4], r2[2], r1;
#pragma unroll
                for (int k = 0; k < 8; ++k) { const float keep = u5 ? lg[tk][k + 8] : lg[tk][k], send = u5 ? lg[tk][k] : lg[tk][k + 8]; r8[k] = keep + __shfl_xor(send, 32); }
#pragma unroll
                for (int k = 0; k < 4; ++k) { const float keep = u4 ? r8[k + 4] : r8[k], send = u4 ? r8[k] : r8[k + 4]; r4[k] = keep + __shfl_xor(send, 16); }
#pragma unroll
                for (int k = 0; k < 2; ++k) { const float keep = u3 ? r4[k + 2] : r4[k], send = u3 ? r4[k] : r4[k + 2]; r2[k] = keep + __shfl_xor(send, 8); }
                { const float keep = u2 ? r2[1] : r2[0], send = u2 ? r2[0] : r2[1]; r1 = keep + __shfl_xor(send, 4); }
                r1 += __shfl_xor(r1, 1); r1 += __shfl_xor(r1, 2);
                float mx = r1;
                mx = fmaxf(mx, __shfl_xor(mx, 4)); mx = fmaxf(mx, __shfl_xor(mx, 8)); mx = fmaxf(mx, __shfl_xor(mx, 16)); mx = fmaxf(mx, __shfl_xor(mx, 32));
                const float ex = expf(r1 - mx);
                float den = ex;
                den += __shfl_xor(den, 4); den += __shfl_xor(den, 8); den += __shfl_xor(den, 16); den += __shfl_xor(den, 32);
                if ((lane & 3) == 0) AFF[((size_t)b * NE + emine) * T + t] = ex / den; }
#pragma unroll
            for (int tk = 0; tk < 2; ++tk)
#pragma unroll
                for (int j = 0; j < 4; ++j) xq[tk][j] = xn[tk][j];
        }
    }
}

__device__ __forceinline__ int block_scan512(int v, LAS int* sc, int tid, int& total) {
    const int lane = tid & 63, w = tid >> 6;
    int x = v;
#pragma unroll
    for (int o = 1; o < 64; o <<= 1) { const int y = __shfl_up(x, o); x += (lane >= o) ? y : 0; }
    if (lane == 63) sc[w] = x;
    __syncthreads();
    int base = 0, tot = 0;
#pragma unroll
    for (int i = 0; i < 8; ++i) { const int t = sc[i]; tot += t; base += (i < w) ? t : 0; }
    __syncthreads();
    total = tot; return base + x - v;
}
__device__ __forceinline__ void radix_round(const int (&bin)[8], const bool (&act)[8], int need, LAS int* hist, LAS int* sc, int tid, int& Bsel, int& aboveSel) {
#pragma unroll
    for (int q = 0; q < 8; ++q) hist[tid * 8 + q] = 0;
    __syncthreads();
#pragma unroll
    for (int q = 0; q < 8; ++q) if (act[q]) atomicAdd((int*)(hist + bin[q]), 1);
    __syncthreads();
    int c[8], ssum = 0;
#pragma unroll
    for (int q = 0; q < 8; ++q) { c[q] = hist[tid * 8 + q]; ssum += c[q]; }
    int total; const int P = block_scan512(ssum, sc, tid, total);
    int running = total - P - ssum;
#pragma unroll
    for (int q = 7; q >= 0; --q) { if (running < need && running + c[q] >= need) { sc[8] = tid * 8 + q; sc[9] = running; } running += c[q]; }
    __syncthreads();
    Bsel = sc[8]; aboveSel = sc[9];
    __syncthreads();
}
__device__ __forceinline__ void phase_topk(const Params& p, LAS unsigned char* lds, int bid, int G, int wv) {
    const int tid = my_tid(wv);
    const float* AFF = (const float*)(p.ws + WS_AFF);
    int* IDX = (int*)(p.ws + WS_IDX); float* VAL = (float*)(p.ws + WS_VAL); int* SEL = (int*)(p.ws + WS_SEL);
    LAS int* hist = (LAS int*)lds;
    LAS int* sc = (LAS int*)(lds + 16384);
    for (int item = bid; item < NB * NE; item += G) {
        const int b = item >> 4, e = item & 15;
        __syncthreads();
        const f32x4 v0 = ((const f32x4*)(AFF + (size_t)item * T))[2 * tid], v1 = ((const f32x4*)(AFF + (size_t)item * T))[2 * tid + 1];
        const float val[8] = {v0.x, v0.y, v0.z, v0.w, v1.x, v1.y, v1.z, v1.w};
        unsigned key[8]; int bin[8]; bool act[8];
#pragma unroll
        for (int q = 0; q < 8; ++q) { key[q] = __float_as_uint(val[q]); bin[q] = (int)(key[q] >> 20); act[q] = true; }
        int B1, ab1; radix_round(bin, act, CAP, hist, sc, tid, B1, ab1);
        const int need1 = CAP - ab1;
#pragma unroll
        for (int q = 0; q < 8; ++q) { act[q] = (int)(key[q] >> 20) == B1; bin[q] = (int)((key[q] >> 8) & 0xFFFu); }
        int B2, ab2; radix_round(bin, act, need1, hist, sc, tid, B2, ab2);
        const int need2 = need1 - ab2;
#pragma unroll
        for (int q = 0; q < 8; ++q) { act[q] = act[q] && (int)((key[q] >> 8) & 0xFFFu) == B2; bin[q] = (int)(key[q] & 0xFFu); }
        int B3, ab3; radix_round(bin, act, need2, hist, sc, tid, B3, ab3);
        const int need3 = need2 - ab3;
        const unsigned K = ((unsigned)B1 << 20) | ((unsigned)B2 << 8) | (unsigned)B3;
        int eqc = 0;
#pragma unroll
        for (int q = 0; q < 8; ++q) eqc += (key[q] == K) ? 1 : 0;
        int tot; int eqr = block_scan512(eqc, sc, tid, tot);
        bool selq[8]; int cnt = 0;
#pragma unroll
        for (int q = 0; q < 8; ++q) { const bool eq = key[q] == K; selq[q] = key[q] > K || (eq && eqr < need3); eqr += eq ? 1 : 0; cnt += selq[q] ? 1 : 0; }
        int slot = block_scan512(cnt, sc, tid, tot);
#pragma unroll
        for (int q = 0; q < 8; ++q) { const int tok = tid * 8 + q;
            SEL[(size_t)item * T + tok] = selq[q] ? slot : -1;
            if (selq[q]) { IDX[(e * NB + b) * CAP + slot] = b * T + tok; VAL[(e * NB + b) * CAP + slot] = val[q]; ++slot; } }
    }
}

__device__ __forceinline__ void phase_final(const Params& p, int bid, int G, int wv) {
    const int tid = my_tid(wv), lane = tid & 63, wave = tid >> 6;
    const bf16_t* X1 = (const bf16_t*)(p.ws + WS_X1); const bf16_t* DN = (const bf16_t*)(p.ws + WS_DN); const int* SEL = (const int*)(p.ws + WS_SEL);
    const float* fg = p.in[26];
    const int gw = bid * NWAVES + wave, NGW = G * NWAVES;
    for (int tok0 = gw; tok0 < MX; tok0 += 2 * NGW) {
        f32x4 v[2][4]; int sel[2]; unsigned long long mask[2];
#pragma unroll
        for (int tk = 0; tk < 2; ++tk) { const int tok = tok0 + tk * NGW, b = tok >> 12, t = tok & (T - 1);
            sel[tk] = lane < NE ? SEL[((size_t)b * NE + lane) * T + t] : -1;
#pragma unroll
            for (int j = 0; j < 4; ++j) v[tk][j] = up4(((const u32x2*)(X1 + (size_t)tok * D))[lane + 64 * j]); }
#pragma unroll
        for (int tk = 0; tk < 2; ++tk) mask[tk] = __ballot(sel[tk] >= 0);
#pragma unroll
        for (int tk = 0; tk < 2; ++tk) { const int tok = tok0 + tk * NGW, b = tok >> 12;
            unsigned long long m = mask[tk];
            while (m) {
#if MOE_FP8
                const unsigned char* rp[4]; float wg[4];
#pragma unroll
                for (int q = 0; q < 4; ++q) {
                    if (m) { const int e = __builtin_ctzll(m); m &= m - 1; const int s_ = __builtin_amdgcn_readlane(sel[tk], e);
                        rp[q] = (const unsigned char*)DN + ((size_t)(e * NB + b) * CAP + s_) * D; wg[q] = 1.f / 16.f; }
                    else { rp[q] = (const unsigned char*)DN; wg[q] = 0.f; } }
                unsigned w[4][4];
#pragma unroll
                for (int q = 0; q < 4; ++q)
#pragma unroll
                    for (int j = 0; j < 4; ++j) w[q][j] = *(const unsigned*)(rp[q] + 4 * (lane + 64 * j));
#pragma unroll
                for (int q = 0; q < 4; ++q)
#pragma unroll
                    for (int j = 0; j < 4; ++j) { const f32x2 lo = __builtin_amdgcn_cvt_pk_f32_fp8((int)w[q][j], false), hi = __builtin_amdgcn_cvt_pk_f32_fp8((int)w[q][j], true);
                        v[tk][j].x += wg[q] * lo.x; v[tk][j].y += wg[q] * lo.y; v[tk][j].z += wg[q] * hi.x; v[tk][j].w += wg[q] * hi.y; }
#else
                const bf16_t* rp[4]; float wg[4];
#pragma unroll
                for (int q = 0; q < 4; ++q) {
                    if (m) { const int e = __builtin_ctzll(m); m &= m - 1; const int s_ = __builtin_amdgcn_readlane(sel[tk], e);
                        rp[q] = DN + ((size_t)(e * NB + b) * CAP + s_) * D; wg[q] = 1.f; }
                    else { rp[q] = DN; wg[q] = 0.f; } }
                u32x2 w[4][4];
#pragma unroll
                for (int q = 0; q < 4; ++q)
#pragma unroll
                    for (int j = 0; j < 4; ++j) w[q][j] = *(const u32x2*)(rp[q] + 4 * (lane + 64 * j));
#pragma unroll
                for (int q = 0; q < 4; ++q)
#pragma unroll
                    for (int j = 0; j < 4; ++j) { v[tk][j].x += wg[q] * bflo(w[q][j].x); v[tk][j].y += wg[q] * bfhi(w[q][j].x); v[tk][j].z += wg[q] * bflo(w[q][j].y); v[tk][j].w += wg[q] * bfhi(w[q][j].y); }
#endif
            } }
#pragma unroll
        for (int tk = 0; tk < 2; ++tk) { const int tok = tok0 + tk * NGW;
            float ss = 0.f;
#pragma unroll
            for (int j = 0; j < 4; ++j) ss += (v[tk][j].x * v[tk][j].x + v[tk][j].y * v[tk][j].y) + (v[tk][j].z * v[tk][j].z + v[tk][j].w * v[tk][j].w);
            const float rstd = rsqrtf(wave_sum(ss) * (1.f / D) + 1e-6f);
#pragma unroll
            for (int j = 0; j < 4; ++j) { const int col = 4 * (lane + 64 * j); const f32x4 g = *(const f32x4*)(fg + col);
                *(f32x4*)(p.out + (size_t)tok * D + col) = v[tk][j] * rstd * g; } }
    }
}

#define XB_TMO      128
#define XB_XCNT(j)  (256  + 64 * (j))
#define XB_XSUB(j)  (1280 + 64 * (j))
#define XB_XGEN(j)  (2304 + 64 * (j))
#define XB_TOP      3328
#define XB_TOPGEN   3392
#define XCD_BAR_WORDS 3456
#define XB_SPIN_CAP (1u << 20)
__device__ __forceinline__ unsigned xb_ld(unsigned* p)              { return __hip_atomic_load(p, __ATOMIC_RELAXED, __HIP_MEMORY_SCOPE_AGENT); }
__device__ __forceinline__ unsigned xb_add(unsigned* p, unsigned v) { return __hip_atomic_fetch_add(p, v, __ATOMIC_RELAXED, __HIP_MEMORY_SCOPE_AGENT); }
__device__ __forceinline__ unsigned xb_xcc_id() { return (unsigned)__builtin_amdgcn_s_getreg((3 << 11) | 20) & 0xFu; }
#define XB_SPIN(cond, bar) do { unsigned _sp = 0; while (cond) { __builtin_amdgcn_s_sleep(1); \
    if ((++_sp & 255u) == 0u) { if (xb_ld(&(bar)[XB_TMO])) break; if (_sp > XB_SPIN_CAP) { atomicAdd(&(bar)[XB_TMO], 1u); break; } } } } while (0)
struct XcdBarrier { unsigned* bar; unsigned x; volatile LAS unsigned* st; int wv; };
__device__ __forceinline__ XcdBarrier xcd_barrier_post(unsigned* bar, volatile LAS unsigned* st, int wv) {
    XcdBarrier b; b.bar = bar; b.x = xb_xcc_id(); b.st = st; b.wv = wv;
    if (my_tid(wv) == 0) (void)xb_add(&bar[XB_XCNT(b.x)], 1u);
    return b;
}
__device__ __forceinline__ void xcd_barrier_complete(unsigned* bar, unsigned x, unsigned& nloc, unsigned& nx) {
    const unsigned G = gridDim.x * gridDim.y * gridDim.z;
    unsigned sum, cnt, mine, sp = 0u;
    for (;;) {
        sum = 0u; cnt = 0u; mine = 0u;
#pragma unroll
        for (unsigned j = 0; j < 16; ++j) { const unsigned c = xb_ld(&bar[XB_XCNT(j)]); sum += c; cnt += (c > 0u) ? 1u : 0u; mine = (j == x) ? c : mine; }
        if (sum == G) break;
        __builtin_amdgcn_s_sleep(1);
        if ((++sp & 255u) == 0u) { if (xb_ld(&bar[XB_TMO])) break; if (sp > XB_SPIN_CAP) { atomicAdd(&bar[XB_TMO], 1u); break; } }
    }
    nloc = mine > 0u ? mine : 1u; nx = cnt > 0u ? cnt : 1u;
}
__device__ __forceinline__ void xcd_barrier(const XcdBarrier& b) {
    asm volatile("s_waitcnt vmcnt(0)" ::: "memory");
    __syncthreads();
    if (my_tid(b.wv) == 0) {
        unsigned* bar = b.bar;
        __builtin_amdgcn_s_waitcnt(0);
        unsigned nloc = b.st[0], nx = b.st[1];
        if (nloc == 0u) { xcd_barrier_complete(bar, b.x, nloc, nx); b.st[0] = nloc; b.st[1] = nx; }
        const unsigned old = xb_add(&bar[XB_XSUB(b.x)], 1u);
        const unsigned gen = old / nloc;
        if (old + 1u == (gen + 1u) * nloc) {
            __builtin_amdgcn_fence(__ATOMIC_RELEASE, "agent");
            asm volatile("s_waitcnt vmcnt(0)" ::: "memory");
            const unsigned og = xb_add(&bar[XB_TOP], 1u);
            const unsigned tg = og / nx;
            if (og + 1u == (tg + 1u) * nx) xb_add(&bar[XB_TOPGEN], 1u);
            else XB_SPIN(xb_ld(&bar[XB_TOPGEN]) == tg, bar);
            __builtin_amdgcn_fence(__ATOMIC_ACQUIRE, "agent");
            xb_add(&bar[XB_XGEN(b.x)], 1u);
            asm volatile("s_waitcnt vmcnt(0)" ::: "memory");
        } else {
            XB_SPIN(xb_ld(&bar[XB_XGEN(b.x)]) == gen, bar);
            __builtin_amdgcn_fence(__ATOMIC_ACQUIRE, "agent");
            asm volatile("s_waitcnt vmcnt(0)" ::: "memory");
        }
    }
    __syncthreads();
}

constexpr int N_PHASES = 12;
__global__ void __launch_bounds__(NTHR, 2) mk_fwd(Params p) {
    extern __shared__ __attribute__((aligned(16))) unsigned char lds_raw[];
    LAS unsigned char* lds = (LAS unsigned char*)lds_raw;
    const int bid = blockIdx.x, G = gridDim.x;
    const int wv = __builtin_amdgcn_readfirstlane((int)threadIdx.x >> 6);
    const int lo = p.ph_lo, hi = p.ph_hi;
#if MK_FUSED
    volatile LAS unsigned* misc = (volatile LAS unsigned*)(lds + LDS_MISC);
    { const int t0 = my_tid(wv); if (t0 < 16) misc[t0] = 0u; }
    __syncthreads();
    const XcdBarrier xbar = xcd_barrier_post((unsigned*)(p.ws + WS_CTL) + 4096, misc, wv);
#define SEAM(k) do { if (lo <= (k) && (k) + 1 < hi) xcd_barrier(xbar); } while (0)
#else
#define SEAM(k) do { } while (0)
#endif
#ifndef PH_MASK
#define PH_MASK 0xFFF
#endif
#ifndef PH_REP
#define PH_REP 0
#endif
#define NREP(k) ((((PH_REP) >> (k)) & 1) ? 2 : 1)
#define IN(k) (((PH_MASK >> (k)) & 1) && lo <= (k) && (k) < hi)
    unsigned char* ws = sgpr_ptr(p.ws); unsigned char* outs = sgpr_ptr(p.out);
    if (IN(0)) { for (int r = 0; r < NREP(0); ++r) { phase0(p, lds, bid, G, wv); __syncthreads(); } SEAM(0); }
    if (IN(1)) { for (int r = 0; r < NREP(1); ++r) phase1(p, bid, G, wv); SEAM(1); }
    if (IN(2)) {
        pg8::Gemm g{(const bf16_t*)(ws + WS_XN), (const bf16_t*)(ws + WS_WINT), MALL, DIN, D, nullptr};
        pg8::InProjOrder S; S.init(G, bid);
        pg8::EpiBf16Plain E{(bf16_t*)(ws + WS_PX), DIN};
        pg8::gemm_phase<pg8::EpiBf16Plain, pg8::InProjOrder, true, true, false, false, PG8_BUF_IN>(lds, g, S, E, wv);
        SEAM(2);
    }
    for (int rep = 0; rep < NREP(4); ++rep) {
    if (IN(3)) { for (int r3 = 0; r3 < NREP(3); ++r3) phase_scanX(p, lds, bid, G, wv); SEAM(3); }
    if (IN(4)) { phase_scanS(p, lds, bid, G, wv); SEAM(4); }
    }
    if (IN(5)) { for (int r = 0; r < NREP(5); ++r) phase_out(p, lds, bid, G, wv); SEAM(5); }
    if (IN(6)) {
        pg8::Gemm g{(const bf16_t*)(ws + WS_AX), (const bf16_t*)(ws + WS_WOUTT), MX, D, D, nullptr};
        pg8::StaticOrder S; S.init(MX, D, G, bid);
        pg8::EpiResid E{p.in[0], (bf16_t*)(ws + WS_X1), (const float*)(ws + WS_MOD)};
        pg8::gemm_phase<pg8::EpiResid, pg8::StaticOrder, true, true, false, false, PG8_BUF_OUT>(lds, g, S, E, wv);
        SEAM(6);
    }
    if (IN(7)) { for (int r = 0; r < NREP(7); ++r) { phase_hx(p, lds, bid, G, wv); __syncthreads(); }
#if CVPOS == 0
        { const int tid = my_tid(wv), lane = tid & 63, gw = bid * NWAVES + (tid >> 6);
          for (int g = gw; g < 3 * 8192; g += G * NWAVES) { f32x4 cv[8]; xcvt_load(p, g, lane, cv); xcvt_store(p, g, lane, cv); } }
#endif
        SEAM(7); }
    if (IN(8)) { for (int r = 0; r < NREP(8); ++r) phase_topk(p, lds, bid, G, wv); SEAM(8); }
    if (IN(9)) {
        pg8::Gemm g{(const bf16_t*)(ws + WS_HX), (const bf16_t*)outs, NE * NB * CAP, NE * 2048, MOE_FP8 ? D / 2 : D, (const int*)(ws + WS_IDX)};
        pg8::ExpertOrder S; S.init(NE, 16, 8, G, bid);
        pg8::EpiSwiGLU E{ws + WS_HID};
        pg8::gemm_phase<pg8::EpiSwiGLU, pg8::ExpertOrder, true, true, true, MOE_FP8 != 0, PG8_BUF_MOE1>(lds, g, S, E, wv);
        SEAM(9);
    }
    if (IN(10)) {
        pg8::Gemm g{(const bf16_t*)(ws + WS_HID), (const bf16_t*)(outs + OUT_W2T), NE * NB * CAP, NE * 1024, MOE_FP8 ? DE / 2 : DE, nullptr};
        pg8::ExpertOrder S; S.init(NE, 16, 4, G, bid);
        pg8::EpiDown E{(bf16_t*)(ws + WS_DN), (const float*)(ws + WS_VAL), (const float*)(ws + WS_MOD)};
        pg8::gemm_phase<pg8::EpiDown, pg8::ExpertOrder, true, true, false, MOE_FP8 != 0, PG8_BUF_MOE2>(lds, g, S, E, wv);
        SEAM(10);
    }
    if (IN(11)) { for (int r = 0; r < NREP(11); ++r) phase_final(p, bid, G, wv); }
#undef IN
#undef SEAM
}

extern "C" void kernel_launch(void* const* d_in, const int* in_sizes, int n_in, void* d_out, int out_size, void* d_ws, size_t ws_size, hipStream_t stream) {
    static int grid = 0;
    if (grid == 0) {
        if (n_in != 27 || out_size != MX * D || ws_size < WS_END) { fprintf(stderr, "kernel_launch: unexpected shapes: n_in %d out %d ws %zu (need %zu)\n", n_in, out_size, ws_size, (size_t)WS_END); grid = -1; return; }
        int dev = 0, cus = 0, per_cu = 0;
        hipGetDevice(&dev); hipDeviceGetAttribute(&cus, hipDeviceAttributeMultiprocessorCount, dev);
        hipFuncSetAttribute((const void*)mk_fwd, hipFuncAttributeMaxDynamicSharedMemorySize, LDS_BYTES);
        hipOccupancyMaxActiveBlocksPerMultiprocessor(&per_cu, (const void*)mk_fwd, NTHR, LDS_BYTES);
        if (per_cu < 1) { fprintf(stderr, "kernel_launch: occupancy query says %d blocks per CU\n", per_cu); per_cu = 1; }
        (void)hipGetLastError();
        grid = cus;
    }
    if (grid < 0) return;
    Params p{};
    for (int i = 0; i < 27; ++i) p.in[i] = (const float*)d_in[i];
    p.out = (float*)d_out; p.ws = (unsigned char*)d_ws;
#if MK_FUSED
    (void)hipMemsetAsync((char*)d_ws + WS_CTL, 0, 65536, stream);
    p.ph_lo = 0; p.ph_hi = N_PHASES;
    void* args[] = {&p};
    hipError_t e = hipLaunchCooperativeKernel((const void*)mk_fwd, dim3(grid), dim3(NTHR), args, LDS_BYTES, stream);
    if (e != hipSuccess) fprintf(stderr, "cooperative launch failed: %s (grid %d)\n", hipGetErrorString(e), grid);
#else
    for (int ph = 0; ph < N_PHASES; ++ph) {
        p.ph_lo = ph; p.ph_hi = ph + 1;
        hipLaunchKernelGGL(mk_fwd, dim3(grid), dim3(NTHR), LDS_BYTES, stream, p);
    }
#endif
}
```

```cpp
#include <hip/hip_runtime.h>
#include <hip/hip_cooperative_groups.h>
#include <cstdio>
#include <cstdint>
namespace cg = cooperative_groups;

#ifndef MK_FUSED
#define MK_FUSED 1
#endif

#define LAS __attribute__((address_space(3)))
typedef unsigned short bf16_t;
typedef short bf16x8 __attribute__((ext_vector_type(8)));
typedef float f32x4 __attribute__((ext_vector_type(4)));
typedef unsigned u32x4 __attribute__((ext_vector_type(4)));
typedef unsigned u32x2 __attribute__((ext_vector_type(2)));
typedef int i32x8 __attribute__((ext_vector_type(8)));
typedef float f32x2 __attribute__((ext_vector_type(2)));
typedef int i32x4 __attribute__((ext_vector_type(4)));

#ifndef PG8_BUF_MOE1
#define PG8_BUF_MOE1 1
#endif
#ifndef PG8_BUF_MOE2
#define PG8_BUF_MOE2 1
#endif
#ifndef PG8_BUF_IN
#define PG8_BUF_IN 0
#endif
#ifndef PG8_BUF_OUT
#define PG8_BUF_OUT 0
#endif
#ifndef MOE_FP8
#define MOE_FP8 1
#endif
#ifndef XSCOPE
#define XSCOPE 0
#endif
#ifndef CVPOS
#define CVPOS 1
#endif
constexpr int NB = 8, T = 4096, D = 1024, CTXL = 256, DIN = 3328, RWC = 1792, NH = 8, HD = 64, DR = 512;
constexpr int NE = 16, CAP = 512, DE = 1024;
constexpr int MX = NB * T;
constexpr int MC = NB * CTXL;
constexpr int MALL = MX + MC;
constexpr int NWAVES = 8, NTHR = 512;
constexpr int LDS_BYTES = 163840;
constexpr int LDS_MISC = 154368;

constexpr size_t MiB = 1u << 20;
constexpr size_t WS_CTL = 0;
constexpr size_t WS_MOD = 1 * MiB;
constexpr size_t WS_BDOT = 2 * MiB;
constexpr size_t WS_AFF = 4 * MiB;
constexpr size_t WS_SEL = 6 * MiB;
constexpr size_t WS_GAM = 8 * MiB;
constexpr size_t WS_WOUTT = 11 * MiB;
constexpr size_t WS_IDX = 13 * MiB;
constexpr size_t WS_VAL = 13 * MiB + 256 * 1024;
constexpr size_t WS_MLR = 16 * MiB;
constexpr size_t WS_YF = 84 * MiB;
constexpr size_t WS_PX = 116 * MiB;
constexpr size_t WS_NT = 337 * MiB;
constexpr size_t WS_RB = 405 * MiB;
constexpr size_t WS_YB = 469 * MiB;
constexpr size_t WS_XN = 337 * MiB;
constexpr size_t WS_WINT = 405 * MiB;
constexpr size_t WS_AX = 337 * MiB;
constexpr size_t WS_X1 = 112 * MiB;
constexpr size_t WS_HX = 240 * MiB;
constexpr size_t WS_HID = 368 * MiB;
constexpr size_t WS_DN = 240 * MiB;
constexpr size_t WS_END = 501 * MiB;

struct Params { const float* in[27]; float* out; unsigned char* ws; int ph_lo, ph_hi; };

__device__ __forceinline__ unsigned f2bf(float f) { unsigned u = __float_as_uint(f); return (u + 0x7fffu + ((u >> 16) & 1u)) >> 16; }
typedef __bf16 hwbf16x2 __attribute__((ext_vector_type(2)));
typedef float f32x2_ __attribute__((ext_vector_type(2)));
__device__ __forceinline__ unsigned pk2(float lo, float hi) { const f32x2_ v = {lo, hi}; return __builtin_bit_cast(unsigned, __builtin_convertvector(v, hwbf16x2)); }
__device__ __forceinline__ float bflo(unsigned w) { return __uint_as_float(w << 16); }
__device__ __forceinline__ float bfhi(unsigned w) { return __uint_as_float(w & 0xffff0000u); }
__device__ __forceinline__ void unpack8(const u32x4 w, float (&f)[8]) {
    f[0] = bflo(w.x); f[1] = bfhi(w.x); f[2] = bflo(w.y); f[3] = bfhi(w.y); f[4] = bflo(w.z); f[5] = bfhi(w.z); f[6] = bflo(w.w); f[7] = bfhi(w.w); }
__device__ __forceinline__ u32x4 pack8(const float (&f)[8]) { u32x4 w; w.x = pk2(f[0], f[1]); w.y = pk2(f[2], f[3]); w.z = pk2(f[4], f[5]); w.w = pk2(f[6], f[7]); return w; }
__device__ __forceinline__ float wave_sum(float v) {
#pragma unroll
    for (int o = 1; o < 64; o <<= 1) v += __shfl_xor(v, o);
    return v;
}
__device__ __forceinline__ float wave_max(float v) {
#pragma unroll
    for (int o = 1; o < 64; o <<= 1) v = fmaxf(v, __shfl_xor(v, o));
    return v;
}
__device__ __forceinline__ float red8(float v) {
    v += __int_as_float(__builtin_amdgcn_update_dpp(0, __float_as_int(v), 0xB1, 0xF, 0xF, true));
    v += __int_as_float(__builtin_amdgcn_update_dpp(0, __float_as_int(v), 0x4E, 0xF, 0xF, true));
    v += __int_as_float(__builtin_amdgcn_update_dpp(0, __float_as_int(v), 0x141, 0xF, 0xF, true));
    return v;
}
__device__ __forceinline__ float sigmoidf_(float x) { return 1.f / (1.f + expf(-x)); }
__device__ __forceinline__ float fsigmoid(float x) { return __builtin_amdgcn_rcpf(1.f + __expf(-x)); }
__device__ __forceinline__ float ftanh(float x) { return 1.f - 2.f * __builtin_amdgcn_rcpf(1.f + __expf(2.f * x)); }

__device__ __forceinline__ float sat8(float x) { return __builtin_amdgcn_fmed3f(x, -448.f, 448.f); }
__device__ __forceinline__ unsigned pk4_fp8_raw(float a, float b, float c, float d) {
    int w = __builtin_amdgcn_cvt_pk_fp8_f32(a, b, 0, false); w = __builtin_amdgcn_cvt_pk_fp8_f32(c, d, w, true); return (unsigned)w; }
__device__ __forceinline__ unsigned pk4_fp8(float a, float b, float c, float d) { return pk4_fp8_raw(sat8(a), sat8(b), sat8(c), sat8(d)); }
constexpr float W8_SCALE = 64.f;
__device__ __forceinline__ int opq(int x) { asm volatile("" : "+v"(x)); return x; }
__device__ __forceinline__ int my_tid(int wv) { int l; asm volatile("v_mbcnt_lo_u32_b32 %0, -1, 0\n\tv_mbcnt_hi_u32_b32 %0, -1, %0" : "=v"(l)); return (wv << 6) | l; }
__device__ __forceinline__ unsigned char* sgpr_ptr(const void* q) {
    const unsigned long long v = (unsigned long long)(size_t)q;
    return (unsigned char*)(((unsigned long long)(unsigned)__builtin_amdgcn_readfirstlane((int)(v >> 32)) << 32) | (unsigned)__builtin_amdgcn_readfirstlane((int)(unsigned)v)); }
namespace pg8 {
#define PG8_LAS __attribute__((address_space(3)))
constexpr int BM = 256, BK = 64, HALF = 128, HTB = HALF * BK * 2, STAGE_BYTES = 8 * HTB, NXCD = 8, WGM = 8;
__host__ __device__ __forceinline__ int lds_byte(int r, int c) { const int st = (r >> 4) * 2 + (c >> 5), rr = r & 15, cc = c & 31, ob = rr * 64 + cc * 2; return st * 1024 + (ob ^ (((ob >> 9) & 1) << 5)); }
__host__ __device__ __forceinline__ void stage_rc(int b, int& R, int& C) { const int st = b / 1024, sb = b % 1024, swz = sb ^ (((sb >> 9) & 1) << 5); R = (st >> 1) * 16 + swz / 64; C = (st & 1) * 32 + (swz % 64) / 2; }
__host__ __device__ __forceinline__ int perm32(int rho) { const int n = rho >> 4, i = rho & 15; return 8 * (i >> 2) + 4 * n + (i & 3); }
struct Unit { int pm, pn; };
constexpr float WSC = MOE_FP8 ? 1.f / 64.f : 1.f;
struct Gemm { const bf16_t* A; const bf16_t* Bt; int M, N, K; const int* rowmap; };

__device__ __forceinline__ int xcd_remap(int wgid, int nwg) { const int q = nwg / NXCD, r = nwg % NXCD, xcd = wgid % NXCD, off = wgid / NXCD; return (xcd < r ? xcd * (q + 1) : r * (q + 1) + (xcd - r) * q) + off; }

struct StaticOrder {
    int nM, nN, nwg, G, c;
    __device__ void init(int M, int N, int G_, int c_) { nM = M / BM; nN = N / BM; nwg = nM * nN; G = G_; c = c_; }
    __device__ bool next(int i, Unit& u) const {
        const long L = (long)i * G + c; if (L >= nwg) return false;
        int wgid = xcd_remap((int)L, nwg);
        const int nig = WGM * nN, gid = wgid / nig, fm = gid * WGM, gsz = (nM - fm) < WGM ? (nM - fm) : WGM;
        u.pm = fm + ((wgid % nig) % gsz); u.pn = (wgid % nig) / gsz; return true;
    }
    __device__ __forceinline__ void a_ready(const Unit&) const {}
    __device__ __forceinline__ void done(const Unit&) const {}
};
struct InProjOrder {
    StaticOrder so; int G, c;
    __device__ void init(int G_, int c_) { so.init(MX, DIN, G_, c_); G = G_; c = c_; }
    __device__ bool next(int i, Unit& u) const {
        const long L = (long)i * G + c;
        if (L < so.nwg) return so.next(i, u);
        const int j = (int)(L - so.nwg); if (j >= 56) return false;
        u.pm = 128 + (j & 7); u.pn = j >> 3; return true;
    }
    __device__ __forceinline__ void a_ready(const Unit&) const {}
    __device__ __forceinline__ void done(const Unit&) const {}
};
struct ExpertOrder {
    int nPM, nPN, nwg, G, c;
    __device__ void init(int nE, int nPM_, int nPN_, int G_, int c_) { nPM = nPM_; nPN = nPN_; nwg = nE * nPM_ * nPN_; G = G_; c = c_; }
    __device__ bool next(int i, Unit& u) const {
        const long L = (long)i * G + c; if (L >= nwg) return false;
        const int wgid = xcd_remap((int)L, nwg);
        const int per = nPM * nPN, e = wgid / per, r = wgid % per;
        u.pm = e * nPM + (r % nPM); u.pn = e * nPN + (r / nPM); return true;
    }
    __device__ __forceinline__ void a_ready(const Unit&) const {}
    __device__ __forceinline__ void done(const Unit&) const {}
};

struct EpiBf16Plain {
    static constexpr bool PERM = true, AFTER_DRAIN = false;
    bf16_t* O; int ldc;
    __device__ __forceinline__ void operator()(const f32x4 (&acc)[2][2][4][2], const Unit& u, int wr, int wc, int fr, int fq) const {
        const int row0 = u.pm * BM + wr * 64 + fr, col0 = u.pn * BM + wc * 32 + 8 * fq;
#pragma unroll
        for (int ai = 0; ai < 2; ++ai)
#pragma unroll
            for (int m = 0; m < 4; ++m) { bf16_t* rowp = O + (size_t)(row0 + ai * HALF + m * 16) * ldc + col0;
#pragma unroll
                for (int bj = 0; bj < 2; ++bj) { const f32x4 v0 = acc[ai][bj][m][0], v1 = acc[ai][bj][m][1];
                    u32x4 w; w.x = pk2(v0[0], v0[1]); w.y = pk2(v0[2], v0[3]); w.z = pk2(v1[0], v1[1]); w.w = pk2(v1[2], v1[3]);
                    *(u32x4*)(rowp + bj * HALF) = w; } }
    }
};
struct EpiResid {
    static constexpr bool PERM = true, AFTER_DRAIN = false;
    const float* x; bf16_t* X1; const float* mod;
    __device__ __forceinline__ void operator()(const f32x4 (&acc)[2][2][4][2], const Unit& u, int wr, int wc, int fr, int fq) const {
        const int row0 = u.pm * BM + wr * 64 + fr, col0 = u.pn * BM + wc * 32 + 8 * fq;
        const float* g1 = mod + (size_t)(u.pm >> 4) * 6144 + 2048;
        f32x4 gv[2][2];
#pragma unroll
        for (int bj = 0; bj < 2; ++bj)
#pragma unroll
            for (int n = 0; n < 2; ++n) gv[bj][n] = *(const f32x4*)(g1 + col0 + bj * HALF + n * 4);
#pragma unroll
        for (int ai = 0; ai < 2; ++ai) { f32x4 xr[4][2][2];
#pragma unroll
            for (int m = 0; m < 4; ++m) { const size_t off = (size_t)(row0 + ai * HALF + m * 16) * D + col0;
#pragma unroll
                for (int bj = 0; bj < 2; ++bj) { xr[m][bj][0] = *(const f32x4*)(x + off + bj * HALF); xr[m][bj][1] = *(const f32x4*)(x + off + bj * HALF + 4); } }
#pragma unroll
            for (int m = 0; m < 4; ++m) { const size_t off = (size_t)(row0 + ai * HALF + m * 16) * D + col0;
#pragma unroll
                for (int bj = 0; bj < 2; ++bj) { const f32x4 v0 = xr[m][bj][0] + gv[bj][0] * acc[ai][bj][m][0], v1 = xr[m][bj][1] + gv[bj][1] * acc[ai][bj][m][1];
                    u32x4 w; w.x = pk2(v0[0], v0[1]); w.y = pk2(v0[2], v0[3]); w.z = pk2(v1[0], v1[1]); w.w = pk2(v1[2], v1[3]);
                    *(u32x4*)(X1 + off + bj * HALF) = w; } } }
    }
};
struct EpiSwiGLU {
    static constexpr bool PERM = true, AFTER_DRAIN = false;
    unsigned char* H;
    __device__ __forceinline__ void operator()(const f32x4 (&acc)[2][2][4][2], const Unit& u, int wr, int wc, int fr, int fq) const {
        const int row0 = u.pm * BM + wr * 64 + fr, col0 = (u.pn & 7) * 128 + wc * 32 + 8 * fq;
        const __amdgpu_buffer_rsrc_t rsH = __builtin_amdgcn_make_buffer_rsrc((void*)H, 0, 0x80000000u, 0x00020000);
#pragma unroll
        for (int ai = 0; ai < 2; ++ai)
#pragma unroll
            for (int m = 0; m < 4; ++m) { float h[8];
#pragma unroll
                for (int n = 0; n < 2; ++n)
#pragma unroll
                    for (int q = 0; q < 4; ++q) { const float g = acc[ai][0][m][n][q] * WSC, up = acc[ai][1][m][n][q] * WSC; h[n * 4 + q] = g / (1.f + __expf(-g)) * up; }
#if MOE_FP8
                u32x2 w; w.x = pk4_fp8(h[0], h[1], h[2], h[3]); w.y = pk4_fp8(h[4], h[5], h[6], h[7]);
                __builtin_amdgcn_raw_buffer_store_b64(w, rsH, (unsigned)((row0 + ai * HALF + m * 16) * DE + col0), 0, 0); }
#else
                u32x4 w; w.x = pk2(h[0], h[1]); w.y = pk2(h[2], h[3]); w.z = pk2(h[4], h[5]); w.w = pk2(h[6], h[7]);
                *(u32x4*)((bf16_t*)H + (size_t)(row0 + ai * HALF + m * 16) * DE + col0) = w; }
#endif
    }
};
struct EpiDown {
    static constexpr bool PERM = true, AFTER_DRAIN = false;
    bf16_t* O; const float* val; const float* mod;
    __device__ __forceinline__ void operator()(const f32x4 (&acc)[2][2][4][2], const Unit& u, int wr, int wc, int fr, int fq) const {
        const int row0 = u.pm * BM + wr * 64 + fr, col0 = (u.pn & 3) * BM + wc * 32 + 8 * fq;
        const int b = (u.pm & 15) >> 1;
        const unsigned char* mods = sgpr_ptr(mod); const unsigned char* vals_ = sgpr_ptr(val); unsigned char* Os = sgpr_ptr(O);
        f32x4 gv[2][2];
#pragma unroll
        for (int bj = 0; bj < 2; ++bj)
#pragma unroll
            for (int n = 0; n < 2; ++n) gv[bj][n] = *(const f32x4*)(mods + (size_t)(unsigned)((b * 6144 + 5120 + col0 + bj * HALF + n * 4) * 4));
        float vals[2][4];
#pragma unroll
        for (int ai = 0; ai < 2; ++ai)
#pragma unroll
            for (int m = 0; m < 4; ++m) vals[ai][m] = *(const float*)(vals_ + (size_t)(unsigned)((row0 + ai * HALF + m * 16) * 4));
#pragma unroll
        for (int ai = 0; ai < 2; ++ai)
#pragma unroll
#if MOE_FP8
            for (int m = 0; m < 4; ++m) { const int row = row0 + ai * HALF + m * 16; const float vv = vals[ai][m] * 0.25f; unsigned char* rowp = Os + (size_t)(unsigned)(row * D + col0);
#pragma unroll
                for (int bj = 0; bj < 2; ++bj) { const f32x4 v0 = acc[ai][bj][m][0] * gv[bj][0] * vv, v1 = acc[ai][bj][m][1] * gv[bj][1] * vv;
                    u32x2 w; w.x = pk4_fp8(v0[0], v0[1], v0[2], v0[3]); w.y = pk4_fp8(v1[0], v1[1], v1[2], v1[3]);
                    *(u32x2*)(Os + (size_t)(unsigned)(row * D + col0 + bj * HALF)) = w; } }
#else
            for (int m = 0; m < 4; ++m) { const int row = row0 + ai * HALF + m * 16; const float vv = vals[ai][m] * WSC; bf16_t* rowp = (bf16_t*)Os + (size_t)row * D + col0;
#pragma unroll
                for (int bj = 0; bj < 2; ++bj) { const f32x4 v0 = acc[ai][bj][m][0] * gv[bj][0] * vv, v1 = acc[ai][bj][m][1] * gv[bj][1] * vv;
                    u32x4 w; w.x = pk2(v0[0], v0[1]); w.y = pk2(v0[2], v0[3]); w.z = pk2(v1[0], v1[1]); w.w = pk2(v1[2], v1[3]);
                    *(u32x4*)(rowp + bj * HALF) = w; } }
#endif
    }
};

template <class Epi, class Sched, bool ALIGN_EPI = false, bool SP2 = false, bool GATHER = false, bool FP8 = false, int BUF = 0>
__device__ __forceinline__ void gemm_phase(PG8_LAS unsigned char* lds, const Gemm g, const Sched& S, const Epi& E, int wv) {
    const int tid = my_tid(wv), wid = __builtin_amdgcn_readfirstlane(tid >> 6), lane = tid & 63, wr = wid >> 2, wc = wid & 3, fr = lane & 15, fq = lane >> 4;
    const int K = g.K, nt = K / BK;
    unsigned voffA[2], voffB[2]; int gR[2]; unsigned gC[2];
#pragma unroll
    for (int i = 0; i < 2; ++i) { int R, C; stage_rc(tid * 16 + i * 8192, R, C); const int Rb = Epi::PERM ? ((R & ~31) + perm32(R & 31)) : R;
        voffA[i] = (unsigned)(R * K + C) * 2u; voffB[i] = (unsigned)(Rb * K + C) * 2u; gR[i] = R; gC[i] = (unsigned)C * 2u; }
    const __amdgpu_buffer_rsrc_t rsM = __builtin_amdgcn_make_buffer_rsrc((void*)g.rowmap, 0, 0x80000000u, 0x00020000);
    unsigned gAc[2][2], gAn[2][2];
#define PG8_GLOAD(dst, pm_) do { const int _t = my_tid(wv); _Pragma("unroll") for (int _i = 0; _i < 2; ++_i) { int _R, _C; stage_rc(_t * 16 + _i * 8192, _R, _C);     \
        _Pragma("unroll") for (int _h = 0; _h < 2; ++_h) dst[_h][_i] = (unsigned)__builtin_amdgcn_raw_buffer_load_b32(rsM, (unsigned)(((pm_) * BM + _h * HALF + _R) * 4), 0, 0) * (unsigned)(K * 2) + (unsigned)_C * 2u; } } while (0)
    const unsigned kstep = (unsigned)(BK * 2);
    const unsigned hstep = (unsigned)(HALF * K * 2);
    const unsigned tstep = 2u * hstep;
    const unsigned long long uA = ((unsigned long long)(unsigned)__builtin_amdgcn_readfirstlane((int)((unsigned long long)(size_t)g.A >> 32)) << 32) | (unsigned)__builtin_amdgcn_readfirstlane((int)(unsigned)(size_t)g.A);
    const unsigned long long uB = ((unsigned long long)(unsigned)__builtin_amdgcn_readfirstlane((int)((unsigned long long)(size_t)g.Bt >> 32)) << 32) | (unsigned)__builtin_amdgcn_readfirstlane((int)(unsigned)(size_t)g.Bt);
    const __amdgpu_buffer_rsrc_t rsA = __builtin_amdgcn_make_buffer_rsrc((void*)uA, 0, 0x80000000u, 0x00020000);
    const __amdgpu_buffer_rsrc_t rsB = __builtin_amdgcn_make_buffer_rsrc((void*)uB, 0, 0x80000000u, 0x00020000);
    const unsigned ldsw = (unsigned)wid * 1024u;
    const int aoff = lds_byte(wr * 64 + fr, fq * 8), boff = lds_byte(wc * 32 + fr, fq * 8);
#define PG8_SA(b, h) (((b) * 2 + (h)) * HTB)
#define PG8_SB(b, h) ((4 + (b) * 2 + (h)) * HTB)
#define PG8_GLDS(ldsp, v32, gp) asm volatile("s_mov_b32 m0, %0\n\ts_nop 0\n\tglobal_load_lds_dwordx4 %1, %2" :: "s"(__builtin_amdgcn_readfirstlane((int)(size_t)(ldsp))), "v"(v32), "s"(gp) : "memory", "m0")
#define PG8_STAGE(bufoff, goff, voff) do { _Pragma("unroll") for (int _i = 0; _i < 2; ++_i) { \
        if constexpr (BUF == 1 || BUF == 3) __builtin_amdgcn_raw_ptr_buffer_load_lds(rsB, (PG8_LAS void*)(lds + (bufoff) + ldsw + _i * 8192), 16, (voff)[_i], (goff), 0, 0); \
        else if constexpr (BUF == 2) PG8_GLDS(lds + (bufoff) + ldsw + _i * 8192, (voff)[_i] + (unsigned)__builtin_amdgcn_readfirstlane((int)(goff)), (const char*)uB); \
        else __builtin_amdgcn_global_load_lds((const unsigned*)((const char*)g.Bt + (size_t)((goff) + (voff)[_i])), (PG8_LAS unsigned*)(lds + (bufoff) + ldsw + _i * 8192), 16, 0, 0); } } while (0)
#define PG8_STA(bufoff, koff, h, nx) do { _Pragma("unroll") for (int _i = 0; _i < 2; ++_i) { \
        const unsigned _v = GATHER ? ((nx) ? gAn[h][_i] : gAc[h][_i]) : voffA[_i]; const unsigned _s = GATHER ? (koff) : (koff) + (unsigned)(h) * hstep; \
        if constexpr (BUF == 1) __builtin_amdgcn_raw_ptr_buffer_load_lds(rsA, (PG8_LAS void*)(lds + (bufoff) + ldsw + _i * 8192), 16, _v, _s, 0, 0); \
        else if constexpr (BUF == 2 || BUF == 3) PG8_GLDS(lds + (bufoff) + ldsw + _i * 8192, _v + (unsigned)__builtin_amdgcn_readfirstlane((int)_s), (const char*)uA); \
        else __builtin_amdgcn_global_load_lds((const unsigned*)((const char*)g.A + (size_t)(_s + _v)), (PG8_LAS unsigned*)(lds + (bufoff) + ldsw + _i * 8192), 16, 0, 0); } } while (0)
#define PG8_LDA(dst, b, h) do { _Pragma("unroll") for (int m = 0; m < 4; ++m) _Pragma("unroll") for (int k = 0; k < 2; ++k) dst[m][k] = *(const PG8_LAS bf16x8*)(lds + PG8_SA(b, h) + aoff + m * 2048 + k * 1024); } while (0)
#define PG8_LDB(dst, b, h) do { _Pragma("unroll") for (int n = 0; n < 2; ++n) _Pragma("unroll") for (int k = 0; k < 2; ++k) dst[n][k] = *(const PG8_LAS bf16x8*)(lds + PG8_SB(b, h) + boff + n * 2048 + k * 1024); } while (0)
#define PG8_CAT(f) __builtin_shufflevector(__builtin_bit_cast(i32x4, (f)[0]), __builtin_bit_cast(i32x4, (f)[1]), 0, 1, 2, 3, 4, 5, 6, 7)
#define PG8_MMA(ai, bj, At, Bt) do { __builtin_amdgcn_s_setprio(1); \
        if constexpr (FP8) { _Pragma("unroll") for (int m = 0; m < 4; ++m) _Pragma("unroll") for (int n = 0; n < 2; ++n) \
            acc[ai][bj][m][n] = __builtin_amdgcn_mfma_scale_f32_16x16x128_f8f6f4(PG8_CAT(Bt[n]), PG8_CAT(At[m]), acc[ai][bj][m][n], 0, 0, 0, 0, 0, 0); } \
        else { _Pragma("unroll") for (int m = 0; m < 4; ++m) _Pragma("unroll") for (int n = 0; n < 2; ++n) _Pragma("unroll") for (int k = 0; k < 2; ++k) \
            acc[ai][bj][m][n] = __builtin_amdgcn_mfma_f32_16x16x32_bf16(Bt[n][k], At[m][k], acc[ai][bj][m][n], 0, 0, 0); } \
        __builtin_amdgcn_s_setprio(0); } while (0)
#define PG8_WAIT_V(n) asm volatile("s_waitcnt vmcnt(" #n ")" ::: "memory")
#define PG8_WAIT_L(n) asm volatile("s_waitcnt lgkmcnt(" #n ")" ::: "memory")
#define PG8_BAR __builtin_amdgcn_s_barrier()
#define PG8_SCHED __builtin_amdgcn_sched_barrier(0)
    Unit cur, nxt; int ui = 0;
    if (!S.next(0, cur)) return;
    f32x4 acc[2][2][4][2];
#pragma unroll
    for (int a = 0; a < 2; ++a)
#pragma unroll
        for (int b = 0; b < 2; ++b)
#pragma unroll
            for (int m = 0; m < 4; ++m)
#pragma unroll
                for (int n = 0; n < 2; ++n) { acc[a][b][m][n] = (f32x4){0.f, 0.f, 0.f, 0.f}; if constexpr (FP8) asm volatile("" : "+v"(acc[a][b][m][n])); }
    bf16x8 At[4][2], B0[2][2], B1[2][2];
    unsigned cA = GATHER ? 0u : (unsigned)cur.pm * tstep, cB = (unsigned)cur.pn * tstep;
    if constexpr (GATHER) { PG8_GLOAD(gAc, cur.pm); }
    S.a_ready(cur);
    if constexpr (SP2) {
        PG8_STAGE(PG8_SB(0, 0), cB, voffB); PG8_STAGE(PG8_SB(0, 1), cB + hstep, voffB); PG8_STA(PG8_SA(0, 0), cA, 0, false); PG8_STA(PG8_SA(0, 1), cA, 1, false);
        if (wr == 1) PG8_BAR;
        PG8_WAIT_V(2); PG8_BAR;
        PG8_STAGE(PG8_SB(1, 0), cB + kstep, voffB); PG8_STA(PG8_SA(1, 0), cA + kstep, 0, false); PG8_STAGE(PG8_SB(1, 1), cB + hstep + kstep, voffB);
        PG8_WAIT_V(6); PG8_BAR;
    } else {
        PG8_STAGE(PG8_SB(0, 0), cB, voffB); PG8_STA(PG8_SA(0, 0), cA, 0, false); PG8_STAGE(PG8_SB(0, 1), cB + hstep, voffB); PG8_STA(PG8_SA(0, 1), cA, 1, false);
        if (wr == 1) PG8_BAR;
        PG8_WAIT_V(4); PG8_BAR;
        PG8_STAGE(PG8_SB(1, 0), cB + kstep, voffB); PG8_STA(PG8_SA(1, 0), cA + kstep, 0, false); PG8_STAGE(PG8_SB(1, 1), cB + hstep + kstep, voffB);
        PG8_WAIT_V(6); PG8_BAR;
    }
    for (;;) {
        const bool has_next = S.next(ui + 1, nxt);
        const unsigned nA = GATHER ? cA : (has_next ? (unsigned)nxt.pm * tstep : cA), nB = has_next ? (unsigned)nxt.pn * tstep : cB;
        if constexpr (GATHER) { if (has_next) { PG8_GLOAD(gAn, nxt.pm); } else {
#pragma unroll
            for (int _h = 0; _h < 2; ++_h)
#pragma unroll
                for (int _i = 0; _i < 2; ++_i) gAn[_h][_i] = gAc[_h][_i]; } }
#pragma unroll 1
        for (int t = 0; t < nt; t += 2) {
            const bool last = (t == nt - 2);
            const unsigned a1 = cA + (unsigned)(t + 1) * kstep;
            const unsigned a2 = last ? nA : cA + (unsigned)(t + 2) * kstep, b2 = last ? nB : cB + (unsigned)(t + 2) * kstep;
            const unsigned a3 = a2 + kstep, b3 = b2 + kstep;
            if (last && has_next) S.a_ready(nxt);
            if constexpr (SP2) {
            PG8_LDB(B0, 0, 0); PG8_LDB(B1, 0, 1); PG8_SCHED; PG8_LDA(At, 0, 0); PG8_STA(PG8_SA(1, 1), a1, 1, false);
            PG8_WAIT_V(8); PG8_WAIT_L(0); PG8_BAR; PG8_MMA(0, 0, At, B0); PG8_MMA(0, 1, At, B1); PG8_BAR; PG8_SCHED;
            PG8_LDA(At, 0, 1); PG8_STAGE(PG8_SB(0, 0), b2, voffB); PG8_STAGE(PG8_SB(0, 1), b2 + hstep, voffB); PG8_STA(PG8_SA(0, 0), a2, 0, last);
            PG8_WAIT_V(8); PG8_WAIT_L(0); PG8_BAR; PG8_MMA(1, 0, At, B0); PG8_MMA(1, 1, At, B1); PG8_BAR; PG8_SCHED;
            PG8_LDB(B0, 1, 0); PG8_LDB(B1, 1, 1); PG8_SCHED; PG8_LDA(At, 1, 0); PG8_STA(PG8_SA(0, 1), a2, 1, last);
            PG8_WAIT_V(8); PG8_WAIT_L(0); PG8_BAR; PG8_MMA(0, 0, At, B0); PG8_MMA(0, 1, At, B1); PG8_BAR; PG8_SCHED;
            PG8_LDA(At, 1, 1); PG8_STAGE(PG8_SB(1, 0), b3, voffB); PG8_STAGE(PG8_SB(1, 1), b3 + hstep, voffB); PG8_STA(PG8_SA(1, 0), a3, 0, last);
            PG8_WAIT_V(8); PG8_WAIT_L(0); PG8_BAR; PG8_MMA(1, 0, At, B0); PG8_MMA(1, 1, At, B1); PG8_BAR; PG8_SCHED;
            } else {
            PG8_LDB(B0, 0, 0); PG8_SCHED; PG8_LDA(At, 0, 0); PG8_STA(PG8_SA(1, 1), a1, 1, false);
            PG8_WAIT_L(8); PG8_BAR; PG8_WAIT_L(0); PG8_MMA(0, 0, At, B0); PG8_BAR; PG8_SCHED;
            PG8_LDB(B1, 0, 1); PG8_STAGE(PG8_SB(0, 0), b2, voffB);
            PG8_BAR; PG8_WAIT_L(0); PG8_MMA(0, 1, At, B1); PG8_BAR;
            PG8_LDA(At, 0, 1); PG8_STA(PG8_SA(0, 0), a2, 0, last);
            PG8_BAR; PG8_WAIT_L(0); PG8_MMA(1, 0, At, B0); PG8_BAR; PG8_SCHED;
            PG8_STAGE(PG8_SB(0, 1), b2 + hstep, voffB);
            PG8_WAIT_V(6); PG8_BAR; PG8_MMA(1, 1, At, B1); PG8_BAR;
            PG8_LDB(B0, 1, 0); PG8_SCHED; PG8_LDA(At, 1, 0); PG8_STA(PG8_SA(0, 1), a2, 1, last);
            PG8_WAIT_L(8); PG8_BAR; PG8_WAIT_L(0); PG8_MMA(0, 0, At, B0); PG8_BAR; PG8_SCHED;
            PG8_LDB(B1, 1, 1); PG8_STAGE(PG8_SB(1, 0), b3, voffB);
            PG8_BAR; PG8_WAIT_L(0); PG8_MMA(0, 1, At, B1); PG8_BAR;
            PG8_LDA(At, 1, 1); PG8_STA(PG8_SA(1, 0), a3, 0, last);
            PG8_BAR; PG8_WAIT_L(0); PG8_MMA(1, 0, At, B0); PG8_BAR; PG8_SCHED;
            PG8_STAGE(PG8_SB(1, 1), b3 + hstep, voffB);
            PG8_WAIT_V(6); PG8_BAR; PG8_MMA(1, 1, At, B1); PG8_BAR;
            }
        }
        if constexpr (ALIGN_EPI) { if (wr == 0) PG8_BAR; }
        if constexpr (!Epi::AFTER_DRAIN) { const int _l = my_tid(wv) & 63; E(acc, cur, wr, wc, _l & 15, _l >> 4); S.done(cur); }
        if (!has_next) break;
#pragma unroll
        for (int a = 0; a < 2; ++a)
#pragma unroll
            for (int b = 0; b < 2; ++b)
#pragma unroll
                for (int m = 0; m < 4; ++m)
#pragma unroll
                    for (int n = 0; n < 2; ++n) { acc[a][b][m][n] = (f32x4){0.f, 0.f, 0.f, 0.f}; if constexpr (FP8) asm volatile("" : "+v"(acc[a][b][m][n])); }
        cur = nxt; cA = nA; cB = nB; ++ui;
        if constexpr (GATHER) {
#pragma unroll
            for (int _h = 0; _h < 2; ++_h)
#pragma unroll
                for (int _i = 0; _i < 2; ++_i) gAc[_h][_i] = gAn[_h][_i]; }
        if constexpr (ALIGN_EPI) { if (wr == 1) PG8_BAR; }
    }
    PG8_WAIT_V(0);
    if constexpr (!ALIGN_EPI) { if (wr == 0) PG8_BAR; }
    PG8_BAR;
#undef PG8_SA
#undef PG8_SB
#undef PG8_STAGE
#undef PG8_STA
#undef PG8_GLDS
#undef PG8_GLOAD
#undef PG8_LDA
#undef PG8_LDB
#undef PG8_MMA
#undef PG8_CAT
#undef PG8_WAIT_V
#undef PG8_WAIT_L
#undef PG8_BAR
#undef PG8_SCHED
}
}

#define LDS_WAIT() asm volatile("s_waitcnt lgkmcnt(0)" ::: "memory")
#define LBAR() do { asm volatile("s_waitcnt lgkmcnt(0)" ::: "memory"); __builtin_amdgcn_s_barrier(); asm volatile("" ::: "memory"); } while (0)

__device__ __forceinline__ void cvt_item(const float* W, int K, int N, bf16_t* WT, int mode, int item, int lane) {
    const int nblk = N / 64, kb = item / nblk, nb = item % nblk, k0 = 64 * kb, n0 = 64 * nb;
    const int rbase = mode == 0 ? n0 : ((n0 >> 7) * 256 + (n0 & 127) + (mode == 2 ? 128 : 0));
    const int r = lane >> 4, c4 = lane & 15;
    const float* src = W + (size_t)(k0 + 16 * r) * N + n0 + 4 * c4;
    f32x4 v[16];
#pragma unroll
    for (int i = 0; i < 16; ++i) v[i] = *(const f32x4*)(src + (size_t)i * N);
    bf16_t* dst = WT + (size_t)(rbase + 4 * c4) * K + k0 + 16 * r;
#pragma unroll
    for (int q = 0; q < 4; ++q)
#pragma unroll
        for (int hh = 0; hh < 2; ++hh) { u32x4 o;
            o.x = pk2(v[8 * hh + 0][q], v[8 * hh + 1][q]); o.y = pk2(v[8 * hh + 2][q], v[8 * hh + 3][q]); o.z = pk2(v[8 * hh + 4][q], v[8 * hh + 5][q]); o.w = pk2(v[8 * hh + 6][q], v[8 * hh + 7][q]);
            *(u32x4*)(dst + (size_t)q * K + 8 * hh) = o; }
}

__device__ __forceinline__ void phase0(const Params& p, LAS unsigned char* lds, int bid, int G, int wv) {
    const int tid = my_tid(wv), lane = tid & 63, wave = tid >> 6;
    unsigned char* ws = p.ws;
    if (bid < 192) {
        LAS float* sc = (LAS float*)lds;
        LAS float* part = sc + 9 * 1024;
        const float* c = p.in[1]; const float* cctx = p.in[3]; const float* ada_w = p.in[4]; const float* ada_b = p.in[5];
        float* MOD = (float*)(ws + WS_MOD);
        for (int i = tid; i < 9 * 1024; i += NTHR) { const int r = i >> 10, k = i & 1023; const float v = r < 8 ? c[r * 1024 + k] : cctx[k]; sc[i] = v / (1.f + expf(-v)); }
        __syncthreads();
        for (int it = bid; it < 192; it += G) {
            const int col = tid & 31, kg = tid >> 5;
            float acc[9];
#pragma unroll
            for (int r = 0; r < 9; ++r) acc[r] = 0.f;
            const float* w = ada_w + (size_t)(kg * 64) * 6144 + it * 32 + col;
#pragma unroll 16
            for (int k = 0; k < 64; ++k) { const float wv = w[(size_t)k * 6144];
#pragma unroll
                for (int r = 0; r < 9; ++r) acc[r] += sc[r * 1024 + kg * 64 + k] * wv; }
#pragma unroll
            for (int r = 0; r < 9; ++r) part[(kg * 9 + r) * 32 + col] = acc[r];
            __syncthreads();
            for (int o = tid; o < 288; o += NTHR) { const int r = o >> 5, cc = o & 31; float s_ = ada_b[it * 32 + cc];
#pragma unroll
                for (int q = 0; q < 16; ++q) s_ += part[(q * 9 + r) * 32 + cc];
                MOD[r * 6144 + it * 32 + cc] = s_; }
            __syncthreads();
        }
    }
    {
        const int gw = bid * NWAVES + wave, NGW = G * NWAVES;
        constexpr int I_IN = 16 * (DIN / 64), I_OUT = 16 * 16;
        for (int it = gw; it < I_IN + I_OUT; it += NGW) {
            if (it < I_IN) cvt_item(p.in[8], D, DIN, (bf16_t*)(ws + WS_WINT), 0, it, lane);
            else cvt_item(p.in[21], D, D, (bf16_t*)(ws + WS_WOUTT), 0, it - I_IN, lane);
        }
    }
}
constexpr size_t OUT_W2T = (MOE_FP8 ? 32 : 64) * MiB;
__device__ __forceinline__ void xcvt_load(const Params& p, int g, int lane, f32x4 (&v)[8]) {
    const int which = g >> 13, r = g & 8191, e = r >> 9, kb = (r >> 4) & 31, nb = r & 15;
    const float* W = which == 0 ? p.in[23] : (which == 1 ? p.in[24] : p.in[25]);
    const __amdgpu_buffer_rsrc_t rs = __builtin_amdgcn_make_buffer_rsrc((void*)W, 0, 64 << 20, 0x00020000);
    const unsigned vo = (unsigned)(((lane >> 4) * 8 * 1024 + (lane & 15) * 4) * 4);
    const unsigned so = (unsigned)(((e * 1024 + kb * 32) * 1024 + nb * 64) * 4);
#pragma unroll
    for (int i = 0; i < 8; ++i) v[i] = __builtin_bit_cast(f32x4, __builtin_amdgcn_raw_buffer_load_b128(rs, vo, so + (unsigned)i * 4096u, 2));
}
__device__ __forceinline__ void xcvt_store(const Params& p, int g, int lane, const f32x4 (&v)[8]) {
    const int which = g >> 13, r = g & 8191, e = r >> 9, kb = (r >> 4) & 31, nb = r & 15, n0 = nb * 64;
    const int rbase = which == 2 ? n0 : ((n0 >> 7) * 256 + (n0 & 127) + (which == 1 ? 128 : 0));
#if MOE_FP8
    const unsigned so = which == 2 ? (unsigned)OUT_W2T + (unsigned)((e * 1024 + rbase) * 1024 + kb * 32) : (unsigned)((e * 2048 + rbase) * 1024 + kb * 32);
    const __amdgpu_buffer_rsrc_t rs = __builtin_amdgcn_make_buffer_rsrc((void*)p.out, 0, 48 << 20, 0x00020000);
    const unsigned vo = (unsigned)((lane & 15) * 4 * 1024 + (lane >> 4) * 8);
#pragma unroll
    for (int q = 0; q < 4; ++q) { u32x2 o;
        o.x = pk4_fp8_raw(v[0][q] * W8_SCALE, v[1][q] * W8_SCALE, v[2][q] * W8_SCALE, v[3][q] * W8_SCALE); o.y = pk4_fp8_raw(v[4][q] * W8_SCALE, v[5][q] * W8_SCALE, v[6][q] * W8_SCALE, v[7][q] * W8_SCALE);
        __builtin_amdgcn_raw_buffer_store_b64(o, rs, vo, so + (unsigned)q * 1024u, 2); }
#else
    const unsigned so = which == 2 ? (unsigned)OUT_W2T + (unsigned)(((e * 1024 + rbase) * 1024 + kb * 32) * 2) : (unsigned)(((e * 2048 + rbase) * 1024 + kb * 32) * 2);
    const __amdgpu_buffer_rsrc_t rs = __builtin_amdgcn_make_buffer_rsrc((void*)p.out, 0, 96 << 20, 0x00020000);
    const unsigned vo = (unsigned)(((lane & 15) * 4 * 1024 + (lane >> 4) * 8) * 2);
#pragma unroll
    for (int q = 0; q < 4; ++q) { u32x4 o;
        o.x = pk2(v[0][q], v[1][q]); o.y = pk2(v[2][q], v[3][q]); o.z = pk2(v[4][q], v[5][q]); o.w = pk2(v[6][q], v[7][q]);
        __builtin_amdgcn_raw_buffer_store_b128(o, rs, vo, so + (unsigned)q * 2048u, 0); }
#endif
}

__device__ __forceinline__ void phase1(const Params& p, int bid, int G, int wv) {
    const int tid = my_tid(wv), lane = tid & 63, wave = tid >> 6;
    const int gw = bid * NWAVES + wave, NGW = G * NWAVES;
    const float* MOD = (const float*)(p.ws + WS_MOD); const float* n1g = p.in[6];
    bf16_t* XN = (bf16_t*)(p.ws + WS_XN);
    f32x4 g[4];
#pragma unroll
    for (int j = 0; j < 4; ++j) g[j] = *(const f32x4*)(n1g + 4 * (lane + 64 * j));
    for (int m0 = gw; m0 < MALL; m0 += 2 * NGW) {
        f32x4 v[2][4]; float ss[2]; int mrow[2];
#pragma unroll
        for (int tk = 0; tk < 2; ++tk) { const int m = m0 + tk * NGW < MALL ? m0 + tk * NGW : m0;
            const float* src = m < MX ? p.in[0] + (size_t)m * D : p.in[2] + (size_t)(m - MX) * D; mrow[tk] = m;
            ss[tk] = 0.f;
#pragma unroll
            for (int j = 0; j < 4; ++j) { v[tk][j] = ((const f32x4*)src)[lane + 64 * j]; ss[tk] += (v[tk][j].x * v[tk][j].x + v[tk][j].y * v[tk][j].y) + (v[tk][j].z * v[tk][j].z + v[tk][j].w * v[tk][j].w); } }
#pragma unroll
        for (int tk = 0; tk < 2; ++tk) { const int m = mrow[tk], mr = m < MX ? (m >> 12) : 8;
            const float* sh = MOD + (size_t)mr * 6144; const float* scp = sh + 1024;
            const float rstd = rsqrtf(wave_sum(ss[tk]) * (1.f / D) + 1e-6f);
#pragma unroll
            for (int j = 0; j < 4; ++j) { const int col = 4 * (lane + 64 * j);
                const f32x4 s_ = *(const f32x4*)(scp + col), h = *(const f32x4*)(sh + col);
                const f32x4 y = v[tk][j] * rstd * g[j] * (s_ + 1.f) + h;
                u32x2 o; o.x = pk2(y.x, y.y); o.y = pk2(y.z, y.w);
                *(u32x2*)(XN + (size_t)m * D + col) = o; } }
    }
}

struct Px5 { u32x4 s, n0, n1, n2, n3; };
__device__ __forceinline__ Px5 px_load(const bf16_t* PX, int row, const int (&nbr)[4], int cb) {
    const __amdgpu_buffer_rsrc_t rs = __builtin_amdgcn_make_buffer_rsrc((void*)PX, 0, MALL * DIN * 2, 0x00020000);
    const unsigned cbb = (unsigned)cb * 2u, OOB = 0xFFFFF000u;
    Px5 q;
    q.s = __builtin_bit_cast(u32x4, __builtin_amdgcn_raw_buffer_load_b128(rs, (unsigned)row * (DIN * 2) + cbb, 0, 0));
    q.n0 = __builtin_bit_cast(u32x4, __builtin_amdgcn_raw_buffer_load_b128(rs, nbr[0] >= 0 ? (unsigned)nbr[0] * (DIN * 2) + cbb : OOB, 0, 0));
    q.n1 = __builtin_bit_cast(u32x4, __builtin_amdgcn_raw_buffer_load_b128(rs, nbr[1] >= 0 ? (unsigned)nbr[1] * (DIN * 2) + cbb : OOB, 0, 0));
    q.n2 = __builtin_bit_cast(u32x4, __builtin_amdgcn_raw_buffer_load_b128(rs, nbr[2] >= 0 ? (unsigned)nbr[2] * (DIN * 2) + cbb : OOB, 0, 0));
    q.n3 = __builtin_bit_cast(u32x4, __builtin_amdgcn_raw_buffer_load_b128(rs, nbr[3] >= 0 ? (unsigned)nbr[3] * (DIN * 2) + cbb : OOB, 0, 0));
    return q; }
__device__ __forceinline__ void px_lerp(const Px5& q, bool isctx, int cb, const float* mu, float (&out)[8]) {
    u32x4 sh;
    if (isctx) { sh.x = (q.n0.x & 0xffffu) | (q.n1.x & 0xffff0000u); sh.y = (q.n0.y & 0xffffu) | (q.n1.y & 0xffff0000u); sh.z = (q.n0.z & 0xffffu) | (q.n1.z & 0xffff0000u); sh.w = (q.n0.w & 0xffffu) | (q.n1.w & 0xffff0000u); }
    else { sh.x = (q.n0.x & 0xffffu) | (q.n1.x & 0xffff0000u); sh.y = (q.n2.y & 0xffffu) | (q.n3.y & 0xffff0000u); sh.z = (q.n0.z & 0xffffu) | (q.n1.z & 0xffff0000u); sh.w = (q.n2.w & 0xffffu) | (q.n3.w & 0xffff0000u); }
    float s[8], sv[8];
    unpack8(q.s, s); unpack8(sh, sv);
    const f32x4 m0 = *(const f32x4*)(mu + cb), m1 = *(const f32x4*)(mu + cb + 4);
    const float mv[8] = {m0.x, m0.y, m0.z, m0.w, m1.x, m1.y, m1.z, m1.w};
#pragma unroll
    for (int e = 0; e < 8; ++e) out[e] = s[e] + mv[e] * (sv[e] - s[e]);
}
__device__ __forceinline__ void neighbours(int t, bool isctx, int rowbase, int (&nbr)[4]) {
    if (isctx) { nbr[0] = t > 0 ? rowbase + t - 1 : -1; nbr[1] = t < CTXL - 1 ? rowbase + t + 1 : -1; nbr[2] = -1; nbr[3] = -1; }
    else { const int cg_ = t & 63, rg = t >> 6;
        nbr[0] = cg_ > 0 ? rowbase + t - 1 : -1; nbr[1] = cg_ < 63 ? rowbase + t + 1 : -1; nbr[2] = rg > 0 ? rowbase + t - 64 : -1; nbr[3] = rg < 63 ? rowbase + t + 64 : -1; }
}

typedef short s16x4 __attribute__((ext_vector_type(4)));
constexpr int RS = 128;
constexpr int IMG = 64 * RS;
__device__ __forceinline__ int ioff(int row, int col) { return row * RS + ((col * 2) ^ (((row & 2) | ((row >> 1) & 4)) << 4)); }
constexpr int I_AT = 0, I_BT = IMG, I_KT = 2 * IMG, I_RT = 3 * IMG, I_BH = 4 * IMG, I_KH = 5 * IMG, I_VV = 6 * IMG;
constexpr int I_LBT = 7 * IMG, I_LAK = 8 * IMG, I_PRB = 9 * IMG, I_PRK = 10 * IMG, I_TM = 11 * IMG, I_Q = 12 * IMG;
constexpr int I_E = 13 * IMG;
constexpr int I_LT = 13 * IMG + 4608;
constexpr int I_WUP = I_LT + 17408, I_AUP = I_WUP + IMG;
constexpr int I_PAR = I_AUP + IMG;
constexpr int I_VV2 = I_PAR + 1280;
constexpr int X_END = I_VV2 + IMG;
constexpr int I_W1 = I_LBT, I_W2 = I_LAK;
constexpr int I_XW = I_Q, I_XA = I_TM;
constexpr int I_DW = I_AT, I_DA = I_LT;
constexpr int I_G = I_PRB, I_GT = I_E;
static_assert(I_DW + 17408 <= I_RT && I_PRK == I_PRB + IMG && X_END + 64 <= LDS_BYTES && X_END == LDS_MISC, "scan LDS map");

__device__ __forceinline__ bf16x8 frag_rm(const LAS unsigned char* img, int row0, int k0, int lane) {
    return *(const LAS bf16x8*)(img + ioff(row0 + (lane & 15), k0 + 8 * (lane >> 4))); }
__device__ __forceinline__ bf16x8 frag_tr(const LAS unsigned char* img, int k0, int col0, int lane) {
    LAS unsigned char* a = (LAS unsigned char*)img + ioff(k0 + 8 * (lane >> 4) + ((lane & 15) >> 2), col0 + 4 * (lane & 3));
    const s16x4 lo = __builtin_amdgcn_ds_read_tr16_b64_v4i16((LAS s16x4*)a);
    const s16x4 hi = __builtin_amdgcn_ds_read_tr16_b64_v4i16((LAS s16x4*)(a + 4 * RS));
    return __builtin_shufflevector(lo, hi, 0, 1, 2, 3, 4, 5, 6, 7); }
#define MFMA16(a, b, c) __builtin_amdgcn_mfma_f32_16x16x32_bf16((a), (b), (c), 0, 0, 0)
__device__ __forceinline__ void st_img(LAS unsigned char* img, int n0, int m0, int lane, const f32x4 v) {
    u32x2 w; w.x = pk2(v[0], v[1]); w.y = pk2(v[2], v[3]);
    *(LAS u32x2*)(img + ioff(n0 + (lane & 15), m0 + 4 * (lane >> 4))) = w; }
__device__ __forceinline__ f32x4 up4(const u32x2 w) { return (f32x4){bflo(w.x), bfhi(w.x), bflo(w.y), bfhi(w.y)}; }

__device__ __forceinline__ void phase_scanX(const Params& p, LAS unsigned char* lds, int bid, int G, int wv) {
    const int tid_ = my_tid(wv), lane_ = tid_ & 63, wave = __builtin_amdgcn_readfirstlane(tid_ >> 6);
    const bf16_t* PX = (const bf16_t*)(p.ws + WS_PX);
    const float* mu = p.in[9];
    const f32x4 fz = (f32x4){0.f, 0.f, 0.f, 0.f};
    for (int it_ = bid; it_ < NB * NH * 2 * 2; it_ += G) {
        const int item = (G == 256) ? ((it_ & 7) * 32 + (it_ >> 3)) : it_;
        const int bhd = item >> 1, dir = bhd & 1, h = (bhd >> 1) & 7, b = bhd >> 4;
        LBAR();
        { const int tid = opq(tid_), j = tid >> 3, k0 = (tid & 7) * 8;
          const float* wu = p.in[11] + (size_t)dir * 64 * DR + (size_t)j * DR + h * 64 + k0; const float* au = p.in[13] + (size_t)dir * 64 * DR + (size_t)j * DR + h * 64 + k0;
          const f32x4 w0 = *(const f32x4*)wu, w1 = *(const f32x4*)(wu + 4), a0 = *(const f32x4*)au, a1 = *(const f32x4*)(au + 4);
          const float wf[8] = {w0.x, w0.y, w0.z, w0.w, w1.x, w1.y, w1.z, w1.w}, af[8] = {a0.x, a0.y, a0.z, a0.w, a1.x, a1.y, a1.z, a1.w};
          *(LAS u32x4*)(lds + I_WUP + ioff(j, k0)) = pack8(wf); *(LAS u32x4*)(lds + I_AUP + ioff(j, k0)) = pack8(af); }
        { const int k0_ = (opq(tid_) & 7) * 8, hc_ = h * 64 + k0_; LAS float* PARw = (LAS float*)(lds + I_PAR) + k0_;
#pragma unroll
          for (int e = 0; e < 8; ++e) { PARw[e] = p.in[10][dir * DR + hc_ + e]; PARw[64 + e] = p.in[12][dir * DR + hc_ + e]; PARw[128 + e] = p.in[14][hc_ + e]; PARw[192 + e] = p.in[15][hc_ + e]; PARw[256 + e] = p.in[16][hc_ + e]; } }
#define XCI(cc_) ((item & 1) * 34 + 33 - (cc_))
#define X_PXLOAD(ci_) do { const int tid__ = opq(tid_), j__ = tid__ >> 3, k0__ = (tid__ & 7) * 8; const int ci__ = (ci_); const bool ctx__ = ci__ < 4; const int c__ = ctx__ ? ci__ : ci__ - 4; \
            const int L__ = ctx__ ? CTXL : T, rb__ = ctx__ ? MX + b * CTXL : b * T, pos__ = 64 * c__ + j__, t__ = dir ? (L__ - 1 - pos__) : pos__; \
            int nbr__[4]; neighbours(t__, ctx__, rb__, nbr__); \
            qv = px_load(PX, rb__ + t__, nbr__, 1024 + h * 64 + k0__); qw = px_load(PX, rb__ + t__, nbr__, 1536 + k0__); qa = px_load(PX, rb__ + t__, nbr__, 1600 + k0__); \
            qr = px_load(PX, rb__ + t__, nbr__, h * 64 + k0__); qk = px_load(PX, rb__ + t__, nbr__, 512 + h * 64 + k0__); } while (0)
#define X_LERP(ci_, par_, rd_, kd_) do { const int tid__ = opq(tid_), j__ = tid__ >> 3, k0__ = (tid__ & 7) * 8; const bool ctx__ = (ci_) < 4; \
            { float v__[8]; px_lerp(qv, ctx__, 1024 + h * 64 + k0__, mu, v__); *(LAS u32x4*)(lds + ((par_) ? I_VV2 : I_VV) + ioff(j__, k0__)) = pack8(v__); } \
            { float xw__[8]; px_lerp(qw, ctx__, 1536 + k0__, mu, xw__); \
              _Pragma("unroll") for (int e = 0; e < 8; ++e) xw__[e] = ftanh(xw__[e]); \
              *(LAS u32x4*)(lds + I_XW + ioff(j__, k0__)) = pack8(xw__); } \
            { float xa__[8]; px_lerp(qa, ctx__, 1600 + k0__, mu, xa__); *(LAS u32x4*)(lds + I_XA + ioff(j__, k0__)) = pack8(xa__); } \
            px_lerp(qr, ctx__, h * 64 + k0__, mu, rd_); px_lerp(qk, ctx__, 512 + h * 64 + k0__, mu, kd_); } while (0)
#define X_LORA() do { const int lane = opq(lane_); const int pr = wave >> 2, nt = wave & 3; \
            const LAS unsigned char* Ximg = lds + (pr ? I_XA : I_XW); const LAS unsigned char* Wimg = lds + (pr ? I_AUP : I_WUP); \
            LAS float* Dout = (LAS float*)(lds + (pr ? I_DA : I_DW)); \
            const bf16x8 b0 = frag_rm(Ximg, 16 * nt, 0, lane), b1 = frag_rm(Ximg, 16 * nt, 32, lane); \
            bf16x8 wa[4][2]; \
            _Pragma("unroll") for (int mt = 0; mt < 4; ++mt) { wa[mt][0] = frag_tr(Wimg, 0, 16 * mt, lane); wa[mt][1] = frag_tr(Wimg, 32, 16 * mt, lane); } \
            _Pragma("unroll") for (int mt = 0; mt < 4; ++mt) { const f32x4 acc = MFMA16(wa[mt][1], b1, MFMA16(wa[mt][0], b0, fz)); \
                *(LAS f32x4*)(Dout + (16 * nt + (lane & 15)) * 68 + 16 * mt + 4 * (lane >> 4)) = acc; } } while (0)
        float r[8], k[8];
#if XSCOPE
        { Px5 qv, qw, qa, qr, qk; X_PXLOAD(XCI(0));
          X_LERP(XCI(0), 0, r, k); }
#else
        Px5 qv, qw, qa, qr, qk;
        X_PXLOAD(XCI(0));
        X_LERP(XCI(0), 0, r, k);
#endif
        LBAR();
        X_LORA();
        for (int cc = 0; cc < 34; ++cc) {
            const int tid = opq(tid_), j = tid >> 3, sub = tid & 7, k0 = sub * 8;
#if XSCOPE
            Px5 qv, qw, qa, qr, qk;
#endif
            const int ci = XCI(cc);
            const bool isctx = ci < 4; const int c = isctx ? ci : ci - 4;
            const int u = bhd * 68 + ci;
            const int L = isctx ? CTXL : T, rowbase = isctx ? MX + b * CTXL : b * T;
            const int pos = 64 * c + j, t = dir ? (L - 1 - pos) : pos;
            const LAS unsigned char* vvimg = lds + ((cc & 1) ? I_VV2 : I_VV);
            LBAR();
            if (cc + 1 < 34) X_PXLOAD(XCI(cc + 1));
            float kkn[8], ab[8], kd[8];
            { const LAS float* DW = (const LAS float*)(lds + I_DW) + j * 68 + k0; const LAS float* DA = (const LAS float*)(lds + I_DA) + j * 68 + k0;
              const f32x4 d0 = *(const LAS f32x4*)DW, d1 = *(const LAS f32x4*)(DW + 4), e0 = *(const LAS f32x4*)DA, e1 = *(const LAS f32x4*)(DA + 4);
              const float dw[8] = {d0.x, d0.y, d0.z, d0.w, d1.x, d1.y, d1.z, d1.w}, da[8] = {e0.x, e0.y, e0.z, e0.w, e1.x, e1.y, e1.z, e1.w};
              const LAS float* PAR = (const LAS float*)(lds + I_PAR) + k0;
              const LAS float* w0p = PAR; const LAS float* a0p = PAR + 64; const LAS float* kkp = PAR + 128; const LAS float* kap = PAR + 192; const LAS float* rkp = PAR + 256;
              float ss = 0.f, bd = 0.f, lw[8];
#pragma unroll
              for (int e = 0; e < 8; ++e) {
                  kkn[e] = k[e] * kkp[e]; ss += kkn[e] * kkn[e];
                  const float z = w0p[e] + dw[e];
                  lw[e] = -0.60653066f * fsigmoid(z);
                  const float as = fsigmoid(a0p[e] + da[e]);
                  kd[e] = k[e] * (1.f + (as - 1.f) * kap[e]);
                  bd += r[e] * kd[e] * rkp[e];
                  ab[e] = as; }
              ss = red8(ss); bd = red8(bd);
              const float inv = __builtin_amdgcn_rcpf(fmaxf(__builtin_amdgcn_sqrtf(ss), 1e-12f));
#pragma unroll
              for (int e = 0; e < 8; ++e) { kkn[e] *= inv; ab[e] *= kkn[e]; }
              LAS float* Gs = (LAS float*)(lds + I_G) + j * 64 + k0;
              *(LAS f32x4*)Gs = (f32x4){lw[0], lw[1], lw[2], lw[3]}; *(LAS f32x4*)(Gs + 4) = (f32x4){lw[4], lw[5], lw[6], lw[7]};
              if (!isctx && sub == 0) *(float*)(p.ws + (size_t)(unsigned)(WS_BDOT + ((dir * MX + rowbase + t) * NH + h) * 4)) = bd; }
            LBAR();
            { const int kap = tid & 63, jq = tid >> 6; LAS float* Gs = (LAS float*)(lds + I_G); LAS float* GT = (LAS float*)(lds + I_GT);
              float pf[8], run = 0.f;
#pragma unroll
              for (int e = 0; e < 8; ++e) { run += Gs[(8 * jq + e) * 64 + kap]; pf[e] = run; }
              GT[jq * 64 + kap] = run;
              LBAR();
              float off = 0.f;
#pragma unroll
              for (int q = 0; q < 7; ++q) off += (q < jq) ? GT[q * 64 + kap] : 0.f;
#pragma unroll
              for (int e = 0; e < 8; ++e) Gs[(8 * jq + e) * 64 + kap] = pf[e] + off; }
            LBAR();
            { const LAS float* Gs = (const LAS float*)(lds + I_G);
              const f32x4 g0 = *(const LAS f32x4*)(Gs + j * 64 + k0), g1 = *(const LAS f32x4*)(Gs + j * 64 + k0 + 4);
              const f32x4 c0 = *(const LAS f32x4*)(Gs + 63 * 64 + k0), c1 = *(const LAS f32x4*)(Gs + 63 * 64 + k0 + 4);
              f32x4 m0 = fz, m1 = fz; if (j > 0) { m0 = *(const LAS f32x4*)(Gs + (j - 1) * 64 + k0); m1 = *(const LAS f32x4*)(Gs + (j - 1) * 64 + k0 + 4); }
              const float g[8] = {g0.x, g0.y, g0.z, g0.w, g1.x, g1.y, g1.z, g1.w}, gm[8] = {m0.x, m0.y, m0.z, m0.w, m1.x, m1.y, m1.z, m1.w}, gc[8] = {c0.x, c0.y, c0.z, c0.w, c1.x, c1.y, c1.z, c1.w};
              float at[8], bt[8], kt[8], rt[8], bh[8], kh[8];
#pragma unroll
              for (int e = 0; e < 8; ++e) { const float eg = __expf(g[e]), em = __expf(gm[e]), ei = __expf(-g[e]), eh = __expf(gc[e] - g[e]);
                  at[e] = -kkn[e] * em; bt[e] = ab[e] * ei; kt[e] = kd[e] * ei; rt[e] = r[e] * eg; bh[e] = ab[e] * eh; kh[e] = kd[e] * eh; }
              const int o = ioff(j, k0);
              *(LAS u32x4*)(lds + I_AT + o) = pack8(at); *(LAS u32x4*)(lds + I_BT + o) = pack8(bt); *(LAS u32x4*)(lds + I_KT + o) = pack8(kt);
              *(LAS u32x4*)(lds + I_RT + o) = pack8(rt); *(LAS u32x4*)(lds + I_BH + o) = pack8(bh); *(LAS u32x4*)(lds + I_KH + o) = pack8(kh);
              if (j == 0) { float* GAM = (float*)(p.ws + (size_t)(unsigned)(WS_GAM + (u * 64 + k0) * 4));
#pragma unroll
                  for (int e = 0; e < 8; ++e) GAM[e] = __expf(gc[e]); } }
            LBAR();
            const int cvitem = __builtin_amdgcn_readfirstlane(opq((CVPOS != 0 && cc < 32 && wave >= 5) ? item * 96 + cc * 3 + (wave - 5) : -1));
            f32x4 cv[8];
#if CVPOS == 1
            if (cvitem >= 0) xcvt_load(p, cvitem, opq(lane_), cv);
#endif
            { const int lane = opq(lane_); const int nt = wave >> 1, mb = (wave & 1) * 2;
              const bf16x8 bB0 = frag_rm(lds + I_BT, 16 * nt, 0, lane), bB1 = frag_rm(lds + I_BT, 16 * nt, 32, lane);
              const int n = 16 * nt + (lane & 15);
#pragma unroll
              for (int mi = 0; mi < 2; ++mi) { const int mt = mb + mi, m0 = 16 * mt + 4 * (lane >> 4);
                  const bf16x8 aA0 = frag_rm(lds + I_AT, 16 * mt, 0, lane), aA1 = frag_rm(lds + I_AT, 16 * mt, 32, lane);
                  f32x4 lt = MFMA16(aA1, bB1, MFMA16(aA0, bB0, fz));
#pragma unroll
                  for (int q = 0; q < 4; ++q) lt[q] = (m0 + q > n) ? lt[q] : 0.f;
                  *(LAS f32x4*)((LAS float*)(lds + I_LT) + n * 68 + m0) = lt;
                  st_img(lds + I_LBT, 16 * nt, 16 * mt, lane, lt); } }
            LBAR();
            if (wave == 0) {
                const int lane = opq(lane_); const int a16 = lane >> 4, il = lane & 15;
                const LAS float* LT = (const LAS float*)(lds + I_LT);
                typedef float f32x2v __attribute__((ext_vector_type(2)));
                f32x2v tp[8];
#pragma unroll
                for (int i = 0; i < 8; ++i) tp[i] = (f32x2v){0.f, 0.f};
                f32x4 Lc[4], Ln[4];
#pragma unroll
                for (int q4 = 0; q4 < 4; ++q4) { Lc[q4] = fz; Ln[q4] = fz; }
                Lc[3] = *(const LAS f32x4*)(LT + (16 * a16 + 14) * 68 + 16 * a16 + 12);
                tp[7].y = (il == 15) ? 1.f : 0.f;
#pragma unroll
                for (int jl = 14; jl >= 0; --jl) {
                    if (jl > 0) { const LAS float* Lrow = LT + (16 * a16 + jl - 1) * 68 + 16 * a16;
#pragma unroll
                        for (int q4 = 0; q4 < 4; ++q4) if (4 * q4 + 3 > jl - 1) Ln[q4] = *(const LAS f32x4*)(Lrow + 4 * q4); }
                    f32x2v s01 = (f32x2v){(il == jl) ? 1.f : 0.f, 0.f}, s23 = (f32x2v){0.f, 0.f};
#pragma unroll
                    for (int q4 = 0; q4 < 4; ++q4) if (4 * q4 + 3 > jl) { const f32x4 Lv = Lc[q4];
                        s01 += tp[2 * q4] * (f32x2v){Lv.x, Lv.y}; s23 += tp[2 * q4 + 1] * (f32x2v){Lv.z, Lv.w}; }
                    float tv_ = (s01.x + s01.y) + (s23.x + s23.y);
                    asm volatile("" : "+v"(tv_) :: "memory");
                    if (jl & 1) tp[jl >> 1].y = tv_; else tp[jl >> 1].x = tv_;
#pragma unroll
                    for (int q4 = 0; q4 < 4; ++q4) Lc[q4] = Ln[q4];
                }
                LAS unsigned char* tmi = lds + I_TM;
                const u32x4 z4 = (u32x4){0u, 0u, 0u, 0u};
#pragma unroll
                for (int c8 = 0; c8 < 2; ++c8) { const float tv[8] = {tp[4 * c8].x, tp[4 * c8].y, tp[4 * c8 + 1].x, tp[4 * c8 + 1].y, tp[4 * c8 + 2].x, tp[4 * c8 + 2].y, tp[4 * c8 + 3].x, tp[4 * c8 + 3].y};
                    *(LAS u32x4*)(tmi + ioff(lane, 16 * a16 + 8 * c8)) = pack8(tv); }
                if ((a16 & 1) == 0) {
#pragma unroll
                    for (int c8 = 0; c8 < 2; ++c8) *(LAS u32x4*)(tmi + ioff(lane, 16 * (a16 + 1) + 8 * c8)) = z4; }
                if (a16 < 2) {
#pragma unroll
                    for (int c8 = 0; c8 < 4; ++c8) *(LAS u32x4*)(tmi + ioff(lane, 32 + 8 * c8)) = z4; }
                asm volatile("s_waitcnt lgkmcnt(0)" ::: "memory");
                const bf16x8 zf = (bf16x8){0, 0, 0, 0, 0, 0, 0, 0};
                const bool khi = (lane & 32) != 0;
#pragma unroll
                for (int pq = 0; pq < 2; ++pq) {
                    bf16x8 fa = frag_tr(lds + I_TM, 32 * pq, 32 * pq, lane), fb = frag_tr(lds + I_LBT, 32 * pq, 32 * pq + 16, lane);
                    fa = khi ? zf : fa; fb = khi ? zf : fb;
                    st_img(lds + I_E, 16 * pq, 0, lane, MFMA16(fa, fb, fz)); }
                asm volatile("s_waitcnt lgkmcnt(0)" ::: "memory");
#pragma unroll
                for (int pq = 0; pq < 2; ++pq) {
                    bf16x8 fa = frag_tr(lds + I_E, 16 * pq, 0, lane), fb = frag_rm(lds + I_TM, 32 * pq + 16, 32 * pq + 16, lane);
                    fa = khi ? zf : fa; fb = khi ? zf : fb;
                    st_img(lds + I_TM, 32 * pq + 16, 32 * pq, lane, MFMA16(fa, fb, fz)); }
                asm volatile("s_waitcnt lgkmcnt(0)" ::: "memory");
                { f32x4 ea[4];
#pragma unroll
                  for (int tq = 0; tq < 4; ++tq) { const int nt2 = tq >> 1, mt2 = tq & 1;
                      ea[tq] = MFMA16(frag_tr(lds + I_TM, 0, 16 * mt2, lane), frag_tr(lds + I_LBT, 0, 32 + 16 * nt2, lane), fz); }
#pragma unroll
                  for (int tq = 0; tq < 4; ++tq) st_img(lds + I_E, 16 * (tq >> 1), 16 * (tq & 1), lane, ea[tq]); }
                asm volatile("s_waitcnt lgkmcnt(0)" ::: "memory");
                { f32x4 ta[4];
#pragma unroll
                  for (int tq = 0; tq < 4; ++tq) { const int nt2 = tq >> 1, mt2 = tq & 1;
                      ta[tq] = MFMA16(frag_tr(lds + I_E, 0, 16 * mt2, lane), frag_rm(lds + I_TM, 32 + 16 * nt2, 32, lane), fz); }
#pragma unroll
                  for (int tq = 0; tq < 4; ++tq) st_img(lds + I_TM, 32 + 16 * (tq >> 1), 16 * (tq & 1), lane, ta[tq]); }
            } else if (wave < 5) {
                const int lane = opq(lane_); const int nt = wave - 1, n = 16 * nt + (lane & 15);
                const bf16x8 bA0 = frag_rm(lds + I_AT, 16 * nt, 0, lane), bA1 = frag_rm(lds + I_AT, 16 * nt, 32, lane);
                const bf16x8 bR0 = frag_rm(lds + I_RT, 16 * nt, 0, lane), bR1 = frag_rm(lds + I_RT, 16 * nt, 32, lane);
                bf16x8 fk[4][2], fb[4][2];
#pragma unroll
                for (int mt = 0; mt < 4; ++mt) { fk[mt][0] = frag_rm(lds + I_KT, 16 * mt, 0, lane); fk[mt][1] = frag_rm(lds + I_KT, 16 * mt, 32, lane);
                                                 fb[mt][0] = frag_rm(lds + I_BT, 16 * mt, 0, lane); fb[mt][1] = frag_rm(lds + I_BT, 16 * mt, 32, lane); }
                f32x4 laks[4], prbs[4];
#pragma unroll
                for (int mt = 0; mt < 4; ++mt) { const int m0 = 16 * mt + 4 * (lane >> 4);
                    f32x4 lak = MFMA16(fk[mt][1], bA1, MFMA16(fk[mt][0], bA0, fz)), prb = MFMA16(fb[mt][1], bR1, MFMA16(fb[mt][0], bR0, fz));
#pragma unroll
                    for (int q = 0; q < 4; ++q) { lak[q] = (m0 + q < n) ? lak[q] : 0.f; prb[q] = (m0 + q <= n) ? prb[q] : 0.f; }
                    laks[mt] = lak; prbs[mt] = prb; }
#pragma unroll
                for (int mt = 0; mt < 4; ++mt) { st_img(lds + I_LAK, 16 * nt, 16 * mt, lane, laks[mt]); st_img(lds + I_PRB, 16 * nt, 16 * mt, lane, prbs[mt]); }
                bf16x8 fv[4][2];
#pragma unroll
                for (int mt = 0; mt < 4; ++mt) { fv[mt][0] = frag_tr(vvimg, 0, 16 * mt, lane); fv[mt][1] = frag_tr(vvimg, 32, 16 * mt, lane); }
                asm volatile("s_waitcnt lgkmcnt(0)" ::: "memory");
                const bf16x8 bL0 = frag_rm(lds + I_LAK, 16 * nt, 0, lane), bL1 = frag_rm(lds + I_LAK, 16 * nt, 32, lane);
                f32x4 qs[4];
#pragma unroll
                for (int mt = 0; mt < 4; ++mt) qs[mt] = MFMA16(fv[mt][1], bL1, MFMA16(fv[mt][0], bL0, fz));
#pragma unroll
                for (int mt = 0; mt < 4; ++mt) st_img(lds + I_Q, 16 * nt, 16 * mt, lane, qs[mt]);
            } else {
                const int lane = opq(lane_);
#if CVPOS == 3
                if (cvitem >= 0) xcvt_load(p, cvitem, lane, cv);
#endif
#pragma unroll
                for (int bt = 0; bt < 2; ++bt) { bf16x8 fa[3][2], fr[3][2]; f32x4 accs[3];
#pragma unroll
                    for (int k3 = 0; k3 < 3; ++k3) { const int tq = (wave - 5) + 3 * (3 * bt + k3); const int tqc = tq < 16 ? tq : 15, nt = tqc >> 2, mt = tqc & 3;
                        fa[k3][0] = frag_rm(lds + I_KT, 16 * mt, 0, lane); fa[k3][1] = frag_rm(lds + I_KT, 16 * mt, 32, lane);
                        fr[k3][0] = frag_rm(lds + I_RT, 16 * nt, 0, lane); fr[k3][1] = frag_rm(lds + I_RT, 16 * nt, 32, lane); }
#pragma unroll
                    for (int k3 = 0; k3 < 3; ++k3) { const int tq = (wave - 5) + 3 * (3 * bt + k3); const int tqc = tq < 16 ? tq : 15, nt = tqc >> 2, mt = tqc & 3, n = 16 * nt + (lane & 15), m0 = 16 * mt + 4 * (lane >> 4);
                        f32x4 acc = MFMA16(fa[k3][1], fr[k3][1], MFMA16(fa[k3][0], fr[k3][0], fz));
#pragma unroll
                        for (int q = 0; q < 4; ++q) acc[q] = (m0 + q <= n) ? acc[q] : 0.f;
                        accs[k3] = acc; }
#pragma unroll
                    for (int k3 = 0; k3 < 3; ++k3) { const int tq = (wave - 5) + 3 * (3 * bt + k3); const int tqc = tq < 16 ? tq : 15, nt = tqc >> 2, mt = tqc & 3;
                        st_img(lds + I_PRK, 16 * nt, 16 * mt, lane, accs[k3]); } }
#if CVPOS == 2
                if (cvitem >= 0) xcvt_load(p, cvitem, lane, cv);
#endif
                if (cvitem >= 0) xcvt_store(p, cvitem, lane, cv);
            }
            LBAR();
            { const int lane = opq(lane_); const int pr = wave >> 2, nt = wave & 3; const LAS unsigned char* Aimg = lds + (pr ? I_Q : I_AT); LAS unsigned char* Oimg = lds + (pr ? I_W2 : I_W1);
              const bf16x8 bT0 = frag_rm(lds + I_TM, 16 * nt, 0, lane), bT1 = frag_rm(lds + I_TM, 16 * nt, 32, lane);
#pragma unroll
              for (int mt = 0; mt < 4; ++mt) { f32x4 acc = MFMA16(frag_tr(Aimg, 0, 16 * mt, lane), bT0, fz); acc = MFMA16(frag_tr(Aimg, 32, 16 * mt, lane), bT1, acc);
                  st_img(Oimg, 16 * nt, 16 * mt, lane, acc); } }
            LBAR();
            float rn[8], kn[8];
            if (cc + 1 < 34) { X_LERP(XCI(cc + 1), (cc + 1) & 1, rn, kn); LBAR(); X_LORA(); }
            { const int lane = opq(lane_); const int nt = wave >> 1, mb = (wave & 1) * 2;
              const int n = 16 * nt + (lane & 15);
              const bf16x8 bBh0 = frag_tr(lds + I_BH, 0, 16 * nt, lane), bBh1 = frag_tr(lds + I_BH, 32, 16 * nt, lane);
              const bf16x8 bW20 = frag_tr(lds + I_W2, 0, 16 * nt, lane), bW21 = frag_tr(lds + I_W2, 32, 16 * nt, lane);
              const bf16x8 bVv0 = frag_tr(vvimg, 0, 16 * nt, lane), bVv1 = frag_tr(vvimg, 32, 16 * nt, lane);
              const bf16x8 bPb0 = frag_rm(lds + I_PRB, 16 * nt, 0, lane), bPb1 = frag_rm(lds + I_PRB, 16 * nt, 32, lane);
              const bf16x8 bPk0 = frag_rm(lds + I_PRK, 16 * nt, 0, lane), bPk1 = frag_rm(lds + I_PRK, 16 * nt, 32, lane);
              const unsigned MLRo = (unsigned)WS_MLR + (unsigned)u * 8192u, NTo = (unsigned)WS_NT + (unsigned)u * 8192u, RBo = (unsigned)WS_RB + (unsigned)(bhd * 64 + c) * 8192u;
              const int posn = 64 * c + n, tn = dir ? (T - 1 - posn) : posn;
              const unsigned Yo = (unsigned)(dir ? WS_YB : WS_YF) + (unsigned)(((b * T + tn) * DR + h * 64) * 2);
#pragma unroll
              for (int mi = 0; mi < 2; ++mi) { const int mt = mb + mi, m0 = 16 * mt + 4 * (lane >> 4);
                  const bf16x8 aW10 = frag_tr(lds + I_W1, 0, 16 * mt, lane), aW11 = frag_tr(lds + I_W1, 32, 16 * mt, lane);
                  const bf16x8 aBh0 = frag_tr(lds + I_BH, 0, 16 * mt, lane), aBh1 = frag_tr(lds + I_BH, 32, 16 * mt, lane);
                  const bf16x8 aKh0 = frag_tr(lds + I_KH, 0, 16 * mt, lane), aKh1 = frag_tr(lds + I_KH, 32, 16 * mt, lane);
                  const f32x4 mlr = MFMA16(aW11, bBh1, MFMA16(aW10, bBh0, fz));
                  const f32x4 ntv = MFMA16(aKh1, bVv1, MFMA16(aKh0, bVv0, MFMA16(aBh1, bW21, MFMA16(aBh0, bW20, fz))));
                  const int fo = ((nt * 2 + (mt >> 1)) * 64 + (lane & 15) + 16 * (2 * (mt & 1) + (lane >> 5))) * 8 + 4 * ((lane >> 4) & 1);
                  { u32x2 w; w.x = pk2(mlr[0], mlr[1]); w.y = pk2(mlr[2], mlr[3]); *(u32x2*)(p.ws + (size_t)(MLRo + 2u * (unsigned)fo)) = w; }
                  { u32x2 w; w.x = pk2(ntv[0], ntv[1]); w.y = pk2(ntv[2], ntv[3]); *(u32x2*)(p.ws + (size_t)(NTo + 8u * (unsigned)((nt * 4 + mt) * 64 + lane))) = w; }
                  if (!isctx) {
                      const bf16x8 aW20 = frag_tr(lds + I_W2, 0, 16 * mt, lane), aW21 = frag_tr(lds + I_W2, 32, 16 * mt, lane);
                      const bf16x8 aVv0 = frag_tr(vvimg, 0, 16 * mt, lane), aVv1 = frag_tr(vvimg, 32, 16 * mt, lane);
                      f32x4 rb = MFMA16(aW11, bPb1, MFMA16(aW10, bPb0, fz));
                      const f32x4 y0 = MFMA16(aVv1, bPk1, MFMA16(aVv0, bPk0, MFMA16(aW21, bPb1, MFMA16(aW20, bPb0, fz))));
                      rb += up4(*(const LAS u32x2*)(lds + I_RT + ioff(n, m0)));
                      { u32x2 w; w.x = pk2(rb[0], rb[1]); w.y = pk2(rb[2], rb[3]); *(u32x2*)(p.ws + (size_t)(RBo + 2u * (unsigned)fo)) = w; }
                      { u32x2 w; w.x = pk2(y0[0], y0[1]); w.y = pk2(y0[2], y0[3]); *(u32x2*)(p.ws + (size_t)(Yo + 2u * (unsigned)m0)) = w; }
                  } } }
#if XSCOPE
#pragma unroll
            for (int e = 0; e < 8; ++e) { r[e] = rn[e]; k[e] = kn[e]; }
#else
            if (cc + 1 < 34) {
#pragma unroll
                for (int e = 0; e < 8; ++e) { r[e] = rn[e]; k[e] = kn[e]; } }
#endif
        }
    }
}
#undef X_PXLOAD
#undef XCI
#undef X_LERP
#undef X_LORA

struct SSet { bf16x8 A0, A1, R0, R1; u32x2 N0, Y0; f32x4 G; size_t yoff; };
__device__ __forceinline__ void phase_scanS(const Params& p, LAS unsigned char* lds, int bid, int G, int wv) {
    const int tid = my_tid(wv), lane = tid & 63, wave = __builtin_amdgcn_readfirstlane(tid >> 6);
    LAS unsigned char* HH = lds; LAS unsigned char* HL = lds + IMG;
    const int mtk = wave >> 1, ntl = wave & 1;
    const f32x4 fz = (f32x4){0.f, 0.f, 0.f, 0.f};
    for (int it = bid; it < NB * NH * 2 * 2; it += G) {
        const int item = it & 127, half = it >> 7, ntg = 2 * half + ntl;
        const int dir = item & 1, h = (item >> 1) & 7, b = item >> 4;
        f32x4 Hm0 = fz;
        LBAR();
        st_img(HH, 16 * ntl, 16 * mtk, lane, fz); st_img(HL, 16 * ntl, 16 * mtk, lane, fz);
        LBAR();
        const bf16_t* MLRg = (const bf16_t*)(p.ws + WS_MLR) + (size_t)item * 68 * 4096; const bf16_t* NTg = (const bf16_t*)(p.ws + WS_NT) + (size_t)item * 68 * 4096;
        const float* GAMg = (const float*)(p.ws + WS_GAM) + (size_t)item * 68 * 64; const bf16_t* RBg = (const bf16_t*)(p.ws + WS_RB) + (size_t)item * 64 * 4096;
        bf16_t* Yg = (bf16_t*)(p.ws + (dir ? WS_YB : WS_YF)) + (size_t)b * T * DR + h * 64;
        const int arow = (mtk * 2 * 64 + lane) * 8;
#define S_LOAD(S_, ci_) do { const int ci__ = (ci_) < 68 ? (ci_) : 67; const int c__ = ci__ >= 4 ? ci__ - 4 : 0; \
            const bf16_t* M__ = MLRg + (size_t)ci__ * 4096; S_.A0 = *(const bf16x8*)(M__ + arow); S_.A1 = *(const bf16x8*)(M__ + arow + 512); \
            S_.N0 = *(const u32x2*)(NTg + (size_t)ci__ * 4096 + lane * 4 + (ntg * 4 + mtk) * 256); \
            S_.G = *(const f32x4*)(GAMg + ci__ * 64 + 16 * mtk + 4 * (lane >> 4)); \
            const bf16_t* R__ = RBg + (size_t)c__ * 4096; S_.R0 = *(const bf16x8*)(R__ + arow); S_.R1 = *(const bf16x8*)(R__ + arow + 512); \
            const int pos__ = 64 * c__ + 16 * mtk + (lane & 15), t__ = dir ? (T - 1 - pos__) : pos__; \
            S_.yoff = (size_t)t__ * DR + 4 * (lane >> 4) + 16 * ntg; S_.Y0 = *(const u32x2*)(Yg + S_.yoff); } while (0)
#define S_STEP(S_, ci_) do { if ((ci_) < 68) { \
            const bf16x8 h00 = frag_rm(HH, 16 * ntl, 0, lane), h01 = frag_rm(HH, 16 * ntl, 32, lane); \
            const bf16x8 l00 = frag_rm(HL, 16 * ntl, 0, lane), l01 = frag_rm(HL, 16 * ntl, 32, lane); \
            f32x4 a0 = Hm0 * S_.G + up4(S_.N0); \
            a0 = MFMA16(S_.A0, h00, a0); a0 = MFMA16(S_.A1, h01, a0); a0 = MFMA16(S_.A0, l00, a0); a0 = MFMA16(S_.A1, l01, a0); \
            if ((ci_) >= 4) { \
                f32x4 y0 = up4(S_.Y0); \
                y0 = MFMA16(h00, S_.R0, y0); y0 = MFMA16(h01, S_.R1, y0); y0 = MFMA16(l00, S_.R0, y0); y0 = MFMA16(l01, S_.R1, y0); \
                { u32x2 w; w.x = pk2(y0[0], y0[1]); w.y = pk2(y0[2], y0[3]); *(u32x2*)(Yg + S_.yoff) = w; } } \
            LBAR(); \
            Hm0 = a0; \
            { f32x4 hi, lo; \
              _Pragma("unroll") for (int q = 0; q < 4; ++q) { hi[q] = __uint_as_float(f2bf(a0[q]) << 16); lo[q] = a0[q] - hi[q]; } \
              st_img(HH, 16 * ntl, 16 * mtk, lane, hi); st_img(HL, 16 * ntl, 16 * mtk, lane, lo); } \
            LBAR(); } } while (0)
        SSet s0, s1, s2, s3;
        S_LOAD(s0, 0); S_LOAD(s1, 1); S_LOAD(s2, 2);
        for (int ci = 0; ci < 68; ci += 4) {
            S_LOAD(s3, ci + 3); S_STEP(s0, ci);
            S_LOAD(s0, ci + 4); S_STEP(s1, ci + 1);
            S_LOAD(s1, ci + 5); S_STEP(s2, ci + 2);
            S_LOAD(s2, ci + 6); S_STEP(s3, ci + 3);
        }
#undef S_LOAD
#undef S_STEP
    }
}

__device__ __forceinline__ void phase_out(const Params& p, LAS unsigned char* lds, int bid, int G, int wv) {
    const int tid_ = my_tid(wv), lane_ = tid_ & 63, wave = __builtin_amdgcn_readfirstlane(tid_ >> 6);
    const bf16_t* PX = (const bf16_t*)(p.ws + WS_PX); const bf16_t* YF = (const bf16_t*)(p.ws + WS_YF); const bf16_t* YB = (const bf16_t*)(p.ws + WS_YB);
    const float* BDOT = (const float*)(p.ws + WS_BDOT);
    bf16_t* AX = (bf16_t*)(p.ws + WS_AX);
    const float* mu = p.in[9];
    constexpr int SGS = 272;
    LAS unsigned char* SG = lds;
    LAS unsigned char* GW = lds + 64 * SGS + wave * IMG;
    const f32x4 fz = (f32x4){0.f, 0.f, 0.f, 0.f};
    bf16x8 gf[4][4];
    { const float* gu = p.in[17] + wave * 64 + (lane_ & 15);
#pragma unroll
      for (int ct = 0; ct < 4; ++ct)
#pragma unroll
          for (int ks = 0; ks < 4; ++ks) { float f[8];
#pragma unroll
              for (int e = 0; e < 8; ++e) f[e] = gu[(size_t)(32 * ks + 8 * (lane_ >> 4) + e) * DR + 16 * ct];
              gf[ct][ks] = __builtin_bit_cast(bf16x8, pack8(f)); } }
    const int tokl = lane_ >> 3, cs = lane_ & 7, cb = wave * 64 + cs * 8;
    float gng[8], gnb[8];
    { const f32x4 g0 = *(const f32x4*)(p.in[18] + cb), g1 = *(const f32x4*)(p.in[18] + cb + 4), b0 = *(const f32x4*)(p.in[19] + cb), b1 = *(const f32x4*)(p.in[19] + cb + 4);
      gng[0] = g0.x; gng[1] = g0.y; gng[2] = g0.z; gng[3] = g0.w; gng[4] = g1.x; gng[5] = g1.y; gng[6] = g1.z; gng[7] = g1.w;
      gnb[0] = b0.x; gnb[1] = b0.y; gnb[2] = b0.z; gnb[3] = b0.w; gnb[4] = b1.x; gnb[5] = b1.y; gnb[6] = b1.z; gnb[7] = b1.w; }
    for (int bq = bid; bq < MX / 64; bq += G) {
        const int bt = (G == 256) ? ((bq & 7) * 64 + ((bq & 255) >> 3) * 2 + (bq >> 8)) : bq;
        const int tok0 = bt * 64, b = tok0 >> 12, rowbase = b * T;
        LBAR();
        { const int tid = opq(tid_), tl = tid >> 3, sub = tid & 7; const int tok = tok0 + tl, t = tok & (T - 1);
          int nbr[4]; neighbours(t, false, rowbase, nbr);
          const Px5 q0 = px_load(PX, tok, nbr, 1664 + sub * 16), q1 = px_load(PX, tok, nbr, 1664 + sub * 16 + 8);
          float x0[8], x1[8]; px_lerp(q0, false, 1664 + sub * 16, mu, x0); px_lerp(q1, false, 1664 + sub * 16 + 8, mu, x1);
#pragma unroll
          for (int e = 0; e < 8; ++e) { x0[e] = fsigmoid(x0[e]); x1[e] = fsigmoid(x1[e]); }
          *(LAS u32x4*)(SG + tl * SGS + sub * 32) = pack8(x0); *(LAS u32x4*)(SG + tl * SGS + sub * 32 + 16) = pack8(x1); }
        LBAR();
        { const int lane = opq(lane_);
#pragma unroll
          for (int tt = 0; tt < 4; ++tt) { bf16x8 bs[4];
#pragma unroll
              for (int ks = 0; ks < 4; ++ks) bs[ks] = *(const LAS bf16x8*)(SG + (16 * tt + (lane & 15)) * SGS + (32 * ks + 8 * (lane >> 4)) * 2);
#pragma unroll
              for (int ct = 0; ct < 4; ++ct) { f32x4 acc = fz;
#pragma unroll
                  for (int ks = 0; ks < 4; ++ks) acc = MFMA16(gf[ct][ks], bs[ks], acc);
                  st_img(GW, 16 * tt, 16 * ct, lane, acc); } } }
        asm volatile("s_waitcnt lgkmcnt(0)" ::: "memory");
#pragma unroll 2
        for (int ps = 0; ps < 8; ++ps) {
            const int lane = opq(lane_); const int tl = 8 * ps + (lane >> 3), tok = tok0 + tl, t = tok & (T - 1);
            int nbr[4]; neighbours(t, false, rowbase, nbr);
            const Px5 qv = px_load(PX, tok, nbr, 1024 + cb);
            float yf[8], yb[8], y[8], g[8], v[8];
            unpack8(*(const u32x4*)(YF + (size_t)tok * DR + cb), yf); unpack8(*(const u32x4*)(YB + (size_t)tok * DR + cb), yb);
            const float bd = BDOT[(size_t)tok * NH + wave] + BDOT[((size_t)MX + tok) * NH + wave];
            unpack8(*(const LAS u32x4*)(GW + ioff(tl, 8 * (lane & 7))), g);
            px_lerp(qv, false, 1024 + cb, mu, v);
            float s1 = 0.f;
#pragma unroll
            for (int e = 0; e < 8; ++e) { y[e] = yf[e] + yb[e]; s1 += y[e]; }
            const float mean = red8(s1) * (1.f / 64.f);
            float s2 = 0.f;
#pragma unroll
            for (int e = 0; e < 8; ++e) { y[e] -= mean; s2 += y[e] * y[e]; }
            const float rstd = rsqrtf(red8(s2) * (1.f / 64.f) + 64e-5f);
            float ax[8];
#pragma unroll
            for (int e = 0; e < 8; ++e) ax[e] = (y[e] * rstd * gng[e] + gnb[e] + bd * v[e]) * g[e];
            *(u32x4*)(AX + (size_t)tok * D + cb) = pack8(ax);
        }
        { const float* cwp = p.in[20] + cb;
          const f32x4 w00 = *(const f32x4*)(cwp), w01 = *(const f32x4*)(cwp + 4), w10 = *(const f32x4*)(cwp + DR), w11 = *(const f32x4*)(cwp + DR + 4), w20 = *(const f32x4*)(cwp + 2 * DR), w21 = *(const f32x4*)(cwp + 2 * DR + 4);
          const float cw0[8] = {w00.x, w00.y, w00.z, w00.w, w01.x, w01.y, w01.z, w01.w}, cw1[8] = {w10.x, w10.y, w10.z, w10.w, w11.x, w11.y, w11.z, w11.w}, cw2[8] = {w20.x, w20.y, w20.z, w20.w, w21.x, w21.y, w21.z, w21.w};
#pragma unroll 2
          for (int ps = 0; ps < 8; ++ps) {
              const int lane = opq(lane_); const int tok = tok0 + 8 * ps + (lane >> 3), t = tok & (T - 1);
              float bg[8], c0[8], u0[8], cm[8], um[8], cp[8], up[8];
              const u32x4 z = (u32x4){0u, 0u, 0u, 0u};
              const bf16_t* pr = PX + (size_t)tok * DIN + RWC + cb;
              unpack8(*(const u32x4*)pr, bg); unpack8(*(const u32x4*)(pr + 512), c0); unpack8(*(const u32x4*)(pr + 1024), u0);
              unpack8(t > 0 ? *(const u32x4*)(pr - DIN + 512) : z, cm); unpack8(t > 0 ? *(const u32x4*)(pr - DIN + 1024) : z, um);
              unpack8(t < T - 1 ? *(const u32x4*)(pr + DIN + 512) : z, cp); unpack8(t < T - 1 ? *(const u32x4*)(pr + DIN + 1024) : z, up);
              float bx[8];
#pragma unroll
              for (int e = 0; e < 8; ++e) bx[e] = bg[e] * (cw0[e] * (cm[e] * um[e]) + cw1[e] * (c0[e] * u0[e]) + cw2[e] * (cp[e] * up[e]));
              *(u32x4*)(AX + (size_t)tok * D + DR + cb) = pack8(bx);
          } }
    }
}

__device__ __forceinline__ void phase_hx(const Params& p, LAS unsigned char* lds, int bid, int G, int wv) {
    const int tid = my_tid(wv), lane = tid & 63, wave = tid >> 6;
    const bf16_t* X1 = (const bf16_t*)(p.ws + WS_X1); const float* MOD = (const float*)(p.ws + WS_MOD); const float* n2g = p.in[7];
    unsigned char* HX = p.ws + WS_HX; float* AFF = (float*)(p.ws + WS_AFF);
    LAS float* RW = (LAS float*)lds;
    { const float* rw = p.in[22]; for (int i = tid; i < 1024 * 16; i += NTHR) RW[(i & 15) * 1024 + (i >> 4)] = rw[i]; }
    __syncthreads();
    const int gw = bid * NWAVES + wave, NGW = G * NWAVES;
    const bool u5 = (lane & 32) != 0, u4 = (lane & 16) != 0, u3 = (lane & 8) != 0, u2 = (lane & 4) != 0;
    const int emine = (u5 ? 8 : 0) + (u4 ? 4 : 0) + (u3 ? 2 : 0) + (u2 ? 1 : 0);
    for (int blk = gw; blk < MX / 16; blk += NGW) {
        const int tokb = blk * 16, b = tokb >> 12;
        const float* sh = MOD + (size_t)b * 6144 + 3072; const float* scp = sh + 1024;
        f32x4 ga[4], hb[4];
#pragma unroll
        for (int j = 0; j < 4; ++j) { const int col = 4 * (lane + 64 * j); ga[j] = *(const f32x4*)(n2g + col) * (*(const f32x4*)(scp + col) + 1.f); hb[j] = *(const f32x4*)(sh + col); }
        u32x2 xq[2][4];
#pragma unroll
        for (int tk = 0; tk < 2; ++tk)
#pragma unroll
            for (int j = 0; j < 4; ++j) xq[tk][j] = ((const u32x2*)(X1 + (size_t)(tokb + tk) * D))[lane + 64 * j];
        for (int it = 0; it < 8; ++it) {
            f32x4 yv[2][4]; float lg[2][16];
            u32x2 xn[2][4];
            { const int itn = it < 7 ? it + 1 : it;
#pragma unroll
              for (int tk = 0; tk < 2; ++tk)
#pragma unroll
                for (int j = 0; j < 4; ++j) xn[tk][j] = ((const u32x2*)(X1 + (size_t)(tokb + 2 * itn + tk) * D))[lane + 64 * j]; }
#pragma unroll
            for (int tk = 0; tk < 2; ++tk) { const int tok = tokb + 2 * it + tk;
                f32x4 v[4]; float ss = 0.f;
#pragma unroll
                for (int j = 0; j < 4; ++j) { v[j] = up4(xq[tk][j]); ss += (v[j].x * v[j].x + v[j].y * v[j].y) + (v[j].z * v[j].z + v[j].w * v[j].w); }
                const float rstd = rsqrtf(wave_sum(ss) * (1.f / D) + 1e-6f);
#pragma unroll
                for (int j = 0; j < 4; ++j) { const f32x4 y = v[j] * rstd * ga[j] + hb[j]; yv[tk][j] = y;
#if MOE_FP8
                    *(unsigned*)(HX + (size_t)tok * D + 4 * (lane + 64 * j)) = pk4_fp8_raw(y.x, y.y, y.z, y.w); } }
#else
                    u32x2 o; o.x = pk2(y.x, y.y); o.y = pk2(y.z, y.w);
                    *(u32x2*)((bf16_t*)HX + (size_t)tok * D + 4 * (lane + 64 * j)) = o; } }
#endif
#pragma unroll
            for (int e = 0; e < 16; ++e) { f32x2 p0 = (f32x2){0.f, 0.f}, p1 = (f32x2){0.f, 0.f};
#pragma unroll
                for (int j = 0; j < 4; ++j) { const f32x4 w = *(const LAS f32x4*)(RW + e * 1024 + 4 * (lane + 64 * j)); const f32x4 y0 = yv[0][j], y1 = yv[1][j];
                    const f32x2 wl = (f32x2){w.x, w.y}, wh = (f32x2){w.z, w.w};
                    p0 += (f32x2){y0.x, y0.y} * wl; p0 += (f32x2){y0.z, y0.w} * wh; p1 += (f32x2){y1.x, y1.y} * wl; p1 += (f32x2){y1.z, y1.w} * wh; }
                float a0 = p0.x + p0.y, a1 = p1.x + p1.y;
                asm volatile("" : "+v"(a0), "+v"(a1) :: "memory");
                lg[0][e] = a0; lg[1][e] = a1; }
#pragma unroll
            for (int tk = 0; tk < 2; ++tk) { const int tok = tokb + 2 * it + tk, t = tok & (T - 1);
                float r8[8], r4[4], r2[2], r1;
#pragma unroll
                for (int k = 0; k < 8; ++k) { const float keep = u5 ? lg[tk][k + 8] : lg[tk][k], send = u5 ? lg[tk][k] : lg[tk][k + 8]; r8[k] = keep + __shfl_xor(send, 32); }
#pragma unroll
                for (int k = 0; k < 4; ++k) { const float keep = u4 ? r8[k + 4] : r8[k], send = u4 ? r8[k] : r8[k + 4]; r4[k] = keep + __shfl_xor(send, 16); }
#pragma unroll
                for (int k = 0; k < 2; ++k) { const float keep = u3 ? r4[k + 2] : r4[k], send = u3 ? r4[k] : r4[k + 2]; r2[k] = keep + __shfl_xor(send, 8); }
                { const float keep = u2 ? r2[1] : r2[0], send = u2 ? r2[0] : r2[1]; r1 = keep + __shfl_xor(send, 4); }
                r1 += __shfl_xor(r1, 1); r1 += __shfl_xor(r1, 2);
                float mx = r1;
                mx = fmaxf(mx, __shfl_xor(mx, 4)); mx = fmaxf(mx, __shfl_xor(mx, 8)); mx = fmaxf(mx, __shfl_xor(mx, 16)); mx = fmaxf(mx, __shfl_xor(mx, 32));
                const float ex = expf(r1 - mx);
                float den = ex;
                den += __shfl_xor(den, 4); den += __shfl_xor(den, 8); den += __shfl_xor(den, 16); den += __shfl_xor(den, 32);
                if ((lane & 3) == 0) AFF[((size_t)b * NE + emine) * T + t] = ex / den; }
#pragma unroll
            for (int tk = 0; tk < 2; ++tk)
#pragma unroll
                for (int j = 0; j < 4; ++j) xq[tk][j] = xn[tk][j];
        }
    }
}

__device__ __forceinline__ int block_scan512(int v, LAS int* sc, int tid, int& total) {
    const int lane = tid & 63, w = tid >> 6;
    int x = v;
#pragma unroll
    for (int o = 1; o < 64; o <<= 1) { const int y = __shfl_up(x, o); x += (lane >= o) ? y : 0; }
    if (lane == 63) sc[w] = x;
    __syncthreads();
    int base = 0, tot = 0;
#pragma unroll
    for (int i = 0; i < 8; ++i) { const int t = sc[i]; tot += t; base += (i < w) ? t : 0; }
    __syncthreads();
    total = tot; return base + x - v;
}
__device__ __forceinline__ void radix_round(const int (&bin)[8], const bool (&act)[8], int need, LAS int* hist, LAS int* sc, int tid, int& Bsel, int& aboveSel) {
#pragma unroll
    for (int q = 0; q < 8; ++q) hist[tid * 8 + q] = 0;
    __syncthreads();
#pragma unroll
    for (int q = 0; q < 8; ++q) if (act[q]) atomicAdd((int*)(hist + bin[q]), 1);
    __syncthreads();
    int c[8], ssum = 0;
#pragma unroll
    for (int q = 0; q < 8; ++q) { c[q] = hist[tid * 8 + q]; ssum += c[q]; }
    int total; const int P = block_scan512(ssum, sc, tid, total);
    int running = total - P - ssum;
#pragma unroll
    for (int q = 7; q >= 0; --q) { if (running < need && running + c[q] >= need) { sc[8] = tid * 8 + q; sc[9] = running; } running += c[q]; }
    __syncthreads();
    Bsel = sc[8]; aboveSel = sc[9];
    __syncthreads();
}
__device__ __forceinline__ void phase_topk(const Params& p, LAS unsigned char* lds, int bid, int G, int wv) {
    const int tid = my_tid(wv);
    const float* AFF = (const float*)(p.ws + WS_AFF);
    int* IDX = (int*)(p.ws + WS_IDX); float* VAL = (float*)(p.ws + WS_VAL); int* SEL = (int*)(p.ws + WS_SEL);
    LAS int* hist = (LAS int*)lds;
    LAS int* sc = (LAS int*)(lds + 16384);
    for (int item = bid; item < NB * NE; item += G) {
        const int b = item >> 4, e = item & 15;
        __syncthreads();
        const f32x4 v0 = ((const f32x4*)(AFF + (size_t)item * T))[2 * tid], v1 = ((const f32x4*)(AFF + (size_t)item * T))[2 * tid + 1];
        const float val[8] = {v0.x, v0.y, v0.z, v0.w, v1.x, v1.y, v1.z, v1.w};
        unsigned key[8]; int bin[8]; bool act[8];
#pragma unroll
        for (int q = 0; q < 8; ++q) { key[q] = __float_as_uint(val[q]); bin[q] = (int)(key[q] >> 20); act[q] = true; }
        int B1, ab1; radix_round(bin, act, CAP, hist, sc, tid, B1, ab1);
        const int need1 = CAP - ab1;
#pragma unroll
        for (int q = 0; q < 8; ++q) { act[q] = (int)(key[q] >> 20) == B1; bin[q] = (int)((key[q] >> 8) & 0xFFFu); }
        int B2, ab2; radix_round(bin, act, need1, hist, sc, tid, B2, ab2);
        const int need2 = need1 - ab2;
#pragma unroll
        for (int q = 0; q < 8; ++q) { act[q] = act[q] && (int)((key[q] >> 8) & 0xFFFu) == B2; bin[q] = (int)(key[q] & 0xFFu); }
        int B3, ab3; radix_round(bin, act, need2, hist, sc, tid, B3, ab3);
        const int need3 = need2 - ab3;
        const unsigned K = ((unsigned)B1 << 20) | ((unsigned)B2 << 8) | (unsigned)B3;
        int eqc = 0;
#pragma unroll
        for (int q = 0; q < 8; ++q) eqc += (key[q] == K) ? 1 : 0;
        int tot; int eqr = block_scan512(eqc, sc, tid, tot);
        bool selq[8]; int cnt = 0;
#pragma unroll
        for (int q = 0; q < 8; ++q) { const bool eq = key[q] == K; selq[q] = key[q] > K || (eq && eqr < need3); eqr += eq ? 1 : 0; cnt += selq[q] ? 1 : 0; }
        int slot = block_scan512(cnt, sc, tid, tot);
#pragma unroll
        for (int q = 0; q < 8; ++q) { const int tok = tid * 8 + q;
            SEL[(size_t)item * T + tok] = selq[q] ? slot : -1;
            if (selq[q]) { IDX[(e * NB + b) * CAP + slot] = b * T + tok; VAL[(e * NB + b) * CAP + slot] = val[q]; ++slot; } }
    }
}

__device__ __forceinline__ void phase_final(const Params& p, int bid, int G, int wv) {
    const int tid = my_tid(wv), lane = tid & 63, wave = tid >> 6;
    const bf16_t* X1 = (const bf16_t*)(p.ws + WS_X1); const bf16_t* DN = (const bf16_t*)(p.ws + WS_DN); const int* SEL = (const int*)(p.ws + WS_SEL);
    const float* fg = p.in[26];
    const int gw = bid * NWAVES + wave, NGW = G * NWAVES;
    for (int tok0 = gw; tok0 < MX; tok0 += 2 * NGW) {
        f32x4 v[2][4]; int sel[2]; unsigned long long mask[2];
#pragma unroll
        for (int tk = 0; tk < 2; ++tk) { const int tok = tok0 + tk * NGW, b = tok >> 12, t = tok & (T - 1);
            sel[tk] = lane < NE ? SEL[((size_t)b * NE + lane) * T + t] : -1;
#pragma unroll
            for (int j = 0; j < 4; ++j) v[tk][j] = up4(((const u32x2*)(X1 + (size_t)tok * D))[lane + 64 * j]); }
#pragma unroll
        for (int tk = 0; tk < 2; ++tk) mask[tk] = __ballot(sel[tk] >= 0);
#pragma unroll
        for (int tk = 0; tk < 2; ++tk) { const int tok = tok0 + tk * NGW, b = tok >> 12;
            unsigned long long m = mask[tk];
            while (m) {
#if MOE_FP8
                const unsigned char* rp[4]; float wg[4];
#pragma unroll
                for (int q = 0; q < 4; ++q) {
                    if (m) { const int e = __builtin_ctzll(m); m &= m - 1; const int s_ = __builtin_amdgcn_readlane(sel[tk], e);
                        rp[q] = (const unsigned char*)DN + ((size_t)(e * NB + b) * CAP + s_) * D; wg[q] = 1.f / 16.f; }
                    else { rp[q] = (const unsigned char*)DN; wg[q] = 0.f; } }
                unsigned w[4][4];
#pragma unroll
                for (int q = 0; q < 4; ++q)
#pragma unroll
                    for (int j = 0; j < 4; ++j) w[q][j] = *(const unsigned*)(rp[q] + 4 * (lane + 64 * j));
#pragma unroll
                for (int q = 0; q < 4; ++q)
#pragma unroll
                    for (int j = 0; j < 4; ++j) { const f32x2 lo = __builtin_amdgcn_cvt_pk_f32_fp8((int)w[q][j], false), hi = __builtin_amdgcn_cvt_pk_f32_fp8((int)w[q][j], true);
                        v[tk][j].x += wg[q] * lo.x; v[tk][j].y += wg[q] * lo.y; v[tk][j].z += wg[q] * hi.x; v[tk][j].w += wg[q] * hi.y; }
#else
                const bf16_t* rp[4]; float wg[4];
#pragma unroll
                for (int q = 0; q < 4; ++q) {
                    if (m) { const int e = __builtin_ctzll(m); m &= m - 1; const int s_ = __builtin_amdgcn_readlane(sel[tk], e);
                        rp[q] = DN + ((size_t)(e * NB + b) * CAP + s_) * D; wg[q] = 1.f; }
                    else { rp[q] = DN; wg[q] = 0.f; } }
                u32x2 w[4][4];
#pragma unroll
                for (int q = 0; q < 4; ++q)
#pragma unroll
                    for (int j = 0; j < 4; ++j) w[q][j] = *(const u32x2*)(rp[q] + 4 * (lane + 64 * j));
#pragma unroll
                for (int q = 0; q < 4; ++q)
#pragma unroll
                    for (int j = 0; j < 4; ++j) { v[tk][j].x += wg[q] * bflo(w[q][j].x); v[tk][j].y += wg[q] * bfhi(w[q][j].x); v[tk][j].z += wg[q] * bflo(w[q][j].y); v[tk][j].w += wg[q] * bfhi(w[q][j].y); }
#endif
            } }
#pragma unroll
        for (int tk = 0; tk < 2; ++tk) { const int tok = tok0 + tk * NGW;
            float ss = 0.f;
#pragma unroll
            for (int j = 0; j < 4; ++j) ss += (v[tk][j].x * v[tk][j].x + v[tk][j].y * v[tk][j].y) + (v[tk][j].z * v[tk][j].z + v[tk][j].w * v[tk][j].w);
            const float rstd = rsqrtf(wave_sum(ss) * (1.f / D) + 1e-6f);
#pragma unroll
            for (int j = 0; j < 4; ++j) { const int col = 4 * (lane + 64 * j); const f32x4 g = *(const f32x4*)(fg + col);
                *(f32x4*)(p.out + (size_t)tok * D + col) = v[tk][j] * rstd * g; } }
    }
}

#define XB_TMO      128
#define XB_XCNT(j)  (256  + 64 * (j))
#define XB_XSUB(j)  (1280 + 64 * (j))
#define XB_XGEN(j)  (2304 + 64 * (j))
#define XB_TOP      3328
#define XB_TOPGEN   3392
#define XCD_BAR_WORDS 3456
#define XB_SPIN_CAP (1u << 20)
__device__ __forceinline__ unsigned xb_ld(unsigned* p)              { return __hip_atomic_load(p, __ATOMIC_RELAXED, __HIP_MEMORY_SCOPE_AGENT); }
__device__ __forceinline__ unsigned xb_add(unsigned* p, unsigned v) { return __hip_atomic_fetch_add(p, v, __ATOMIC_RELAXED, __HIP_MEMORY_SCOPE_AGENT); }
__device__ __forceinline__ unsigned xb_xcc_id() { return (unsigned)__builtin_amdgcn_s_getreg((3 << 11) | 20) & 0xFu; }
#define XB_SPIN(cond, bar) do { unsigned _sp = 0; while (cond) { __builtin_amdgcn_s_sleep(1); \
    if ((++_sp & 255u) == 0u) { if (xb_ld(&(bar)[XB_TMO])) break; if (_sp > XB_SPIN_CAP) { atomicAdd(&(bar)[XB_TMO], 1u); break; } } } } while (0)
struct XcdBarrier { unsigned* bar; unsigned x; volatile LAS unsigned* st; int wv; };
__device__ __forceinline__ XcdBarrier xcd_barrier_post(unsigned* bar, volatile LAS unsigned* st, int wv) {
    XcdBarrier b; b.bar = bar; b.x = xb_xcc_id(); b.st = st; b.wv = wv;
    if (my_tid(wv) == 0) (void)xb_add(&bar[XB_XCNT(b.x)], 1u);
    return b;
}
__device__ __forceinline__ void xcd_barrier_complete(unsigned* bar, unsigned x, unsigned& nloc, unsigned& nx) {
    const unsigned G = gridDim.x * gridDim.y * gridDim.z;
    unsigned sum, cnt, mine, sp = 0u;
    for (;;) {
        sum = 0u; cnt = 0u; mine = 0u;
#pragma unroll
        for (unsigned j = 0; j < 16; ++j) { const unsigned c = xb_ld(&bar[XB_XCNT(j)]); sum += c; cnt += (c > 0u) ? 1u : 0u; mine = (j == x) ? c : mine; }
        if (sum == G) break;
        __builtin_amdgcn_s_sleep(1);
        if ((++sp & 255u) == 0u) { if (xb_ld(&bar[XB_TMO])) break; if (sp > XB_SPIN_CAP) { atomicAdd(&bar[XB_TMO], 1u); break; } }
    }
    nloc = mine > 0u ? mine : 1u; nx = cnt > 0u ? cnt : 1u;
}
__device__ __forceinline__ void xcd_barrier(const XcdBarrier& b) {
    asm volatile("s_waitcnt vmcnt(0)" ::: "memory");
    __syncthreads();
    if (my_tid(b.wv) == 0) {
        unsigned* bar = b.bar;
        __builtin_amdgcn_s_waitcnt(0);
        unsigned nloc = b.st[0], nx = b.st[1];
        if (nloc == 0u) { xcd_barrier_complete(bar, b.x, nloc, nx); b.st[0] = nloc; b.st[1] = nx; }
        const unsigned old = xb_add(&bar[XB_XSUB(b.x)], 1u);
        const unsigned gen = old / nloc;
        if (old + 1u == (gen + 1u) * nloc) {
            __builtin_amdgcn_fence(__ATOMIC_RELEASE, "agent");
            asm volatile("s_waitcnt vmcnt(0)" ::: "memory");
            const unsigned og = xb_add(&bar[XB_TOP], 1u);
            const unsigned tg = og / nx;
            if (og + 1u == (tg + 1u) * nx) xb_add(&bar[XB_TOPGEN], 1u);
            else XB_SPIN(xb_ld(&bar[XB_TOPGEN]) == tg, bar);
            __builtin_amdgcn_fence(__ATOMIC_ACQUIRE, "agent");
            xb_add(&bar[XB_XGEN(b.x)], 1u);
            asm volatile("s_waitcnt vmcnt(0)" ::: "memory");
        } else {
            XB_SPIN(xb_ld(&bar[XB_XGEN(b.x)]) == gen, bar);
            __builtin_amdgcn_fence(__ATOMIC_ACQUIRE, "agent");
            asm volatile("s_waitcnt vmcnt(0)" ::: "memory");
        }
    }
    __syncthreads();
}

constexpr int N_PHASES = 12;
__global__ void __launch_bounds__(NTHR, 2) mk_fwd(Params p) {
    extern __shared__ __attribute__((aligned(16))) unsigned char lds_raw[];
    LAS unsigned char* lds = (LAS unsigned char*)lds_raw;
    const int bid = blockIdx.x, G = gridDim.x;
    const int wv = __builtin_amdgcn_readfirstlane((int)threadIdx.x >> 6);
    const int lo = p.ph_lo, hi = p.ph_hi;
#if MK_FUSED
    volatile LAS unsigned* misc = (volatile LAS unsigned*)(lds + LDS_MISC);
    { const int t0 = my_tid(wv); if (t0 < 16) misc[t0] = 0u; }
    __syncthreads();
    const XcdBarrier xbar = xcd_barrier_post((unsigned*)(p.ws + WS_CTL) + 4096, misc, wv);
#define SEAM(k) do { if (lo <= (k) && (k) + 1 < hi) xcd_barrier(xbar); } while (0)
#else
#define SEAM(k) do { } while (0)
#endif
#ifndef PH_MASK
#define PH_MASK 0xFFF
#endif
#ifndef PH_REP
#define PH_REP 0
#endif
#define NREP(k) ((((PH_REP) >> (k)) & 1) ? 2 : 1)
#define IN(k) (((PH_MASK >> (k)) & 1) && lo <= (k) && (k) < hi)
    unsigned char* ws = sgpr_ptr(p.ws); unsigned char* outs = sgpr_ptr(p.out);
    if (IN(0)) { for (int r = 0; r < NREP(0); ++r) { phase0(p, lds, bid, G, wv); __syncthreads(); } SEAM(0); }
    if (IN(1)) { for (int r = 0; r < NREP(1); ++r) phase1(p, bid, G, wv); SEAM(1); }
    if (IN(2)) {
        pg8::Gemm g{(const bf16_t*)(ws + WS_XN), (const bf16_t*)(ws + WS_WINT), MALL, DIN, D, nullptr};
        pg8::InProjOrder S; S.init(G, bid);
        pg8::EpiBf16Plain E{(bf16_t*)(ws + WS_PX), DIN};
        pg8::gemm_phase<pg8::EpiBf16Plain, pg8::InProjOrder, true, true, false, false, PG8_BUF_IN>(lds, g, S, E, wv);
        SEAM(2);
    }
    for (int rep = 0; rep < NREP(4); ++rep) {
    if (IN(3)) { for (int r3 = 0; r3 < NREP(3); ++r3) phase_scanX(p, lds, bid, G, wv); SEAM(3); }
    if (IN(4)) { phase_scanS(p, lds, bid, G, wv); SEAM(4); }
    }
    if (IN(5)) { for (int r = 0; r < NREP(5); ++r) phase_out(p, lds, bid, G, wv); SEAM(5); }
    if (IN(6)) {
        pg8::Gemm g{(const bf16_t*)(ws + WS_AX), (const bf16_t*)(ws + WS_WOUTT), MX, D, D, nullptr};
        pg8::StaticOrder S; S.init(MX, D, G, bid);
        pg8::EpiResid E{p.in[0], (bf16_t*)(ws + WS_X1), (const float*)(ws + WS_MOD)};
        pg8::gemm_phase<pg8::EpiResid, pg8::StaticOrder, true, true, false, false, PG8_BUF_OUT>(lds, g, S, E, wv);
        SEAM(6);
    }
    if (IN(7)) { for (int r = 0; r < NREP(7); ++r) { phase_hx(p, lds, bid, G, wv); __syncthreads(); }
#if CVPOS == 0
        { const int tid = my_tid(wv), lane = tid & 63, gw = bid * NWAVES + (tid >> 6);
          for (int g = gw; g < 3 * 8192; g += G * NWAVES) { f32x4 cv[8]; xcvt_load(p, g, lane, cv); xcvt_store(p, g, lane, cv); } }
#endif
        SEAM(7); }
    if (IN(8)) { for (int r = 0; r < NREP(8); ++r) phase_topk(p, lds, bid, G, wv); SEAM(8); }
    if (IN(9)) {
        pg8::Gemm g{(const bf16_t*)(ws + WS_HX), (const bf16_t*)outs, NE * NB * CAP, NE * 2048, MOE_FP8 ? D / 2 : D, (const int*)(ws + WS_IDX)};
        pg8::ExpertOrder S; S.init(NE, 16, 8, G, bid);
        pg8::EpiSwiGLU E{ws + WS_HID};
        pg8::gemm_phase<pg8::EpiSwiGLU, pg8::ExpertOrder, true, true, true, MOE_FP8 != 0, PG8_BUF_MOE1>(lds, g, S, E, wv);
        SEAM(9);
    }
    if (IN(10)) {
        pg8::Gemm g{(const bf16_t*)(ws + WS_HID), (const bf16_t*)(outs + OUT_W2T), NE * NB * CAP, NE * 1024, MOE_FP8 ? DE / 2 : DE, nullptr};
        pg8::ExpertOrder S; S.init(NE, 16, 4, G, bid);
        pg8::EpiDown E{(bf16_t*)(ws + WS_DN), (const float*)(ws + WS_VAL), (const float*)(ws + WS_MOD)};
        pg8::gemm_phase<pg8::EpiDown, pg8::ExpertOrder, true, true, false, MOE_FP8 != 0, PG8_BUF_MOE2>(lds, g, S, E, wv);
        SEAM(10);
    }
    if (IN(11)) { for (int r = 0; r < NREP(11); ++r) phase_final(p, bid, G, wv); }
#undef IN
#undef SEAM
}

extern "C" void kernel_launch(void* const* d_in, const int* in_sizes, int n_in, void* d_out, int out_size, void* d_ws, size_t ws_size, hipStream_t stream) {
    static int grid = 0;
    if (grid == 0) {
        if (n_in != 27 || out_size != MX * D || ws_size < WS_END) { fprintf(stderr, "kernel_launch: unexpected shapes: n_in %d out %d ws %zu (need %zu)\n", n_in, out_size, ws_size, (size_t)WS_END); grid = -1; return; }
        int dev = 0, cus = 0, per_cu = 0;
        hipGetDevice(&dev); hipDeviceGetAttribute(&cus, hipDeviceAttributeMultiprocessorCount, dev);
        hipFuncSetAttribute((const void*)mk_fwd, hipFuncAttributeMaxDynamicSharedMemorySize, LDS_BYTES);
        hipOccupancyMaxActiveBlocksPerMultiprocessor(&per_cu, (const void*)mk_fwd, NTHR, LDS_BYTES);
        if (per_cu < 1) { fprintf(stderr, "kernel_launch: occupancy query says %d blocks per CU\n", per_cu); per_cu = 1; }
        (void)hipGetLastError();
        grid = cus;
    }
    if (grid < 0) return;
    Params p{};
    for (int i = 0; i < 27; ++i) p.in[i] = (const float*)d_in[i];
    p.out = (float*)d_out; p.ws = (unsigned char*)d_ws;
#if MK_FUSED
    (void)hipMemsetAsync((char*)d_ws + WS_CTL, 0, 65536, stream);
    p.ph_lo = 0; p.ph_hi = N_PHASES;
    void* args[] = {&p};
    hipError_t e = hipLaunchCooperativeKernel((const void*)mk_fwd, dim3(grid), dim3(NTHR), args, LDS_BYTES, stream);
    if (e != hipSuccess) fprintf(stderr, "cooperative launch failed: %s (grid %d)\n", hipGetErrorString(e), grid);
#else
    for (int ph = 0; ph < N_PHASES; ++ph) {
        p.ph_lo = ph; p.ph_hi = ph + 1;
        hipLaunchKernelGGL(mk_fwd, dim3(grid), dim3(NTHR), LDS_BYTES, stream, p);
    }
#endif
}
```
